# Optimizing an MI355X kernel written in HIP

```python
import math
import numpy as np
import jax
import jax.numpy as jnp
from jax import lax

D_MODEL = 1024
BATCH = 2
SEQ = 8192
DEPTH = 4

D_MIX = D_MODEL
SSD_WIDTH = D_MIX // 2
SSD_HEAD_DIM = 64
SSD_HEADS = SSD_WIDTH // SSD_HEAD_DIM
SSD_GROUPS = 2
SSD_STATE = 64
SSD_CONV = 4
SSD_CONV_DIM = SSD_WIDTH + 2 * SSD_GROUPS * SSD_STATE
SSD_CHUNK = 128
DT_MIN = 0.001
DT_MAX = 0.1
HGRN_WIDTH = D_MIX // 4
HGRN_HEAD_DIM = 64
HGRN_HEADS = HGRN_WIDTH // HGRN_HEAD_DIM
HGRN_CHUNK = 16
GATE_FLOOR = 1e-30
RET_WIDTH = D_MIX // 4
RET_HEAD_DIM = 64
RET_HEADS = RET_WIDTH // RET_HEAD_DIM
RET_CHUNK = 128
ROPE_BASE = 10000.0
IN_WIDTHS = (SSD_WIDTH, SSD_CONV_DIM, SSD_HEADS,
             HGRN_WIDTH, HGRN_WIDTH, HGRN_WIDTH, HGRN_WIDTH,
             RET_WIDTH, RET_WIDTH, RET_WIDTH, RET_WIDTH)
D_IN = SSD_WIDTH + SSD_CONV_DIM + SSD_HEADS + 4 * HGRN_WIDTH + 4 * RET_WIDTH
N_GROUPS = 4
EXPERTS_PER_GROUP = 8
N_EXPERTS = N_GROUPS * EXPERTS_PER_GROUP
TOP_K = 2
D_EXPERT = D_MODEL // 4
ADA_SCALE = 0.5
EPS = 1e-6

kernel_name = 'hybrid_ssd_hgrn2_retention_hmoe_adaln'


def rms(x):
    xf = x.astype(jnp.float32)
    return xf * lax.rsqrt(jnp.mean(xf * xf, axis=-1, keepdims=True) + EPS)


def rmsnorm(x, g):
    return rms(x) * g


def causal_depthwise_conv(x, w, bias):
    width, ch = w.shape
    out = lax.conv_general_dilated(
        x, w[:, None, :].astype(x.dtype), window_strides=(1,), padding=[(width - 1, 0)],
        dimension_numbers=('NWC', 'WIO', 'NWC'), feature_group_count=ch)
    return out + bias


def rotary(x, pos):
    half = x.shape[-1] // 2
    inv_freq = ROPE_BASE ** (-jnp.arange(half, dtype=jnp.float32) / half)
    ang = pos[:, None] * inv_freq[None, :]
    cos = jnp.cos(ang)[None, :, None, :]
    sin = jnp.sin(ang)[None, :, None, :]
    x1 = x[..., :half].astype(jnp.float32)
    x2 = x[..., half:].astype(jnp.float32)
    return jnp.concatenate([x1 * cos - x2 * sin, x1 * sin + x2 * cos], axis=-1)


def chunked_linear_recurrence(q, k, v, log_a, chunk):
    b, l, h, dk = q.shape
    dv = v.shape[-1]
    nc = l // chunk
    q, k, v, log_a = (t.astype(jnp.float32).reshape(b, nc, chunk, h, t.shape[-1])
                      for t in (q, k, v, log_a))
    cum = jnp.cumsum(log_a, axis=2)
    causal = jnp.tril(jnp.ones((chunk, chunk), dtype=bool))
    if log_a.shape[-1] == 1:
        cs = jnp.moveaxis(cum[..., 0], 2, 3)
        diff = cs[..., :, None] - cs[..., None, :]
        decay = jnp.where(causal, jnp.exp(jnp.where(causal, diff, 0.0)), 0.0)
        scores = jnp.einsum('bcthk,bcshk->bchts', q, k) * decay
    else:
        diff = cum[:, :, :, None] - cum[:, :, None]
        m = causal[:, :, None, None]
        decay = jnp.where(m, jnp.exp(jnp.where(m, diff, 0.0)), 0.0)
        scores = jnp.einsum('bcthk,bcshk,bctshk->bchts', q, k, decay)
    o_intra = jnp.einsum('bchts,bcshv->bcthv', scores, v)
    k_end = k * jnp.exp(cum[:, :, -1:] - cum)
    chunk_states = jnp.einsum('bcshk,bcshv->bchkv', k_end, v)
    chunk_decay = jnp.exp(cum[:, :, -1])

    def carry_state(s, inp):
        a, s_c = inp
        return a[..., None] * s + s_c, s

    _, s_prev = lax.scan(carry_state, jnp.zeros((b, h, dk, dv), jnp.float32),
                         (jnp.moveaxis(chunk_decay, 1, 0), jnp.moveaxis(chunk_states, 1, 0)))
    s_prev = jnp.moveaxis(s_prev, 0, 1)
    o_inter = jnp.einsum('bcthk,bchkv->bcthv', q * jnp.exp(cum), s_prev)
    return (o_intra + o_inter).reshape(b, l, h, dv)


def token_mixer(h, w_in, conv_w, conv_b, dt_bias, a_log, d_skip, ssd_norm_g,
                lower_bound, hgrn_norm_g, w_out):
    b, l, _ = h.shape
    proj = h @ w_in
    offsets = np.cumsum(IN_WIDTHS)[:-1].tolist()
    z, xbc, dt, hq, hf, hi, hg, rq, rk, rv, rg = jnp.split(proj, offsets, axis=-1)

    def heads(t, n):
        return t.reshape(b, l, n, -1)

    xbc = jax.nn.silu(causal_depthwise_conv(xbc, conv_w, conv_b))
    xs, bm, cm = jnp.split(xbc, [SSD_WIDTH, SSD_WIDTH + SSD_GROUPS * SSD_STATE], axis=-1)
    rep = SSD_HEADS // SSD_GROUPS
    xs = heads(xs, SSD_HEADS)
    bm = jnp.repeat(heads(bm, SSD_GROUPS), rep, axis=2)
    cm = jnp.repeat(heads(cm, SSD_GROUPS), rep, axis=2)
    dt = jax.nn.softplus(dt.astype(jnp.float32) + dt_bias)
    log_a = (dt * -jnp.exp(a_log.astype(jnp.float32)))[..., None]
    y = chunked_linear_recurrence(cm, bm, xs * dt[..., None], log_a, SSD_CHUNK)
    y = y + d_skip[:, None] * xs
    y = y * jax.nn.silu(heads(z, SSD_HEADS).astype(jnp.float32))
    y_ssd = rmsnorm(y.reshape(b, l, SSD_GROUPS, -1),
                    ssd_norm_g.reshape(SSD_GROUPS, -1)).reshape(b, l, SSD_WIDTH)

    raw = hf.astype(jnp.float32)
    forget = lower_bound + (1.0 - lower_bound) * jax.nn.sigmoid(raw)
    log_f = jnp.log(jnp.maximum(forget, GATE_FLOOR))
    k_in = 1.0 - forget
    o = chunked_linear_recurrence(heads(hq, HGRN_HEADS), heads(k_in, HGRN_HEADS),
                                  heads(hi, HGRN_HEADS), heads(log_f, HGRN_HEADS), HGRN_CHUNK)
    o = rmsnorm(o, hgrn_norm_g.reshape(HGRN_HEADS, HGRN_HEAD_DIM))
    o_hgrn = (o * jax.nn.sigmoid(heads(hg, HGRN_HEADS).astype(jnp.float32))).reshape(b, l, HGRN_WIDTH)

    pos = jnp.arange(l, dtype=jnp.float32)
    q_r = rotary(heads(rq, RET_HEADS), pos)
    k_r = rotary(heads(rk, RET_HEADS), pos) * RET_HEAD_DIM ** -0.5
    log_gamma = jnp.log1p(-jnp.exp2(-5.0 - jnp.arange(RET_HEADS, dtype=jnp.float32)))
    log_g = jnp.broadcast_to(log_gamma[:, None], (b, l, RET_HEADS, 1))
    o = chunked_linear_recurrence(q_r, k_r, heads(rv, RET_HEADS), log_g, RET_CHUNK)
    o_ret = (rms(o) * jax.nn.silu(heads(rg, RET_HEADS).astype(jnp.float32))).reshape(b, l, RET_WIDTH)

    mixed = jnp.concatenate([y_ssd, o_hgrn, o_ret], axis=-1).astype(h.dtype)
    return mixed @ w_out


def hierarchical_moe(h, w_grp, b_grp, w_exp, b_exp, w_gate, w_up, w_down):
    b, l, d = h.shape
    t = h.reshape(b * l, d)
    grp_logits = (t @ w_grp + b_grp).astype(jnp.float32)
    grp_prob = jax.nn.softmax(grp_logits, axis=-1)
    g_idx = jnp.argmax(grp_logits, axis=-1)
    p_grp = jnp.max(grp_prob, axis=-1, keepdims=True)
    exp_logits = (t @ w_exp + b_exp).astype(jnp.float32).reshape(-1, N_GROUPS, EXPERTS_PER_GROUP)
    in_grp = jnp.einsum('tg,tge->te', jax.nn.one_hot(g_idx, N_GROUPS, dtype=jnp.float32), exp_logits)
    top_logit, top_idx = lax.top_k(in_grp, TOP_K)
    weights = jax.nn.softmax(top_logit, axis=-1) * p_grp
    expert_id = g_idx[:, None] * EXPERTS_PER_GROUP + top_idx
    combine = jnp.einsum('tk,tke->te', weights,
                         jax.nn.one_hot(expert_id, N_EXPERTS, dtype=jnp.float32)).astype(t.dtype)
    y = jnp.zeros_like(t)
    for gi in range(N_GROUPS):
        sl = slice(gi * EXPERTS_PER_GROUP, (gi + 1) * EXPERTS_PER_GROUP)
        hid = jax.nn.silu(jnp.einsum('td,edf->tef', t, w_gate[sl])) * jnp.einsum('td,edf->tef', t, w_up[sl])
        y = y + jnp.einsum('tef,efd->td', hid * combine[:, sl, None], w_down[sl])
    return y.reshape(b, l, d)


def setup_inputs(seed: int = 0) -> dict:
    key = jax.random.key(seed)
    ks = jax.random.split(key, 24)
    f32 = jnp.float32

    def nrm(k, shape, scale):
        return scale * jax.random.normal(k, shape, f32)

    dt0 = jnp.exp(jax.random.uniform(ks[9], (DEPTH, SSD_HEADS), f32, math.log(DT_MIN), math.log(DT_MAX)))
    return {
        'x': nrm(ks[0], (BATCH, SEQ, D_MODEL), 1.0),
        'c': nrm(ks[1], (BATCH, D_MODEL), 1.0),
        'norm_mix_g': 1.0 + nrm(ks[2], (DEPTH, D_MODEL), 0.02),
        'norm_ffn_g': 1.0 + nrm(ks[3], (DEPTH, D_MODEL), 0.02),
        'final_norm_g': 1.0 + nrm(ks[4], (D_MODEL,), 0.02),
        'w_ada': nrm(ks[5], (DEPTH, D_MODEL, 6 * D_MODEL), ADA_SCALE * D_MODEL ** -0.5),
        'b_ada': nrm(ks[6], (DEPTH, 6 * D_MODEL), 0.02),
        'w_in': nrm(ks[7], (DEPTH, D_MODEL, D_IN), D_MODEL ** -0.5),
        'conv_w': nrm(ks[8], (DEPTH, SSD_CONV, SSD_CONV_DIM), SSD_CONV ** -0.5),
        'conv_b': nrm(ks[10], (DEPTH, SSD_CONV_DIM), 0.02),
        'ssd_dt_bias': dt0 + jnp.log(-jnp.expm1(-dt0)),
        'ssd_a_log': jnp.log(jax.random.uniform(ks[11], (DEPTH, SSD_HEADS), f32, 1.0, 16.0)),
        'ssd_d': 1.0 + nrm(ks[12], (DEPTH, SSD_HEADS), 0.1),
        'ssd_norm_g': 1.0 + nrm(ks[13], (DEPTH, SSD_WIDTH), 0.02),
        'hgrn_lower_bounds': nrm(ks[14], (DEPTH, HGRN_WIDTH), 0.1),
        'hgrn_norm_g': 1.0 + nrm(ks[15], (DEPTH, HGRN_WIDTH), 0.02),
        'w_out': nrm(ks[16], (DEPTH, D_MIX, D_MODEL), D_MIX ** -0.5),
        'w_grp': nrm(ks[17], (DEPTH, D_MODEL, N_GROUPS), D_MODEL ** -0.5),
        'b_grp': nrm(ks[18], (DEPTH, N_GROUPS), 0.01),
        'w_exp': nrm(ks[19], (DEPTH, D_MODEL, N_EXPERTS), D_MODEL ** -0.5),
        'b_exp': nrm(ks[20], (DEPTH, N_EXPERTS), 0.01),
        'w_gate': nrm(ks[21], (DEPTH, N_EXPERTS, D_MODEL, D_EXPERT), D_MODEL ** -0.5),
        'w_up': nrm(ks[22], (DEPTH, N_EXPERTS, D_MODEL, D_EXPERT), D_MODEL ** -0.5),
        'w_down': nrm(ks[23], (DEPTH, N_EXPERTS, D_EXPERT, D_MODEL), D_EXPERT ** -0.5),
    }


def reference(x, c, norm_mix_g, norm_ffn_g, final_norm_g, w_ada, b_ada, w_in, conv_w, conv_b,
              ssd_dt_bias, ssd_a_log, ssd_d, ssd_norm_g, hgrn_lower_bounds, hgrn_norm_g, w_out,
              w_grp, b_grp, w_exp, b_exp, w_gate, w_up, w_down):
    lb_soft = jax.nn.softmax(hgrn_lower_bounds.astype(jnp.float32), axis=0)
    lower_bound = jnp.cumsum(lb_soft, axis=0) - lb_soft[0]
    c_act = jax.nn.silu(c)
    for layer in range(DEPTH):
        mod = c_act @ w_ada[layer] + b_ada[layer]
        sh_mix, sc_mix, g_mix, sh_ffn, sc_ffn, g_ffn = jnp.split(mod[:, None, :], 6, axis=-1)
        h = (rmsnorm(x, norm_mix_g[layer]) * (1.0 + sc_mix) + sh_mix).astype(x.dtype)
        mixed = token_mixer(h, w_in[layer], conv_w[layer], conv_b[layer], ssd_dt_bias[layer],
                            ssd_a_log[layer], ssd_d[layer], ssd_norm_g[layer], lower_bound[layer],
                            hgrn_norm_g[layer], w_out[layer])
        x = x + (g_mix * mixed).astype(x.dtype)
        h = (rmsnorm(x, norm_ffn_g[layer]) * (1.0 + sc_ffn) + sh_ffn).astype(x.dtype)
        moe = hierarchical_moe(h, w_grp[layer], b_grp[layer], w_exp[layer], b_exp[layer],
                               w_gate[layer], w_up[layer], w_down[layer])
        x = x + (g_ffn * moe).astype(x.dtype)
    return rmsnorm(x, final_norm_g).astype(x.dtype)
```

```cpp
#include <hip/hip_runtime.h>
#include <stdint.h>
#include <stdio.h>

#define GAS __attribute__((address_space(1)))
#define LAS __attribute__((address_space(3)))
typedef unsigned short bf16;
typedef float f32x4 __attribute__((ext_vector_type(4)));
typedef unsigned u32x2 __attribute__((ext_vector_type(2)));
typedef unsigned u32x4 __attribute__((ext_vector_type(4)));

constexpr int D = 1024, NB = 2, L = 8192, T = NB * L, DEPTH = 4;
constexpr int DIN = 3336;
constexpr int NP = 3328;
constexpr int NE = 32, DE = 256;
constexpr float EPS = 1e-6f;
constexpr int R_DT = 1280;
constexpr int C_Z = 0, C_XBC = 512, C_HQ = 1280, C_HF = 1536, C_HI = 1792, C_HG = 2048, C_RQ = 2304, C_RK = 2560, C_RV = 2816, C_RG = 3072;
constexpr int PAIR_ROWS = 2 * T + NE * 256;

constexpr size_t MiB = 1u << 20;
constexpr size_t WS_CTL = 0, CTL_BYTES = 1 * MiB;
constexpr size_t WS_MOD = 1 * MiB;
constexpr size_t WS_LB = 1 * MiB + 512 * 1024;
constexpr size_t WS_ROPE = 2 * MiB;
constexpr size_t WS_DT = 4 * MiB;
constexpr size_t WS_EID = 5 * MiB;
constexpr size_t WS_EW = 5 * MiB + 128 * 1024;
constexpr size_t WS_SLOT = 5 * MiB + 256 * 1024;
constexpr size_t WS_LIST = 6 * MiB;
constexpr size_t WS_WL = 8 * MiB;
constexpr size_t WS_XW = 10 * MiB;
constexpr size_t WS_H = 74 * MiB;
constexpr size_t WS_PROJ = 106 * MiB;
constexpr size_t WS_HID = 106 * MiB;
constexpr size_t WS_Y = 126 * MiB;
constexpr size_t WS_MIXED = 210 * MiB;
constexpr size_t WS_O = 242 * MiB;
constexpr size_t WS_WIN = 306 * MiB;
constexpr size_t WS_WOUT = 332 * MiB;
constexpr size_t WS_WGU = 340 * MiB;
constexpr size_t WS_WD = 468 * MiB;
constexpr size_t WS_ST = 532 * MiB;
constexpr size_t WS_DEC = 4 * MiB + 512 * 1024;
constexpr size_t WS_WR = 564 * MiB;
constexpr size_t WS_WDT = 565 * MiB;
constexpr size_t WS_END = 566 * MiB;
constexpr int CW_CNT = 8192, CNT_STRIDE = 64;
constexpr int CW_BAR = 16384;
constexpr int LDS_STAGE = 0, LDS_TAB = 131072, LDS_TSTART = 139264, LDS_MISC = 143360, LDS_ARGS = 143424, LDS_BYTES = 147456;

struct Args { const float* in[24]; float* out; unsigned char* ws; int ph_lo, ph_hi, region, pad; };

__device__ __forceinline__ float bf2f(unsigned short u) { return __uint_as_float(((unsigned)u) << 16); }
typedef float f32x2_t __attribute__((ext_vector_type(2)));
typedef __bf16 bf16x2_t __attribute__((ext_vector_type(2)));
__device__ __forceinline__ unsigned pk2(float lo, float hi) { const f32x2_t v = {lo, hi}; const bf16x2_t b = __builtin_convertvector(v, bf16x2_t); return __builtin_bit_cast(unsigned, b); }
__device__ __forceinline__ unsigned f2bf(float f) { return pk2(f, f) & 0xffffu; }
__device__ __forceinline__ float fexp(float x) { return __builtin_amdgcn_exp2f(x * 1.4426950408889634f); }
__device__ __forceinline__ float fexp2(float x) { return __builtin_amdgcn_exp2f(x); }
__device__ __forceinline__ float flog(float x) { return __builtin_amdgcn_logf(x) * 0.6931471805599453f; }
__device__ __forceinline__ float frcp(float x) { return __builtin_amdgcn_rcpf(x); }
__device__ __forceinline__ float siluf(float x) { return x * frcp(1.f + fexp(-x)); }
__device__ __forceinline__ float sigmf(float x) { return frcp(1.f + fexp(-x)); }
__device__ __forceinline__ float softplusf(float x) { return fmaxf(x, 0.f) + log1pf(__expf(-fabsf(x))); }
template <int X> __device__ __forceinline__ float swz_xor(float v) { return __int_as_float(__builtin_amdgcn_ds_swizzle(__float_as_int(v), (X << 10) | 0x1f)); }
__device__ __forceinline__ float rdlane(float v, int l) { return __int_as_float(__builtin_amdgcn_readlane(__float_as_int(v), l)); }
__device__ __forceinline__ float wave_sum(float v) {
    v += swz_xor<1>(v); v += swz_xor<2>(v); v += swz_xor<4>(v); v += swz_xor<8>(v); v += swz_xor<16>(v);
    return rdlane(v, 0) + rdlane(v, 32);
}
__device__ __forceinline__ float xor32(float v, int lane) { return __int_as_float(__builtin_amdgcn_ds_bpermute((lane ^ 32) << 2, __float_as_int(v))); }
__constant__ double c_invf[32] = {1.0, 0.7498942093324559, 0.5623413251903491, 0.4216965034285822, 0.31622776601683794, 0.23713737056616552, 0.1778279410038923, 0.1333521432163324, 0.1, 0.07498942093324558, 0.05623413251903491, 0.042169650342858224, 0.03162277660168379, 0.023713737056616554, 0.01778279410038923, 0.01333521432163324, 0.01, 0.007498942093324558, 0.005623413251903491, 0.004216965034285823, 0.0031622776601683794, 0.0023713737056616554, 0.0017782794100389228, 0.001333521432163324, 0.001, 0.0007498942093324559, 0.0005623413251903491, 0.00042169650342858224, 0.00031622776601683794, 0.00023713737056616554, 0.00017782794100389227, 0.0001333521432163324};
constexpr int NWAVES = 8, NTHREADS = 512;
constexpr int PH_PRO = 0, PH_PER_LAYER = 9, PH_FINAL = 1 + DEPTH * PH_PER_LAYER, NPH = PH_FINAL + 1;
enum { P_N1 = 0, P_GIN, P_M1, P_M2, P_M3, P_GOUT, P_N2, P_GGU, P_GDN };

__device__ __forceinline__ void phase_prologue(const Args& a, LAS unsigned char* lds, int bid, int G, int tid) {
    const float* c = a.in[1]; const float* w_ada = a.in[5]; const float* b_ada = a.in[6];
    float* mod = (float*)(a.ws + WS_MOD);
    const int wave = tid >> 6, lane = tid & 63;
    LAS float* cact = (LAS float*)lds;
    LAS float* red = (LAS float*)(lds + 8192);
    for (int i = tid; i < NB * D; i += NTHREADS) { const float v = c[i]; cact[i] = siluf(v); }
    __syncthreads();
    for (int it = bid; it < DEPTH * 24; it += G) {
        const int l = it / 24, j0 = (it % 24) * 256;
        const float* W = w_ada + (size_t)l * D * 6144 + j0 + lane * 4;
        f32x4 a0 = {0.f, 0.f, 0.f, 0.f}, a1 = {0.f, 0.f, 0.f, 0.f};
        const int k0 = wave * 128;
#pragma unroll 8
        for (int k = 0; k < 128; ++k) {
            const f32x4 w = *(const f32x4*)(W + (size_t)(k0 + k) * 6144);
            const float c0 = cact[k0 + k], c1 = cact[D + k0 + k];
            a0 += w * c0; a1 += w * c1;
        }
        __syncthreads();
        *(LAS f32x4*)(red + (wave * 2 + 0) * 256 + lane * 4) = a0;
        *(LAS f32x4*)(red + (wave * 2 + 1) * 256 + lane * 4) = a1;
        __syncthreads();
        {
            const int b = tid >> 8, col = tid & 255;
            float s = 0.f;
#pragma unroll
            for (int w = 0; w < 8; ++w) s += red[(w * 2 + b) * 256 + col];
            mod[((size_t)l * NB + b) * 6144 + j0 + col] = s + b_ada[(size_t)l * 6144 + j0 + col];
        }
    }
    if (bid == G - 1 && tid < 256) {
        const float* hl = a.in[14]; float* lb = (float*)(a.ws + WS_LB);
        const float v0 = hl[tid], v1 = hl[256 + tid], v2 = hl[512 + tid], v3 = hl[768 + tid];
        const float m = fmaxf(fmaxf(v0, v1), fmaxf(v2, v3));
        const float e0 = expf(v0 - m), e1 = expf(v1 - m), e2 = expf(v2 - m), e3 = expf(v3 - m);
        const float inv = 1.f / (e0 + e1 + e2 + e3);
        lb[tid] = 0.f; lb[256 + tid] = e1 * inv; lb[512 + tid] = (e1 + e2) * inv; lb[768 + tid] = (e1 + e2 + e3) * inv;
    }
    {
        float* rope = (float*)(a.ws + WS_ROPE);
        for (int i = bid * NTHREADS + tid; i < L * 32; i += G * NTHREADS) {
            const int p = i >> 5, j = i & 31;
            const double f = c_invf[j];
            double r = (double)p * f * 0.15915494309189535;
            r -= floor(r);
            const float rf = (float)r;
            rope[2 * i] = __builtin_amdgcn_cosf(rf); rope[2 * i + 1] = __builtin_amdgcn_sinf(rf);
        }
    }
}

typedef short n2s8 __attribute__((ext_vector_type(8)));
__device__ __forceinline__ void phase_norm1(const Args& a, int layer, LAS unsigned char* lds, int bid, int G, int wave, int lane, bool rerun = false) {
    const float* xin = a.in[0];
    float* xw = (float*)(a.ws + WS_XW);
    const float* mod = (const float*)(a.ws + WS_MOD);
    bf16* h = (bf16*)(a.ws + WS_H);
    float* dtraw = (float*)(a.ws + WS_DT);
    const bf16* Y = (const bf16*)(a.ws + WS_Y);
    const int* eid = (const int*)(a.ws + WS_EID);
    const int* slot = (const int*)(a.ws + WS_SLOT);
    LAS float* part = (LAS float*)lds;
    LAS float* pdt = (LAS float*)(lds + 512);
    int mybase = 0;
    const bool gather = (layer > 0 && !rerun);
    if (gather) {
        const int* cnt = (const int*)(a.ws + WS_CTL) + CW_CNT + (layer - 1) * NE * CNT_STRIDE;
        int pc = (lane < NE) ? ((cnt[lane * CNT_STRIDE] + 255) & ~255) : 0;
        int run = 0;
#pragma unroll
        for (int i = 0; i < NE; ++i) { mybase = (lane == i) ? run : mybase; run += __builtin_amdgcn_readlane(pc, i); }
    }
    const float* gvec = (layer < DEPTH) ? a.in[2] + (size_t)layer * D : a.in[4];
    const bf16* wdt = (const bf16*)(a.ws + WS_WDT) + (size_t)(layer < DEPTH ? layer : 0) * 2 * 16 * D;
    LAS float* vec = (LAS float*)(lds + 32768);
    const int tile = wave >> 1, kh = wave & 1, t = lane & 15, q = lane >> 4;
    for (int blk = bid; blk < T / 64; blk += G) {
        const int row = blk * 64 + tile * 16 + t, b = row >> 13;
        const int cb = 512 * kh + 8 * q;
        if (layer < DEPTH) {
            const float* mbv = mod + ((size_t)layer * NB + b) * 6144;
            for (int i = wave * 64 + lane; i < D; i += NTHREADS) { vec[i] = gvec[i]; vec[D + i] = mbv[i]; vec[2 * D + i] = mbv[D + i] + 1.f; }
        }
        const float* src = ((layer == 0 && !rerun) ? xin : xw) + (size_t)row * D + cb;
        float* xo = xw + (size_t)row * D + cb;
        const bf16* y0p = Y; const bf16* y1p = Y;
        if (gather) {
            const int e0 = eid[2 * row], e1 = eid[2 * row + 1];
            const int b0 = __builtin_amdgcn_ds_bpermute(e0 << 2, mybase), b1 = __builtin_amdgcn_ds_bpermute(e1 << 2, mybase);
            y0p = Y + (size_t)(b0 + slot[2 * row]) * D + cb; y1p = Y + (size_t)(b1 + slot[2 * row + 1]) * D + cb;
        }
        const float* gf = mod + ((size_t)(layer > 0 ? layer - 1 : 0) * NB + b) * 6144 + 5 * D + cb;
        float ss = 0.f;
#pragma unroll 4
        for (int ks = 0; ks < 16; ++ks) {
            f32x4 x0 = *(const f32x4*)(src + 32 * ks), x1 = *(const f32x4*)(src + 32 * ks + 4);
            if (gather) {
                const u32x4 ya = *(const u32x4*)(y0p + 32 * ks), yb = *(const u32x4*)(y1p + 32 * ks);
                const f32x4 g0 = *(const f32x4*)(gf + 32 * ks), g1 = *(const f32x4*)(gf + 32 * ks + 4);
                x0.x += g0.x * (__uint_as_float(ya.x << 16) + __uint_as_float(yb.x << 16)); x0.y += g0.y * (__uint_as_float(ya.x & 0xffff0000u) + __uint_as_float(yb.x & 0xffff0000u));
                x0.z += g0.z * (__uint_as_float(ya.y << 16) + __uint_as_float(yb.y << 16)); x0.w += g0.w * (__uint_as_float(ya.y & 0xffff0000u) + __uint_as_float(yb.y & 0xffff0000u));
                x1.x += g1.x * (__uint_as_float(ya.z << 16) + __uint_as_float(yb.z << 16)); x1.y += g1.y * (__uint_as_float(ya.z & 0xffff0000u) + __uint_as_float(yb.z & 0xffff0000u));
                x1.z += g1.z * (__uint_as_float(ya.w << 16) + __uint_as_float(yb.w << 16)); x1.w += g1.w * (__uint_as_float(ya.w & 0xffff0000u) + __uint_as_float(yb.w & 0xffff0000u));
            }
            if (layer < DEPTH) { *(f32x4*)(xo + 32 * ks) = x0; *(f32x4*)(xo + 32 * ks + 4) = x1; }
            ss += ((x0.x * x0.x + x0.y * x0.y) + (x0.z * x0.z + x0.w * x0.w)) + ((x1.x * x1.x + x1.y * x1.y) + (x1.z * x1.z + x1.w * x1.w));
        }
        ss += swz_xor<16>(ss); ss += xor32(ss, lane);
        if (q == 0) part[(tile * 2 + kh) * 16 + t] = ss;
        __syncthreads();
        const float rstd = rsqrtf((part[(tile * 2) * 16 + t] + part[(tile * 2 + 1) * 16 + t]) * (1.f / D) + EPS);
        if (layer == DEPTH) {
            float* op = a.out + (size_t)row * D + cb;
#pragma unroll 4
            for (int ks = 0; ks < 16; ++ks) {
                f32x4 x0 = *(const f32x4*)(src + 32 * ks), x1 = *(const f32x4*)(src + 32 * ks + 4);
                {
                    const u32x4 ya = *(const u32x4*)(y0p + 32 * ks), yb = *(const u32x4*)(y1p + 32 * ks);
                    const f32x4 g0 = *(const f32x4*)(gf + 32 * ks), g1 = *(const f32x4*)(gf + 32 * ks + 4);
                    x0.x += g0.x * (__uint_as_float(ya.x << 16) + __uint_as_float(yb.x << 16)); x0.y += g0.y * (__uint_as_float(ya.x & 0xffff0000u) + __uint_as_float(yb.x & 0xffff0000u));
                    x0.z += g0.z * (__uint_as_float(ya.y << 16) + __uint_as_float(yb.y << 16)); x0.w += g0.w * (__uint_as_float(ya.y & 0xffff0000u) + __uint_as_float(yb.y & 0xffff0000u));
                    x1.x += g1.x * (__uint_as_float(ya.z << 16) + __uint_as_float(yb.z << 16)); x1.y += g1.y * (__uint_as_float(ya.z & 0xffff0000u) + __uint_as_float(yb.z & 0xffff0000u));
                    x1.z += g1.z * (__uint_as_float(ya.w << 16) + __uint_as_float(yb.w << 16)); x1.w += g1.w * (__uint_as_float(ya.w & 0xffff0000u) + __uint_as_float(yb.w & 0xffff0000u));
                }
                const f32x4 g0 = *(const f32x4*)(gvec + cb + 32 * ks), g1 = *(const f32x4*)(gvec + cb + 32 * ks + 4);
                *(f32x4*)(op + 32 * ks) = x0 * rstd * g0; *(f32x4*)(op + 32 * ks + 4) = x1 * rstd * g1;
            }
            __syncthreads();
            continue;
        }
        const LAS float* vp = vec + cb;
        bf16* hr = h + (size_t)row * D + cb;
        const bf16* wp = wdt + (size_t)t * D + cb;
        f32x4 acc = {0.f, 0.f, 0.f, 0.f};
#pragma unroll 4
        for (int ks = 0; ks < 16; ++ks) {
            unsigned hi[4], lo[4];
#pragma unroll
            for (int e = 0; e < 2; ++e) {
                const f32x4 g = *(const LAS f32x4*)(vp + 32 * ks + 4 * e), sh = *(const LAS f32x4*)(vp + D + 32 * ks + 4 * e), sc1 = *(const LAS f32x4*)(vp + 2 * D + 32 * ks + 4 * e);
                const f32x4 hv = *(const f32x4*)(xo + 32 * ks + 4 * e) * rstd * g * sc1 + sh;
                const unsigned p01 = pk2(hv.x, hv.y), p23 = pk2(hv.z, hv.w);
                hi[2 * e] = p01; hi[2 * e + 1] = p23;
                lo[2 * e] = pk2(hv.x - __uint_as_float(p01 << 16), hv.y - __uint_as_float(p01 & 0xffff0000u)); lo[2 * e + 1] = pk2(hv.z - __uint_as_float(p23 << 16), hv.w - __uint_as_float(p23 & 0xffff0000u));
            }
            const u32x4 hiv = {hi[0], hi[1], hi[2], hi[3]}, lov = {lo[0], lo[1], lo[2], lo[3]};
            *(u32x4*)(hr + 32 * ks) = hiv;
            const n2s8 Ah = __builtin_bit_cast(n2s8, hiv), Al = __builtin_bit_cast(n2s8, lov);
            const n2s8 Bh = *(const n2s8*)(wp + 32 * ks), Bl = *(const n2s8*)(wp + (size_t)16 * D + 32 * ks);
            acc = __builtin_amdgcn_mfma_f32_16x16x32_bf16(Ah, Bh, acc, 0, 0, 0);
            acc = __builtin_amdgcn_mfma_f32_16x16x32_bf16(Ah, Bl, acc, 0, 0, 0);
            acc = __builtin_amdgcn_mfma_f32_16x16x32_bf16(Al, Bh, acc, 0, 0, 0);
        }
#pragma unroll
        for (int r = 0; r < 4; ++r) pdt[((tile * 2 + kh) * 16 + 4 * q + r) * 16 + t] = acc[r];
        __syncthreads();
        {
            const int tid = wave * 64 + lane, tk = tid >> 3, d = tid & 7, tl = tk >> 4, tt = tk & 15;
            dtraw[(size_t)(blk * 64 + tk) * 8 + d] = pdt[((tl * 2) * 16 + tt) * 16 + d] + pdt[((tl * 2 + 1) * 16 + tt) * 16 + d];
        }
        __syncthreads();
    }
}

__device__ __forceinline__ void phase_norm2(const Args& a, int layer, LAS unsigned char* lds, int bid, int G, int wave, int lane, bool rerun = false) {
    const float* xw = (const float*)(a.ws + WS_XW);
    const float* mod = (const float*)(a.ws + WS_MOD);
    bf16* h = (bf16*)(a.ws + WS_H);
    int* eid = (int*)(a.ws + WS_EID); float* ew = (float*)(a.ws + WS_EW);
    int* slot = (int*)(a.ws + WS_SLOT); int* list = (int*)(a.ws + WS_LIST); float* wl = (float*)(a.ws + WS_WL);
    int* cnt = (int*)(a.ws + WS_CTL) + CW_CNT + layer * NE * CNT_STRIDE;
    const float* gvec = a.in[3] + (size_t)layer * D;
    const float* bg = a.in[18] + layer * 4; const float* be = a.in[20] + layer * NE;
    const bf16* wr = (const bf16*)(a.ws + WS_WR) + (size_t)layer * 2 * 48 * D;
    LAS float* part = (LAS float*)lds;
    LAS float* plog = (LAS float*)(lds + 512);
    LAS int* hist = (LAS int*)(lds + 512 + 4 * 2 * 16 * 48 * 4);
    LAS float* vec = (LAS float*)(lds + 32768);
    const int tile = wave >> 1, kh = wave & 1, t = lane & 15, q = lane >> 4, tid = wave * 64 + lane;
    for (int blk = bid; blk < T / 64; blk += G) {
        const int row = blk * 64 + tile * 16 + t, b = row >> 13;
        {
            const float* mbv = mod + ((size_t)layer * NB + b) * 6144 + 3 * D;
            for (int i = tid; i < D; i += NTHREADS) { vec[i] = gvec[i]; vec[D + i] = mbv[i]; vec[2 * D + i] = mbv[D + i] + 1.f; }
        }
        const float* xr = xw + (size_t)row * D + 512 * kh + 8 * q;
        float ss = 0.f;
#pragma unroll 8
        for (int ks = 0; ks < 16; ++ks) {
            const f32x4 x0 = *(const f32x4*)(xr + 32 * ks), x1 = *(const f32x4*)(xr + 32 * ks + 4);
            ss += ((x0.x * x0.x + x0.y * x0.y) + (x0.z * x0.z + x0.w * x0.w)) + ((x1.x * x1.x + x1.y * x1.y) + (x1.z * x1.z + x1.w * x1.w));
        }
        ss += swz_xor<16>(ss); ss += xor32(ss, lane);
        if (tid < 32) hist[tid] = 0;
        if (q == 0) part[(tile * 2 + kh) * 16 + t] = ss;
        __syncthreads();
        const float rstd = rsqrtf((part[(tile * 2) * 16 + t] + part[(tile * 2 + 1) * 16 + t]) * (1.f / D) + EPS);
        const LAS float* vp = vec + 512 * kh + 8 * q;
        bf16* hr = h + (size_t)row * D + 512 * kh + 8 * q;
        const bf16* wp = wr + (size_t)t * D + 512 * kh + 8 * q;
        f32x4 acc[3] = {{0.f, 0.f, 0.f, 0.f}, {0.f, 0.f, 0.f, 0.f}, {0.f, 0.f, 0.f, 0.f}};
#pragma unroll 4
        for (int ks = 0; ks < 16; ++ks) {
            unsigned hi[4], lo[4];
#pragma unroll
            for (int e = 0; e < 2; ++e) {
                const f32x4 g = *(const LAS f32x4*)(vp + 32 * ks + 4 * e), sh = *(const LAS f32x4*)(vp + D + 32 * ks + 4 * e), sc1 = *(const LAS f32x4*)(vp + 2 * D + 32 * ks + 4 * e);
                const f32x4 hv = *(const f32x4*)(xr + 32 * ks + 4 * e) * rstd * g * sc1 + sh;
                const unsigned p01 = pk2(hv.x, hv.y), p23 = pk2(hv.z, hv.w);
                hi[2 * e] = p01; hi[2 * e + 1] = p23;
                lo[2 * e] = pk2(hv.x - __uint_as_float(p01 << 16), hv.y - __uint_as_float(p01 & 0xffff0000u)); lo[2 * e + 1] = pk2(hv.z - __uint_as_float(p23 << 16), hv.w - __uint_as_float(p23 & 0xffff0000u));
            }
            const u32x4 hiv = {hi[0], hi[1], hi[2], hi[3]}, lov = {lo[0], lo[1], lo[2], lo[3]};
            *(u32x4*)(hr + 32 * ks) = hiv;
            const n2s8 Ah = __builtin_bit_cast(n2s8, hiv), Al = __builtin_bit_cast(n2s8, lov);
#pragma unroll
            for (int nt = 0; nt < 3; ++nt) {
                const n2s8 Bh = *(const n2s8*)(wp + (size_t)(16 * nt) * D + 32 * ks), Bl = *(const n2s8*)(wp + (size_t)(48 + 16 * nt) * D + 32 * ks);
                acc[nt] = __builtin_amdgcn_mfma_f32_16x16x32_bf16(Ah, Bh, acc[nt], 0, 0, 0);
                acc[nt] = __builtin_amdgcn_mfma_f32_16x16x32_bf16(Ah, Bl, acc[nt], 0, 0, 0);
                acc[nt] = __builtin_amdgcn_mfma_f32_16x16x32_bf16(Al, Bh, acc[nt], 0, 0, 0);
            }
        }
#pragma unroll
        for (int nt = 0; nt < 3; ++nt)
#pragma unroll
            for (int r = 0; r < 4; ++r) plog[((tile * 2 + kh) * 16 + 4 * q + r) * 48 + 16 * nt + t] = acc[nt][r];
        __syncthreads();
        int e0 = 0, e1 = 0, r0 = 0, r1 = 0; float w0 = 0.f, w1 = 0.f;
        const bool router = (kh == 0 && lane < 16 && !rerun);
        const int rrow = blk * 64 + tile * 16 + lane;
        if (router) {
            const LAS float* p0 = plog + ((tile * 2) * 16 + lane) * 48; const LAS float* p1 = p0 + 16 * 48;
            float lg[4];
#pragma unroll
            for (int i = 0; i < 4; ++i) lg[i] = p0[32 + i] + p1[32 + i] + bg[i];
            int gi = 0; float gm = lg[0];
#pragma unroll
            for (int i = 1; i < 4; ++i) if (lg[i] > gm) { gm = lg[i]; gi = i; }
            float se = 0.f;
#pragma unroll
            for (int i = 0; i < 4; ++i) se += expf(lg[i] - gm);
            const float pg = 1.f / se;
            float ig[8];
#pragma unroll
            for (int i = 0; i < 8; ++i) ig[i] = p0[gi * 8 + i] + p1[gi * 8 + i] + be[gi * 8 + i];
            int i0 = 0; float v0 = ig[0];
#pragma unroll
            for (int i = 1; i < 8; ++i) if (ig[i] > v0) { v0 = ig[i]; i0 = i; }
            int i1 = -1; float v1 = -3.0e38f;
#pragma unroll
            for (int i = 0; i < 8; ++i) if (i != i0 && ig[i] > v1) { v1 = ig[i]; i1 = i; }
            const float ex = expf(v1 - v0);
            w0 = pg / (1.f + ex); w1 = pg * ex / (1.f + ex);
            e0 = gi * 8 + i0; e1 = gi * 8 + i1;
            r0 = __hip_atomic_fetch_add(&hist[e0], 1, __ATOMIC_RELAXED, __HIP_MEMORY_SCOPE_WORKGROUP); r1 = __hip_atomic_fetch_add(&hist[e1], 1, __ATOMIC_RELAXED, __HIP_MEMORY_SCOPE_WORKGROUP);
        }
        __syncthreads();
        if (tid < 32) { const int c = hist[tid]; hist[32 + tid] = c ? atomicAdd(&cnt[tid * CNT_STRIDE], c) : 0; }
        __syncthreads();
        if (router) {
            const int s0 = hist[32 + e0] + r0, s1 = hist[32 + e1] + r1;
            eid[2 * rrow] = e0; eid[2 * rrow + 1] = e1; ew[2 * rrow] = w0; ew[2 * rrow + 1] = w1; slot[2 * rrow] = s0; slot[2 * rrow + 1] = s1;
            list[(size_t)e0 * T + s0] = rrow; wl[(size_t)e0 * T + s0] = w0; list[(size_t)e1 * T + s1] = rrow; wl[(size_t)e1 * T + s1] = w1;
        }
        __syncthreads();
    }
}

#define XB_TMO      128
#define XB_XCNT(j)  (256  + 64 * (j))
#define XB_XSUB(j)  (1280 + 64 * (j))
#define XB_XGEN(j)  (2304 + 64 * (j))
#define XB_TOP      3328
#define XB_TOPGEN   3392
#define XCD_BAR_WORDS 3456
#define XB_SPIN_CAP (1u << 18)

__device__ __forceinline__ unsigned xb_ld(unsigned* p)              { return __hip_atomic_load(p, __ATOMIC_RELAXED, __HIP_MEMORY_SCOPE_AGENT); }
__device__ __forceinline__ unsigned xb_add(unsigned* p, unsigned v) { return __hip_atomic_fetch_add(p, v, __ATOMIC_RELAXED, __HIP_MEMORY_SCOPE_AGENT); }
__device__ __forceinline__ unsigned xb_xcc_id() { return (unsigned)__builtin_amdgcn_s_getreg((3 << 11) | 20) & 0xFu; }
#define XB_SPIN(cond, bar) do { unsigned _sp = 0; while (cond) { __builtin_amdgcn_s_sleep(1); \
    if ((++_sp & 255u) == 0u) { if (xb_ld(&(bar)[XB_TMO])) break; if (_sp > XB_SPIN_CAP) { atomicAdd(&(bar)[XB_TMO], 1u); break; } } } } while (0)

struct XcdBarrier {
    unsigned* bar; unsigned x;
    volatile LAS unsigned* st;
};

__device__ __forceinline__ XcdBarrier xcd_barrier_post(unsigned* bar, volatile LAS unsigned* st) {
    XcdBarrier b; b.bar = bar; b.x = xb_xcc_id(); b.st = st;
    if (threadIdx.x == 0) (void)xb_add(&bar[XB_XCNT(b.x)], 1u);
    return b;
}
__device__ __forceinline__ void xcd_barrier_complete(unsigned* bar, unsigned x, unsigned& nloc, unsigned& nx) {
    const unsigned G = gridDim.x * gridDim.y * gridDim.z;
    unsigned sum, cnt, mine, sp = 0u;
    for (;;) {
        sum = 0u; cnt = 0u; mine = 0u;
#pragma unroll
        for (unsigned j = 0; j < 16; ++j) { const unsigned c = xb_ld(&bar[XB_XCNT(j)]); sum += c; cnt += (c > 0u) ? 1u : 0u; mine = (j == x) ? c : mine; }
        if (sum == G) break;
        __builtin_amdgcn_s_sleep(1);
        if ((++sp & 255u) == 0u) { if (xb_ld(&bar[XB_TMO])) break; if (sp > XB_SPIN_CAP) { atomicAdd(&bar[XB_TMO], 1u); break; } }
    }
    nloc = mine > 0u ? mine : 1u; nx = cnt > 0u ? cnt : 1u;
}

__device__ __forceinline__ void xcd_barrier(const XcdBarrier& b) {
    asm volatile("s_waitcnt vmcnt(0)" ::: "memory");
    __syncthreads();
    if (threadIdx.x == 0) {
        unsigned* bar = b.bar;
        __builtin_amdgcn_s_waitcnt(0);
        unsigned nloc = b.st[0], nx = b.st[1];
        if (nloc == 0u) { xcd_barrier_complete(bar, b.x, nloc, nx); b.st[0] = nloc; b.st[1] = nx; }
        const unsigned old = xb_add(&bar[XB_XSUB(b.x)], 1u);
        const unsigned gen = old / nloc;
        if (old + 1u == (gen + 1u) * nloc) {
            __builtin_amdgcn_fence(__ATOMIC_RELEASE, "agent");
            asm volatile("s_waitcnt vmcnt(0)" ::: "memory");
            const unsigned og = xb_add(&bar[XB_TOP], 1u);
            const unsigned tg = og / nx;
            if (og + 1u == (tg + 1u) * nx) xb_add(&bar[XB_TOPGEN], 1u);
            else XB_SPIN(xb_ld(&bar[XB_TOPGEN]) == tg, bar);
            __builtin_amdgcn_fence(__ATOMIC_ACQUIRE, "agent");
            xb_add(&bar[XB_XGEN(b.x)], 1u);
            asm volatile("s_waitcnt vmcnt(0)" ::: "memory");
        } else {
            XB_SPIN(xb_ld(&bar[XB_XGEN(b.x)]) == gen, bar);
            __builtin_amdgcn_fence(__ATOMIC_ACQUIRE, "agent");
            asm volatile("s_waitcnt vmcnt(0)" ::: "memory");
        }
    }
    __syncthreads();
}

namespace pg8 {
typedef unsigned short bf16_t;
typedef short bf16x8 __attribute__((ext_vector_type(8)));
constexpr int BM = 256, BK = 64, HALF = 128, HTB = HALF * BK * 2  , STAGE_BYTES = 8 * HTB, NXCD = 8, WGM = 8;

__host__ __device__ __forceinline__ int lds_byte(int r, int c) { const int st = (r >> 4) * 2 + (c >> 5), rr = r & 15, cc = c & 31, ob = rr * 64 + cc * 2; return st * 1024 + (ob ^ (((ob >> 9) & 1) << 5)); }
__host__ __device__ __forceinline__ void stage_rc(int b, int& R, int& C) { const int st = b / 1024, sb = b % 1024, swz = sb ^ (((sb >> 9) & 1) << 5); R = (st >> 1) * 16 + swz / 64; C = (st & 1) * 32 + (swz % 64) / 2; }
__host__ __device__ __forceinline__ int perm32(int rho) { const int n = rho >> 4, i = rho & 15; return 8 * (i >> 2) + 4 * n + (i & 3); }

struct Unit { int pm, pn, e, lu; };
struct Gemm { const bf16_t* A; const bf16_t* Bt; int K; size_t strideB; };

struct StaticOrder {
    int nM, nN, nwg, G, c;
    __host__ __device__ void init(int M, int N, int G_, int c_) { nM = M / BM; nN = N / BM; nwg = nM * nN; G = G_; c = c_; }
    __host__ __device__ bool next(int i, Unit& u) const {
        const long L = (long)i * G + c; if (L >= nwg) return false;
        int wgid = (int)L; { const int q = nwg / NXCD, r = nwg % NXCD, xcd = wgid % NXCD, off = wgid / NXCD; wgid = (xcd < r ? xcd * (q + 1) : r * (q + 1) + (xcd - r) * q) + off; }
        const int nig = WGM * nN, gid = wgid / nig, fm = gid * WGM, gsz = (nM - fm) < WGM ? (nM - fm) : WGM;
        u.pm = fm + ((wgid % nig) % gsz); u.pn = (wgid % nig) / gsz; u.e = 0; u.lu = 0; return true;
    }
};
struct GroupOrder {
    const LAS int* tstart; int NT, total, G, c;
    __device__ __forceinline__ bool next(int i, Unit& u) const {
        const int Lx = i * G + c; if (Lx >= total) return false;
        const int PM = Lx / NT; u.pn = Lx - PM * NT; u.pm = PM;
        int e = 0; while (__builtin_amdgcn_readfirstlane(tstart[e + 1]) <= PM) ++e;
        u.e = e; u.lu = i; return true;
    }
};

__device__ __forceinline__ unsigned cvt_pk_bf16(float lo, float hi) { unsigned r; asm volatile("v_cvt_pk_bf16_f32 %0, %1, %2" : "=v"(r) : "v"(lo), "v"(hi)); return r; }

struct EpiStoreBf16 {
    static constexpr bool PERM = true;
    bf16_t* O; int ldc;
    __device__ __forceinline__ void operator()(const f32x4 (&acc)[2][2][4][2], const Unit& u, int wr, int wc, int fr, int fq) const {
        const int row0 = u.pm * BM + wr * 64 + fr, col0 = u.pn * BM + wc * 32 + 8 * fq;
#pragma unroll
        for (int ai = 0; ai < 2; ++ai)
#pragma unroll
            for (int m = 0; m < 4; ++m) { bf16_t* rowp = O + (size_t)(row0 + ai * HALF + m * 16) * ldc + col0;
#pragma unroll
                for (int bj = 0; bj < 2; ++bj) { const f32x4 v0 = acc[ai][bj][m][0], v1 = acc[ai][bj][m][1];
                    u32x4 w; w.x = cvt_pk_bf16(v0[0], v0[1]); w.y = cvt_pk_bf16(v0[2], v0[3]); w.z = cvt_pk_bf16(v1[0], v1[1]); w.w = cvt_pk_bf16(v1[2], v1[3]);
                    *(u32x4*)(rowp + bj * HALF) = w; } }
    }
};
struct EpiResid {
    static constexpr bool PERM = false;
    float* X; const float* gate;
    __device__ __forceinline__ void operator()(const f32x4 (&acc)[2][2][4][2], const Unit& u, int wr, int wc, int fr, int fq) const {
        const int row0 = u.pm * BM + wr * 64 + fr, col0 = u.pn * BM + wc * 32 + 4 * fq;
        const int b = (u.pm * BM) >> 13;
        f32x4 gv[2][2];
#pragma unroll
        for (int bj = 0; bj < 2; ++bj)
#pragma unroll
            for (int n = 0; n < 2; ++n) gv[bj][n] = *(const f32x4*)(gate + (size_t)b * 6144 + col0 + bj * HALF + n * 16);
#pragma unroll
        for (int ai = 0; ai < 2; ++ai)
#pragma unroll
            for (int m = 0; m < 4; ++m) { float* rowp = X + (size_t)(row0 + ai * HALF + m * 16) * D + col0; f32x4 xv[2][2];
#pragma unroll
                for (int bj = 0; bj < 2; ++bj)
#pragma unroll
                    for (int n = 0; n < 2; ++n) xv[bj][n] = *(const f32x4*)(rowp + bj * HALF + n * 16);
#pragma unroll
                for (int bj = 0; bj < 2; ++bj)
#pragma unroll
                    for (int n = 0; n < 2; ++n) *(f32x4*)(rowp + bj * HALF + n * 16) = xv[bj][n] + gv[bj][n] * acc[ai][bj][m][n]; }
    }
};
struct EpiGU {
    static constexpr bool PERM = true;
    bf16_t* H; const LAS float* tabw;
    __device__ __forceinline__ void operator()(const f32x4 (&acc)[2][2][4][2], const Unit& u, int wr, int wc, int fr, int fq) const {
#pragma unroll
        for (int ai = 0; ai < 2; ++ai)
#pragma unroll
            for (int m = 0; m < 4; ++m) {
                const int rl = ai * HALF + wr * 64 + m * 16 + fr;
                const float w = tabw[u.lu * 256 + rl];
                bf16_t* rowp = H + (size_t)(u.pm * BM + rl) * DE + u.pn * HALF + wc * 32 + 8 * fq;
                float o[8];
#pragma unroll
                for (int n = 0; n < 2; ++n)
#pragma unroll
                    for (int j = 0; j < 4; ++j) { const float g = acc[ai][0][m][n][j], up = acc[ai][1][m][n][j]; o[n * 4 + j] = g * __builtin_amdgcn_rcpf(1.f + __builtin_amdgcn_exp2f(-1.4426950408889634f * g)) * up * w; }
                u32x4 wv; wv.x = cvt_pk_bf16(o[0], o[1]); wv.y = cvt_pk_bf16(o[2], o[3]); wv.z = cvt_pk_bf16(o[4], o[5]); wv.w = cvt_pk_bf16(o[6], o[7]);
                *(u32x4*)rowp = wv;
            }
    }
};

template <class Epi, class Sched, bool GATHER, bool ALIGN_EPI>
__device__ __forceinline__ void gemm_phase(LAS unsigned char* lds, const Gemm g, const Sched& S, const Epi& E, const LAS unsigned* taboff, int wave_id) {
    int lane = __builtin_amdgcn_mbcnt_hi(~0u, __builtin_amdgcn_mbcnt_lo(~0u, 0u)); asm volatile("" : "+v"(lane));
    const int wid = wave_id, tid = wid * 64 + lane, wr = wid >> 2, wc = wid & 3, fr = lane & 15, fq = lane >> 4;
    const int K = g.K, nt = K / BK;
    unsigned voffA[2], voffB[2]; int RA[2]; unsigned cA2[2];
#pragma unroll
    for (int i = 0; i < 2; ++i) { int R, C; stage_rc(tid * 16 + i * 8192, R, C); const int Rb = Epi::PERM ? ((R & ~31) + perm32(R & 31)) : R;
        voffA[i] = (unsigned)(R * K + C) * 2u; voffB[i] = (unsigned)(Rb * K + C) * 2u; RA[i] = R; cA2[i] = (unsigned)C * 2u; }
    const size_t kstep = (size_t)(BK * 2);
    const size_t hstep = (size_t)HALF * K * 2;
    const size_t tstep = 2 * hstep;
    const unsigned ldsw = (unsigned)wid * 1024u;
    const int aoff = lds_byte(wr * 64 + fr, fq * 8), boff = lds_byte(wc * 32 + fr, fq * 8);
#define PG8_SA(b, h) (((b) * 2 + (h)) * HTB)
#define PG8_SB(b, h) ((4 + (b) * 2 + (h)) * HTB)
#define PG8_STAGE(bufoff, gbase, voff) do { _Pragma("unroll") for (int _i = 0; _i < 2; ++_i) \
        __builtin_amdgcn_global_load_lds((const unsigned*)((const char*)(gbase) + (voff)[_i]), (LAS unsigned*)(lds + (bufoff) + ldsw + _i * 8192), 16, 0, 0); } while (0)
#define PG8_STAGE_A(bufoff, ap, h, GO) do { if constexpr (GATHER) { PG8_STAGE(bufoff, ap, (GO)[h]); } else { PG8_STAGE(bufoff, (ap) + (h) * hstep, voffA); } } while (0)
#define PG8_LDA(dst, b, h) do { _Pragma("unroll") for (int m = 0; m < 4; ++m) _Pragma("unroll") for (int k = 0; k < 2; ++k) dst[m][k] = *(const LAS bf16x8*)(lds + PG8_SA(b, h) + aoff + m * 2048 + k * 1024); } while (0)
#define PG8_LDB(dst, b, h) do { _Pragma("unroll") for (int n = 0; n < 2; ++n) _Pragma("unroll") for (int k = 0; k < 2; ++k) dst[n][k] = *(const LAS bf16x8*)(lds + PG8_SB(b, h) + boff + n * 2048 + k * 1024); } while (0)
#define PG8_MMA(ai, bj, At, Bt) do { __builtin_amdgcn_s_setprio(1); _Pragma("unroll") for (int m = 0; m < 4; ++m) _Pragma("unroll") for (int n = 0; n < 2; ++n) _Pragma("unroll") for (int k = 0; k < 2; ++k) \
        acc[ai][bj][m][n] = __builtin_amdgcn_mfma_f32_16x16x32_bf16(Bt[n][k], At[m][k], acc[ai][bj][m][n], 0, 0, 0); __builtin_amdgcn_s_setprio(0); } while (0)
#define PG8_WAIT_V(n) asm volatile("s_waitcnt vmcnt(" #n ")" ::: "memory")
#define PG8_WAIT_L(n) asm volatile("s_waitcnt lgkmcnt(" #n ")" ::: "memory")
#define PG8_BAR __builtin_amdgcn_s_barrier()
#define PG8_SCHED __builtin_amdgcn_sched_barrier(0)
#define PG8_GOLOAD(dst, un) do { _Pragma("unroll") for (int _h = 0; _h < 2; ++_h) _Pragma("unroll") for (int _i = 0; _i < 2; ++_i) dst[_h][_i] = taboff[(un).lu * 256 + _h * HALF + RA[_i]] + cA2[_i]; } while (0)
    Unit cur, nxt; int ui = 0;
    if (!S.next(0, cur)) return;
    f32x4 acc[2][2][4][2];
#pragma unroll
    for (int a = 0; a < 2; ++a)
#pragma unroll
        for (int b = 0; b < 2; ++b)
#pragma unroll
            for (int m = 0; m < 4; ++m)
#pragma unroll
                for (int n = 0; n < 2; ++n) acc[a][b][m][n] = (f32x4){0.f, 0.f, 0.f, 0.f};
    bf16x8 At[4][2], B0[2][2], B1[2][2];
    unsigned goC[2][2] = {{0u, 0u}, {0u, 0u}}, goN[2][2] = {{0u, 0u}, {0u, 0u}};
    const char* cA = GATHER ? (const char*)g.A : (const char*)g.A + (size_t)cur.pm * tstep;
    const char* cB = (const char*)g.Bt + (size_t)cur.e * g.strideB + (size_t)cur.pn * tstep;
    if constexpr (GATHER) { PG8_GOLOAD(goC, cur); PG8_WAIT_L(0); }
    PG8_STAGE(PG8_SB(0, 0), cB, voffB); PG8_STAGE(PG8_SB(0, 1), cB + hstep, voffB); PG8_STAGE_A(PG8_SA(0, 0), cA, 0, goC); PG8_STAGE_A(PG8_SA(0, 1), cA, 1, goC);
    if (wr == 1) PG8_BAR;
    PG8_WAIT_V(2); PG8_BAR;
    PG8_STAGE(PG8_SB(1, 0), cB + kstep, voffB); PG8_STAGE_A(PG8_SA(1, 0), cA + kstep, 0, goC); PG8_STAGE(PG8_SB(1, 1), cB + hstep + kstep, voffB);
    PG8_WAIT_V(6); PG8_BAR;
    for (;;) {
        const bool has_next = S.next(ui + 1, nxt);
        const char* nA = GATHER ? (const char*)g.A : (has_next ? (const char*)g.A + (size_t)nxt.pm * tstep : cA);
        const char* nB = has_next ? (const char*)g.Bt + (size_t)nxt.e * g.strideB + (size_t)nxt.pn * tstep : cB;
        if constexpr (GATHER) {
            if (has_next) { PG8_GOLOAD(goN, nxt); }
            else {
#pragma unroll
                for (int _h = 0; _h < 2; ++_h)
#pragma unroll
                    for (int _i = 0; _i < 2; ++_i) goN[_h][_i] = goC[_h][_i];
            }
        }
#pragma unroll 1
        for (int t = 0; t < nt; t += 2) {
            const bool last = (t == nt - 2);
            const char* a1 = cA + (size_t)(t + 1) * kstep;
            const char* a2 = last ? nA : cA + (size_t)(t + 2) * kstep; const char* b2 = last ? nB : cB + (size_t)(t + 2) * kstep;
            const char* a3 = a2 + kstep; const char* b3 = b2 + kstep;
            unsigned go2[2][2];
#pragma unroll
            for (int _h = 0; _h < 2; ++_h)
#pragma unroll
                for (int _i = 0; _i < 2; ++_i) go2[_h][_i] = last ? goN[_h][_i] : goC[_h][_i];
            PG8_LDB(B0, 0, 0); PG8_LDB(B1, 0, 1); PG8_SCHED; PG8_LDA(At, 0, 0); PG8_STAGE_A(PG8_SA(1, 1), a1, 1, goC);
            PG8_WAIT_V(8); PG8_WAIT_L(0); PG8_BAR; PG8_MMA(0, 0, At, B0); PG8_MMA(0, 1, At, B1); PG8_BAR; PG8_SCHED;
            PG8_LDA(At, 0, 1); PG8_STAGE(PG8_SB(0, 0), b2, voffB); PG8_STAGE(PG8_SB(0, 1), b2 + hstep, voffB); PG8_STAGE_A(PG8_SA(0, 0), a2, 0, go2);
            PG8_WAIT_V(8); PG8_WAIT_L(0); PG8_BAR; PG8_MMA(1, 0, At, B0); PG8_MMA(1, 1, At, B1); PG8_BAR; PG8_SCHED;
            PG8_LDB(B0, 1, 0); PG8_LDB(B1, 1, 1); PG8_SCHED; PG8_LDA(At, 1, 0); PG8_STAGE_A(PG8_SA(0, 1), a2, 1, go2);
            PG8_WAIT_V(8); PG8_WAIT_L(0); PG8_BAR; PG8_MMA(0, 0, At, B0); PG8_MMA(0, 1, At, B1); PG8_BAR; PG8_SCHED;
            PG8_LDA(At, 1, 1); PG8_STAGE(PG8_SB(1, 0), b3, voffB); PG8_STAGE(PG8_SB(1, 1), b3 + hstep, voffB); PG8_STAGE_A(PG8_SA(1, 0), a3, 0, go2);
            PG8_WAIT_V(8); PG8_WAIT_L(0); PG8_BAR; PG8_MMA(1, 0, At, B0); PG8_MMA(1, 1, At, B1); PG8_BAR; PG8_SCHED;
        }
        if constexpr (ALIGN_EPI) { if (wr == 0) PG8_BAR; }
        E(acc, cur, wr, wc, fr, fq);
        if (!has_next) break;
#pragma unroll
        for (int a = 0; a < 2; ++a)
#pragma unroll
            for (int b = 0; b < 2; ++b)
#pragma unroll
                for (int m = 0; m < 4; ++m)
#pragma unroll
                    for (int n = 0; n < 2; ++n) acc[a][b][m][n] = (f32x4){0.f, 0.f, 0.f, 0.f};
        cur = nxt; cA = nA; cB = nB; ++ui;
#pragma unroll
        for (int _h = 0; _h < 2; ++_h)
#pragma unroll
            for (int _i = 0; _i < 2; ++_i) goC[_h][_i] = goN[_h][_i];
        if constexpr (ALIGN_EPI) { if (wr == 1) PG8_BAR; }
    }
    PG8_WAIT_V(0);
    if constexpr (!ALIGN_EPI) { if (wr == 0) PG8_BAR; }
    PG8_BAR;
#undef PG8_SA
#undef PG8_SB
#undef PG8_STAGE
#undef PG8_STAGE_A
#undef PG8_LDA
#undef PG8_LDB
#undef PG8_MMA
#undef PG8_WAIT_V
#undef PG8_WAIT_L
#undef PG8_BAR
#undef PG8_SCHED
#undef PG8_GOLOAD
}
}

__device__ __forceinline__ void cvt_tile(const float* Wsrc, int ldn, bf16* dst, int Kd, LAS float* scr, int lane) {
#pragma unroll 8
    for (int i = 0; i < 32; ++i) { const int kk = 2 * i + (lane >> 5); scr[kk * 33 + (lane & 31)] = Wsrc[(size_t)kk * ldn + (lane & 31)]; }
    asm volatile("s_waitcnt lgkmcnt(0)" ::: "memory");
    const int c = lane & 7;
#pragma unroll
    for (int j = 0; j < 4; ++j) { const int n = (lane >> 3) + 8 * j; const LAS float* s = scr + (8 * c) * 33 + n;
        u32x4 o; o.x = pk2(s[0 * 33], s[1 * 33]); o.y = pk2(s[2 * 33], s[3 * 33]); o.z = pk2(s[4 * 33], s[5 * 33]); o.w = pk2(s[6 * 33], s[7 * 33]);
        *(u32x4*)(dst + (size_t)n * Kd + 8 * c) = o; }
    asm volatile("s_waitcnt lgkmcnt(0)" ::: "memory");
}
constexpr int CV_IN = 16 * 104, CV_OUT = 16 * 32, CV_GU = NE * 256, CV_DN = NE * 128, CV_LAYER = CV_IN + CV_OUT + CV_GU + CV_DN;
__device__ __forceinline__ void cvt_item(const Args& a, int l, int r, LAS float* scr, int lane) {
    if (r < CV_IN) {
        const int kb = r / 104, nb = r % 104, nd = nb * 32, ns = nd + (nd >= R_DT ? 8 : 0);
        cvt_tile(a.in[7] + (size_t)l * D * DIN + (size_t)kb * 64 * DIN + ns, DIN, (bf16*)(a.ws + WS_WIN) + (size_t)l * NP * D + (size_t)nd * D + kb * 64, D, scr, lane); return; }
    r -= CV_IN;
    if (r < CV_OUT) {
        const int kb = r / 32, nb = r % 32;
        cvt_tile(a.in[16] + (size_t)l * D * D + (size_t)kb * 64 * D + nb * 32, D, (bf16*)(a.ws + WS_WOUT) + (size_t)l * D * D + (size_t)nb * 32 * D + kb * 64, D, scr, lane); return; }
    r -= CV_OUT;
    if (r < CV_GU) {
        const int e = r / 256, q = r % 256, kb = q / 16, nb = q % 16, pn = nb / 8, half = (nb % 8) / 4, i0 = (nb % 4) * 32;
        const float* W = (half ? a.in[22] : a.in[21]) + ((size_t)l * NE + e) * D * DE;
        cvt_tile(W + (size_t)kb * 64 * DE + pn * 128 + i0, DE, (bf16*)(a.ws + WS_WGU) + ((size_t)l * NE + e) * 512 * D + (size_t)nb * 32 * D + kb * 64, D, scr, lane); return; }
    r -= CV_GU;
    {
        const int e = r / 128, q = r % 128, kb = q / 32, nb = q % 32;
        const float* W = a.in[23] + ((size_t)l * NE + e) * DE * D;
        cvt_tile(W + (size_t)kb * 64 * D + nb * 32, D, (bf16*)(a.ws + WS_WD) + ((size_t)l * NE + e) * D * DE + (size_t)nb * 32 * DE + kb * 64, DE, scr, lane);
    }
}
__device__ __forceinline__ void convert_router(const Args& a, int gtid, int gthreads) {
    bf16* wr = (bf16*)(a.ws + WS_WR);
    for (int i = gtid; i < DEPTH * 48 * D; i += gthreads) {
        const int l = i / (48 * D), n = (i / D) % 48, k = i % D;
        float w = 0.f;
        if (n < 32) w = a.in[19][((size_t)l * D + k) * NE + n]; else if (n < 36) w = a.in[17][((size_t)l * D + k) * 4 + (n - 32)];
        const unsigned hi = f2bf(w);
        wr[((size_t)l * 2 * 48 + n) * D + k] = (bf16)hi;
        wr[((size_t)l * 2 * 48 + 48 + n) * D + k] = (bf16)f2bf(w - __uint_as_float(hi << 16));
    }
}
__device__ __forceinline__ void convert_dt(const Args& a, int gtid, int gthreads) {
    bf16* wd = (bf16*)(a.ws + WS_WDT);
    for (int i = gtid; i < DEPTH * 16 * D; i += gthreads) {
        const int l = i / (16 * D), n = (i / D) % 16, k = i % D;
        const float w = (n < 8) ? a.in[7][((size_t)l * D + k) * DIN + R_DT + n] : 0.f;
        const unsigned hi = f2bf(w);
        wd[((size_t)l * 2 * 16 + n) * D + k] = (bf16)hi;
        wd[((size_t)l * 2 * 16 + 16 + n) * D + k] = (bf16)f2bf(w - __uint_as_float(hi << 16));
    }
}
constexpr int CW_CVCTR = 4096;
constexpr int CV_TOTAL = DEPTH * CV_LAYER;
constexpr int CV_QUOTA_IN = 6, CV_QUOTA_GU = 6, CV_QUOTA_DN = 2;
__device__ __forceinline__ int cv_need_out(int l) { return l * CV_LAYER + CV_IN + CV_OUT; }
__device__ __forceinline__ int cv_need_dn(int l) { return (l + 1) * CV_LAYER; }
__device__ __forceinline__ void cvt_pull(const Args& a, LAS unsigned char* lds, int wave, int lane, int upto, int quota) {
    int* ctr = (int*)(a.ws + WS_CTL) + CW_CVCTR;
    LAS float* scr = (LAS float*)(lds + LDS_STAGE + 32768 + wave * 8704);
    for (int n = 0; n < quota; ++n) {
        if (__builtin_amdgcn_readfirstlane(__hip_atomic_load(ctr, __ATOMIC_RELAXED, __HIP_MEMORY_SCOPE_AGENT)) >= upto) break;
        int it = 0;
        if (lane == 0) it = atomicAdd(ctr, 1);
        it = __builtin_amdgcn_readfirstlane(it);
        if (it >= CV_TOTAL) break;
        cvt_item(a, it / CV_LAYER, it % CV_LAYER, scr, lane);
    }
}
__device__ __forceinline__ void cvt_ensure(const Args& a, LAS unsigned char* lds, int wave, int lane, int upto) { cvt_pull(a, lds, wave, lane, upto, 1 << 30); __syncthreads(); }
__device__ __forceinline__ void phase_convert(const Args& a, LAS unsigned char* lds, int gw, int ngw, int wave, int lane) {
    convert_router(a, gw * 64 + lane, ngw * 64);
    convert_dt(a, gw * 64 + lane, ngw * 64);
    cvt_ensure(a, lds, wave, lane, cv_need_out(0));
}

__device__ __forceinline__ void phase_gemm_in(const Args& a, int layer, LAS unsigned char* lds, int G, int bid, int wave) {
    pg8::Gemm g{(const bf16*)(a.ws + WS_H), (const bf16*)(a.ws + WS_WIN) + (size_t)layer * NP * D, D, 0};
    pg8::StaticOrder S; S.init(T, NP, G, bid);
    pg8::EpiStoreBf16 E{(bf16*)(a.ws + WS_PROJ), NP};
    pg8::gemm_phase<pg8::EpiStoreBf16, pg8::StaticOrder, false, true>(lds + LDS_STAGE, g, S, E, nullptr, wave);
    if ((S.nwg - bid + G - 1) / G < (S.nwg + G - 1) / G) { int ln = __builtin_amdgcn_mbcnt_hi(~0u, __builtin_amdgcn_mbcnt_lo(~0u, 0u)); cvt_pull(a, lds, wave, ln, CV_TOTAL, CV_QUOTA_IN); }
}
__device__ __forceinline__ void phase_gemm_out(const Args& a, int layer, LAS unsigned char* lds, int G, int bid, int wave) {
    pg8::Gemm g{(const bf16*)(a.ws + WS_MIXED), (const bf16*)(a.ws + WS_WOUT) + (size_t)layer * D * D, D, 0};
    pg8::StaticOrder S; S.init(T, D, G, bid);
    pg8::EpiResid E{(float*)(a.ws + WS_XW), (const float*)(a.ws + WS_MOD) + (size_t)layer * NB * 6144 + 2 * D};
    pg8::gemm_phase<pg8::EpiResid, pg8::StaticOrder, false, false>(lds + LDS_STAGE, g, S, E, nullptr, wave);
}
__device__ __forceinline__ void build_tstart(const int* cnt, LAS int* tstart, int tid) {
    if (tid == 0) { int s = 0; for (int e = 0; e < NE; ++e) { tstart[e] = s; s += (cnt[e * CNT_STRIDE] + 255) >> 8; } tstart[NE] = s; }
    __syncthreads();
}
constexpr int MAXU = 4;
__device__ __forceinline__ void phase_gemm_gu(const Args& a, int layer, LAS unsigned char* lds, int G, int bid, int tid, int wave) {
    const int* cnt = (const int*)(a.ws + WS_CTL) + CW_CNT + layer * NE * CNT_STRIDE;
    LAS int* tstart = (LAS int*)(lds + LDS_TSTART);
    LAS unsigned* taboff = (LAS unsigned*)(lds + LDS_TAB);
    LAS float* tabw = (LAS float*)(lds + LDS_TAB + MAXU * 1024);
    build_tstart(cnt, tstart, tid);
    pg8::GroupOrder S{tstart, 2, __builtin_amdgcn_readfirstlane(tstart[NE]) * 2, G, bid};
    const int* list = (const int*)(a.ws + WS_LIST); const float* wl = (const float*)(a.ws + WS_WL);
    for (int i = 0; i < MAXU; ++i) {
        pg8::Unit u;
        if (!S.next(i, u)) break;
        if (tid < 256) {
            const int slot = (u.pm - tstart[u.e]) * 256 + tid;
            const bool v = slot < cnt[u.e * CNT_STRIDE];
            const int tok = v ? list[(size_t)u.e * T + slot] : 0;
            taboff[i * 256 + tid] = (unsigned)tok * (unsigned)(D * 2);
            tabw[i * 256 + tid] = v ? wl[(size_t)u.e * T + slot] : 0.f;
        }
    }
    __syncthreads();
    pg8::Gemm g{(const bf16*)(a.ws + WS_H), (const bf16*)(a.ws + WS_WGU) + (size_t)layer * NE * 512 * D, D, (size_t)512 * D * 2};
    pg8::EpiGU E{(bf16*)(a.ws + WS_HID), tabw};
    pg8::gemm_phase<pg8::EpiGU, pg8::GroupOrder, true, true>(lds + LDS_STAGE, g, S, E, taboff, wave);
    if ((S.total - bid + G - 1) / G < (S.total + G - 1) / G) { int ln = __builtin_amdgcn_mbcnt_hi(~0u, __builtin_amdgcn_mbcnt_lo(~0u, 0u)); cvt_pull(a, lds, wave, ln, CV_TOTAL, CV_QUOTA_GU); }
}
__device__ __forceinline__ void phase_gemm_dn(const Args& a, int layer, LAS unsigned char* lds, int G, int bid, int tid, int wave) {
    const int* cnt = (const int*)(a.ws + WS_CTL) + CW_CNT + layer * NE * CNT_STRIDE;
    LAS int* tstart = (LAS int*)(lds + LDS_TSTART);
    build_tstart(cnt, tstart, tid);
    pg8::GroupOrder S{tstart, 4, __builtin_amdgcn_readfirstlane(tstart[NE]) * 4, G, bid};
    pg8::Gemm g{(const bf16*)(a.ws + WS_HID), (const bf16*)(a.ws + WS_WD) + (size_t)layer * NE * D * DE, DE, (size_t)D * DE * 2};
    pg8::EpiStoreBf16 E{(bf16*)(a.ws + WS_Y), D};
    pg8::gemm_phase<pg8::EpiStoreBf16, pg8::GroupOrder, false, true>(lds + LDS_STAGE, g, S, E, nullptr, wave);
    if ((S.total - bid + G - 1) / G < (S.total + G - 1) / G) { int ln = __builtin_amdgcn_mbcnt_hi(~0u, __builtin_amdgcn_mbcnt_lo(~0u, 0u)); cvt_pull(a, lds, wave, ln, CV_TOTAL, CV_QUOTA_DN); }
}

#define PROBE_SUB 0
constexpr int NATP = 144, TRP = 272;
typedef short s16x8 __attribute__((ext_vector_type(8)));
typedef short s16x4 __attribute__((ext_vector_type(4)));
__device__ __forceinline__ f32x4 mfma32(s16x8 a, s16x8 b, f32x4 c) { return __builtin_amdgcn_mfma_f32_16x16x32_bf16(a, b, c, 0, 0, 0); }
__device__ __forceinline__ f32x4 mfma16(s16x4 a, s16x4 b, f32x4 c) { return __builtin_amdgcn_mfma_f32_16x16x16bf16_1k(a, b, c, 0, 0, 0); }
__device__ __forceinline__ s16x8 cat8(u32x2 lo, u32x2 hi) { u32x4 v = {lo.x, lo.y, hi.x, hi.y}; return __builtin_bit_cast(s16x8, v); }
__device__ __forceinline__ s16x8 ld8(const LAS unsigned char* p) { return *(const LAS s16x8*)p; }
__device__ __forceinline__ u32x2 ld4(const LAS unsigned char* p) { return *(const LAS u32x2*)p; }
__device__ __forceinline__ void wr_run_T(LAS unsigned char* rowp, const float (&x)[16]) {
    u32x4 w0 = {pk2(x[0], x[1]), pk2(x[2], x[3]), pk2(x[4], x[5]), pk2(x[6], x[7])}, w1 = {pk2(x[8], x[9]), pk2(x[10], x[11]), pk2(x[12], x[13]), pk2(x[14], x[15])};
    *(LAS u32x4*)rowp = w0; *(LAS u32x4*)(rowp + 16) = w1;
}
__device__ __forceinline__ void wr_run_N(LAS unsigned char* colp, const float (&x)[16]) {
#pragma unroll
    for (int tt = 0; tt < 16; tt += 2) { const unsigned p = pk2(x[tt], x[tt + 1]); *(LAS unsigned short*)(colp + tt * NATP) = (unsigned short)p; *(LAS unsigned short*)(colp + (tt + 1) * NATP) = (unsigned short)(p >> 16); }
}
__device__ __forceinline__ float ret_log2_gamma(int h) { return log2f(1.f - exp2f(-5.f - (float)h)); }

__device__ __forceinline__ void ld_run16(const bf16* proj, size_t row0, int col, unsigned (&r)[16]) {
#pragma unroll
    for (int tt = 0; tt < 16; ++tt) r[tt] = (unsigned)proj[(row0 + tt) * NP + col];
}
__device__ __forceinline__ void ret_rot(const unsigned (&r)[16], const float* rope, int p0, int lane, float scale, float (&x)[16]) {
#pragma unroll
    for (int tt = 0; tt < 16; ++tt) {
        const float own = __uint_as_float(r[tt] << 16), oth = xor32(own, lane);
        const float2 cs = *(const float2*)(rope + ((size_t)(p0 + tt) * 32 + (lane & 31)) * 2);
        x[tt] = ((lane < 32) ? (own * cs.x - oth * cs.y) : (oth * cs.y + own * cs.x)) * scale;
    }
}
__device__ __forceinline__ void ret_m1(const Args& a, LAS unsigned char* lds, int b, int c, int half, int tid) {
    asm volatile("" : "+v"(tid), "+s"(b), "+s"(c));
    const bf16* proj = (const bf16*)(a.ws + WS_PROJ); const float* rope = (const float*)(a.ws + WS_ROPE);
    float* ST = (float*)(a.ws + WS_ST); float* DEC = (float*)(a.ws + WS_DEC);
    const int j = tid >> 6, lane = tid & 63, fr = lane & 15, q = lane >> 4;
    LAS unsigned char* KT = lds; LAS unsigned char* VT = lds + 2 * 64 * TRP;
    const size_t row0 = (size_t)b * L + c * 128 + 16 * j; const int p0 = c * 128 + 16 * j;
    {
        unsigned rk[2][16], rv[2][16];
#pragma unroll
        for (int hd = 0; hd < 2; ++hd) { ld_run16(proj, row0, C_RK + (2 * half + hd) * 64 + lane, rk[hd]); ld_run16(proj, row0, C_RV + (2 * half + hd) * 64 + lane, rv[hd]); }
#pragma unroll
        for (int hd = 0; hd < 2; ++hd) {
            const float lg = ret_log2_gamma(2 * half + hd);
            float kr[16], vv[16];
            ret_rot(rk[hd], rope, p0, lane, 0.125f, kr);
#pragma unroll
            for (int tt = 0; tt < 16; ++tt) { kr[tt] *= fexp2((float)(127 - (16 * j + tt)) * lg); vv[tt] = __uint_as_float(rv[hd][tt] << 16); }
            wr_run_T(KT + (hd * 64 + lane) * TRP + 32 * j, kr);
            wr_run_T(VT + (hd * 64 + lane) * TRP + 32 * j, vv);
        }
    }
    __syncthreads();
    {
        const int hd = j >> 2, vt = j & 3, head = 12 + 2 * half + hd;
        s16x8 Af[4];
#pragma unroll
        for (int ss = 0; ss < 4; ++ss) Af[ss] = ld8(VT + (hd * 64 + 16 * vt + fr) * TRP + (32 * ss + 8 * q) * 2);
        float* dst = ST + (((size_t)b * 64 + c) * 16 + head) * 4096;
#pragma unroll
        for (int kt = 0; kt < 4; ++kt) {
            f32x4 acc = {0.f, 0.f, 0.f, 0.f};
#pragma unroll
            for (int ss = 0; ss < 4; ++ss) acc = mfma32(Af[ss], ld8(KT + (hd * 64 + 16 * kt + fr) * TRP + (32 * ss + 8 * q) * 2), acc);
#pragma unroll
            for (int r = 0; r < 4; ++r) dst[(16 * vt + 4 * q + r) * 64 + 16 * kt + fr] = acc[r];
        }
        if (tid < 128) { const int hd2 = tid >> 6, h2 = 2 * half + hd2; DEC[(((size_t)b * 64 + c) * 16 + 12 + h2) * 64 + (tid & 63)] = exp2f(128.f * ret_log2_gamma(h2)); }
    }
    __syncthreads();
}
__device__ __forceinline__ void ret_m3(const Args& a, LAS unsigned char* lds, int b, int c, int half, int tid) {
    asm volatile("" : "+v"(tid), "+s"(b), "+s"(c));
    const bf16* proj = (const bf16*)(a.ws + WS_PROJ); const float* rope = (const float*)(a.ws + WS_ROPE);
    const float* ST = (const float*)(a.ws + WS_ST); bf16* mixed = (bf16*)(a.ws + WS_MIXED);
    const int j = tid >> 6, lane = tid & 63, fr = lane & 15, q = lane >> 4;
    LAS unsigned char* QN = lds; LAS unsigned char* KN = QN + 2 * 128 * NATP; LAS unsigned char* VT = KN + 2 * 128 * NATP; LAS unsigned char* SN = VT + 2 * 64 * TRP;
    const size_t row0 = (size_t)b * L + c * 128 + 16 * j; const int p0 = c * 128 + 16 * j;
    {
        unsigned rq[2][16], rk[2][16], rv[2][16];
#pragma unroll
        for (int hd = 0; hd < 2; ++hd) { const int h = 2 * half + hd; ld_run16(proj, row0, C_RQ + h * 64 + lane, rq[hd]); ld_run16(proj, row0, C_RK + h * 64 + lane, rk[hd]); ld_run16(proj, row0, C_RV + h * 64 + lane, rv[hd]); }
#pragma unroll
        for (int hd = 0; hd < 2; ++hd) {
            float x[16];
            ret_rot(rq[hd], rope, p0, lane, 1.f, x);
            wr_run_N(QN + (hd * 128 + 16 * j) * NATP + lane * 2, x);
            ret_rot(rk[hd], rope, p0, lane, 0.125f, x);
            wr_run_N(KN + (hd * 128 + 16 * j) * NATP + lane * 2, x);
#pragma unroll
            for (int tt = 0; tt < 16; ++tt) x[tt] = __uint_as_float(rv[hd][tt] << 16);
            wr_run_T(VT + (hd * 64 + lane) * TRP + 32 * j, x);
        }
    }
    {
        const int idx = tid * 16, hd = idx >> 12, rem = idx & 4095, v = rem >> 6, k0 = rem & 63;
        const float* src = ST + (((size_t)b * 64 + c) * 16 + 12 + 2 * half + hd) * 4096 + v * 64 + k0;
        const f32x4 s0 = *(const f32x4*)src, s1 = *(const f32x4*)(src + 4), s2 = *(const f32x4*)(src + 8), s3 = *(const f32x4*)(src + 12);
        u32x4 w0 = {pk2(s0.x, s0.y), pk2(s0.z, s0.w), pk2(s1.x, s1.y), pk2(s1.z, s1.w)}, w1 = {pk2(s2.x, s2.y), pk2(s2.z, s2.w), pk2(s3.x, s3.y), pk2(s3.z, s3.w)};
        LAS unsigned char* d = SN + (hd * 64 + v) * NATP + k0 * 2;
        *(LAS u32x4*)d = w0; *(LAS u32x4*)(d + 16) = w1;
    }
    __syncthreads();
#pragma unroll 1
    for (int hd = 0; hd < 2; ++hd) {
        const int w = (hd == 0) ? j : 7 - j, tl = 16 * w + fr;
        const int h = 2 * half + hd; const float lg = ret_log2_gamma(h);
        const size_t row = (size_t)b * L + c * 128 + tl;
        u32x2 gzr[4];
#pragma unroll
        for (int vt = 0; vt < 4; ++vt) gzr[vt] = *(const u32x2*)(proj + row * NP + C_RG + h * 64 + 16 * vt + 4 * q);
        s16x8 Qf[2];
#pragma unroll
        for (int ks = 0; ks < 2; ++ks) Qf[ks] = ld8(QN + (hd * 128 + 16 * w + fr) * NATP + (32 * ks + 8 * q) * 2);
        f32x4 oacc[4];
#pragma unroll
        for (int vt = 0; vt < 4; ++vt) {
            f32x4 t = {0.f, 0.f, 0.f, 0.f};
#pragma unroll
            for (int ks = 0; ks < 2; ++ks) t = mfma32(ld8(SN + (hd * 64 + 16 * vt + fr) * NATP + (32 * ks + 8 * q) * 2), Qf[ks], t);
            oacc[vt] = t * fexp2((float)(tl + 1) * lg);
        }
#pragma unroll 1
        for (int pa = 0; pa <= (w >> 1); ++pa) {
            unsigned pb[4];
#pragma unroll
            for (int u = 0; u < 2; ++u) {
                const int st = 2 * pa + u;
                f32x4 sc = {0.f, 0.f, 0.f, 0.f};
                if (st <= w) {
#pragma unroll
                    for (int ks = 0; ks < 2; ++ks) sc = mfma32(ld8(KN + (hd * 128 + 16 * st + fr) * NATP + (32 * ks + 8 * q) * 2), Qf[ks], sc);
                }
                float p[4];
#pragma unroll
                for (int r = 0; r < 4; ++r) { const int d = tl - (16 * st + 4 * q + r); p[r] = (d >= 0 && st <= w) ? sc[r] * fexp2((float)d * lg) : 0.f; }
                pb[2 * u] = pk2(p[0], p[1]); pb[2 * u + 1] = pk2(p[2], p[3]);
            }
            const u32x4 pbv = {pb[0], pb[1], pb[2], pb[3]};
            const s16x8 Bp = __builtin_bit_cast(s16x8, pbv);
#pragma unroll
            for (int vt = 0; vt < 4; ++vt) {
                const LAS unsigned char* vp = VT + (hd * 64 + 16 * vt + fr) * TRP + (32 * pa + 4 * q) * 2;
                oacc[vt] = mfma32(cat8(ld4(vp), ld4(vp + 32)), Bp, oacc[vt]);
            }
        }
        float ss = 0.f;
#pragma unroll
        for (int vt = 0; vt < 4; ++vt) ss += (oacc[vt].x * oacc[vt].x + oacc[vt].y * oacc[vt].y) + (oacc[vt].z * oacc[vt].z + oacc[vt].w * oacc[vt].w);
        ss += swz_xor<16>(ss); ss += xor32(ss, lane);
        const float rinv = rsqrtf(ss * (1.f / 64.f) + EPS);
#pragma unroll
        for (int vt = 0; vt < 4; ++vt) {
            const int col = h * 64 + 16 * vt + 4 * q;
            const u32x2 gz = gzr[vt];
            const float g0 = __uint_as_float(gz.x << 16), g1 = __uint_as_float(gz.x & 0xffff0000u), g2 = __uint_as_float(gz.y << 16), g3 = __uint_as_float(gz.y & 0xffff0000u);
            u32x2 o; o.x = pk2(oacc[vt].x * rinv * siluf(g0), oacc[vt].y * rinv * siluf(g1)); o.y = pk2(oacc[vt].z * rinv * siluf(g2), oacc[vt].w * rinv * siluf(g3));
            *(u32x2*)(mixed + row * D + 768 + col) = o;
        }
    }
    __syncthreads();
}

__device__ __forceinline__ void ssd_load_raw(const bf16* proj, size_t row0, int p0, int ch, unsigned (&r)[19]) {
#pragma unroll
    for (int i = 0; i < 19; ++i) { const int p = p0 - 3 + i; r[i] = (p >= 0) ? (unsigned)proj[(row0 + i - 3) * NP + C_XBC + ch] : 0u; }
}
__device__ __forceinline__ void ssd_conv(const unsigned (&r)[19], int ch, const float* cw, const float* cb, float (&x)[16]) {
    const float w0 = cw[ch], w1 = cw[768 + ch], w2 = cw[2 * 768 + ch], w3 = cw[3 * 768 + ch], bb = cb[ch];
#pragma unroll
    for (int tt = 0; tt < 16; ++tt) x[tt] = siluf(bb + w0 * __uint_as_float(r[tt] << 16) + w1 * __uint_as_float(r[tt + 1] << 16) + w2 * __uint_as_float(r[tt + 2] << 16) + w3 * __uint_as_float(r[tt + 3] << 16));
}
__device__ __forceinline__ void ssd_scalars(const Args& a, int layer, int b, int c, int g, int tid, LAS float* aL, LAS float* cumL, LAS float* dtL) {
    const float* dtraw = (const float*)(a.ws + WS_DT);
    const int hl = tid >> 7, t = tid & 127, h = 4 * g + hl;
    const float dt = softplusf(dtraw[((size_t)b * L + c * 128 + t) * 8 + h] + a.in[10][layer * 8 + h]);
    dtL[tid] = dt; aL[tid] = -expf(a.in[11][layer * 8 + h]) * dt;
    __syncthreads();
    float cs = 0.f;
    for (int s = 0; s <= t; ++s) cs += aL[hl * 128 + s];
    cumL[tid] = cs;
    __syncthreads();
}
__device__ __forceinline__ void ssd_m1(const Args& a, int layer, LAS unsigned char* lds, int b, int c, int g, int tid) {
    asm volatile("" : "+v"(tid), "+s"(b), "+s"(c));
    const bf16* proj = (const bf16*)(a.ws + WS_PROJ);
    const float* cw = a.in[8] + (size_t)layer * 4 * 768; const float* cb = a.in[9] + (size_t)layer * 768;
    float* ST = (float*)(a.ws + WS_ST); float* DEC = (float*)(a.ws + WS_DEC);
    const int j = tid >> 6, lane = tid & 63, fr = lane & 15, q = lane >> 4;
    LAS unsigned char* XT = lds; LAS unsigned char* BT = lds + 4 * 64 * TRP;
    LAS float* aL = (LAS float*)(lds + 5 * 64 * TRP); LAS float* cumL = aL + 512; LAS float* dtL = cumL + 512; LAS float* wL = dtL + 512;
    const size_t row0 = (size_t)b * L + c * 128 + 16 * j; const int p0 = c * 128 + 16 * j;
    {
        unsigned raw[5][19];
#pragma unroll
        for (int i = 0; i < 5; ++i) ssd_load_raw(proj, row0, p0, (i < 4 ? (4 * g + i) * 64 : 512 + g * 64) + lane, raw[i]);
        float x[16];
#pragma unroll
        for (int hl = 0; hl < 4; ++hl) {
            ssd_conv(raw[hl], (4 * g + hl) * 64 + lane, cw, cb, x);
            wr_run_T(XT + (hl * 64 + lane) * TRP + 32 * j, x);
        }
        ssd_conv(raw[4], 512 + g * 64 + lane, cw, cb, x);
        wr_run_T(BT + lane * TRP + 32 * j, x);
    }
    ssd_scalars(a, layer, b, c, g, tid, aL, cumL, dtL);
    {
        const int hl = tid >> 7, t = tid & 127;
        const float cl = cumL[hl * 128 + 127];
        wL[tid] = expf(cl - cumL[tid]) * dtL[tid];
        if (t < 64) DEC[(((size_t)b * 64 + c) * 16 + 4 * g + hl) * 64 + t] = expf(cl);
    }
    __syncthreads();
    {
        const int hl = j >> 1;
        float* dst = ST + (((size_t)b * 64 + c) * 16 + 4 * g + hl) * 4096;
#pragma unroll 1
        for (int vi = 0; vi < 2; ++vi) {
            const int vt = (j & 1) * 2 + vi;
            s16x8 Af[4];
#pragma unroll
            for (int ss = 0; ss < 4; ++ss) {
                const u32x4 au = *(const LAS u32x4*)(XT + (hl * 64 + 16 * vt + fr) * TRP + (32 * ss + 8 * q) * 2);
                const f32x4 w0 = *(const LAS f32x4*)(wL + hl * 128 + 32 * ss + 8 * q), w1 = *(const LAS f32x4*)(wL + hl * 128 + 32 * ss + 8 * q + 4);
                u32x4 o;
                o.x = pk2(__uint_as_float(au.x << 16) * w0.x, __uint_as_float(au.x & 0xffff0000u) * w0.y);
                o.y = pk2(__uint_as_float(au.y << 16) * w0.z, __uint_as_float(au.y & 0xffff0000u) * w0.w);
                o.z = pk2(__uint_as_float(au.z << 16) * w1.x, __uint_as_float(au.z & 0xffff0000u) * w1.y);
                o.w = pk2(__uint_as_float(au.w << 16) * w1.z, __uint_as_float(au.w & 0xffff0000u) * w1.w);
                Af[ss] = __builtin_bit_cast(s16x8, o);
            }
#pragma unroll
            for (int kt = 0; kt < 4; ++kt) {
                f32x4 acc = {0.f, 0.f, 0.f, 0.f};
#pragma unroll
                for (int ss = 0; ss < 4; ++ss) acc = mfma32(Af[ss], ld8(BT + (16 * kt + fr) * TRP + (32 * ss + 8 * q) * 2), acc);
#pragma unroll
                for (int r = 0; r < 4; ++r) dst[(16 * vt + 4 * q + r) * 64 + 16 * kt + fr] = acc[r];
            }
        }
    }
    __syncthreads();
}
__device__ __forceinline__ void stage_states2(const float* ST, int b, int c, int head0, LAS unsigned char* SN, int tid) {
    const int idx = tid * 16, hd = idx >> 12, rem = idx & 4095, v = rem >> 6, k0 = rem & 63;
    const float* src = ST + (((size_t)b * 64 + c) * 16 + head0 + hd) * 4096 + v * 64 + k0;
    const f32x4 s0 = *(const f32x4*)src, s1 = *(const f32x4*)(src + 4), s2 = *(const f32x4*)(src + 8), s3 = *(const f32x4*)(src + 12);
    u32x4 w0 = {pk2(s0.x, s0.y), pk2(s0.z, s0.w), pk2(s1.x, s1.y), pk2(s1.z, s1.w)}, w1 = {pk2(s2.x, s2.y), pk2(s2.z, s2.w), pk2(s3.x, s3.y), pk2(s3.z, s3.w)};
    LAS unsigned char* d = SN + (hd * 64 + v) * NATP + k0 * 2;
    *(LAS u32x4*)d = w0; *(LAS u32x4*)(d + 16) = w1;
}
__device__ __forceinline__ void ssd_m3(const Args& a, int layer, LAS unsigned char* lds, int b, int c, int g, int tid) {
    asm volatile("" : "+v"(tid), "+s"(b), "+s"(c));
    const bf16* proj = (const bf16*)(a.ws + WS_PROJ);
    const float* cw = a.in[8] + (size_t)layer * 4 * 768; const float* cb = a.in[9] + (size_t)layer * 768;
    const float* ST = (const float*)(a.ws + WS_ST); bf16* mixed = (bf16*)(a.ws + WS_MIXED);
    const int j = tid >> 6, lane = tid & 63, fr = lane & 15, q = lane >> 4;
    LAS unsigned char* XT = lds; LAS unsigned char* KN = XT + 4 * 64 * TRP; LAS unsigned char* QN = KN + 128 * NATP; LAS unsigned char* SN = QN + 128 * NATP;
    LAS float* aL = (LAS float*)(SN + 2 * 64 * NATP); LAS float* cumL = aL + 512; LAS float* dtL = cumL + 512;
    const size_t row0 = (size_t)b * L + c * 128 + 16 * j; const int p0 = c * 128 + 16 * j;
    {
        unsigned raw[6][19];
#pragma unroll
        for (int i = 0; i < 6; ++i) ssd_load_raw(proj, row0, p0, (i < 4 ? (4 * g + i) * 64 : (i == 4 ? 512 : 640) + g * 64) + lane, raw[i]);
        float x[16];
#pragma unroll
        for (int hl = 0; hl < 4; ++hl) {
            ssd_conv(raw[hl], (4 * g + hl) * 64 + lane, cw, cb, x);
            wr_run_T(XT + (hl * 64 + lane) * TRP + 32 * j, x);
        }
        ssd_conv(raw[4], 512 + g * 64 + lane, cw, cb, x);
        wr_run_N(KN + (16 * j) * NATP + lane * 2, x);
        ssd_conv(raw[5], 640 + g * 64 + lane, cw, cb, x);
        wr_run_N(QN + (16 * j) * NATP + lane * 2, x);
    }
    stage_states2(ST, b, c, 4 * g, SN, tid);
    ssd_scalars(a, layer, b, c, g, tid, aL, cumL, dtL);
    u32x2 y[2][2][4]; float ssum[2];
    size_t rowp[2];
#pragma unroll
    for (int p = 0; p < 2; ++p) {
        if (p == 1) { __syncthreads(); stage_states2(ST, b, c, 4 * g + 2, SN, tid); __syncthreads(); }
        const int wb = (p == 0) ? j : 7 - j, tl = 16 * wb + fr;
        rowp[p] = (size_t)b * L + c * 128 + tl;
        u32x2 gz[2][4];
#pragma unroll
        for (int hd = 0; hd < 2; ++hd)
#pragma unroll
            for (int vt = 0; vt < 4; ++vt) gz[hd][vt] = *(const u32x2*)(proj + rowp[p] * NP + C_Z + (4 * g + 2 * p + hd) * 64 + 16 * vt + 4 * q);
        s16x8 Qf[2];
#pragma unroll
        for (int ks = 0; ks < 2; ++ks) Qf[ks] = ld8(QN + (16 * wb + fr) * NATP + (32 * ks + 8 * q) * 2);
        f32x4 sc[8];
#pragma unroll
        for (int st = 0; st < 8; ++st) {
            sc[st] = (f32x4){0.f, 0.f, 0.f, 0.f};
            if (st <= wb) {
#pragma unroll
                for (int ks = 0; ks < 2; ++ks) sc[st] = mfma32(ld8(KN + (16 * st + fr) * NATP + (32 * ks + 8 * q) * 2), Qf[ks], sc[st]);
            }
        }
        float ss = 0.f;
#pragma unroll
        for (int hd = 0; hd < 2; ++hd) {
            const int hl = 2 * p + hd, h = 4 * g + hl;
            const float cum_t = cumL[hl * 128 + tl], dsk = a.in[12][layer * 8 + h];
            f32x4 oacc[4];
            const float et = fexp(cum_t);
#pragma unroll
            for (int vt = 0; vt < 4; ++vt) {
                f32x4 t = {0.f, 0.f, 0.f, 0.f};
#pragma unroll
                for (int ks = 0; ks < 2; ++ks) t = mfma32(ld8(SN + (hd * 64 + 16 * vt + fr) * NATP + (32 * ks + 8 * q) * 2), Qf[ks], t);
                oacc[vt] = t * et;
            }
#pragma unroll
            for (int pa = 0; pa < 4; ++pa) {
                if (2 * pa <= wb) {
                    unsigned pb[4];
#pragma unroll
                    for (int u = 0; u < 2; ++u) {
                        const int st = 2 * pa + u;
                        const f32x4 cs4 = *(const LAS f32x4*)(cumL + hl * 128 + 16 * st + 4 * q), dt4 = *(const LAS f32x4*)(dtL + hl * 128 + 16 * st + 4 * q);
                        float pv[4];
#pragma unroll
                        for (int r = 0; r < 4; ++r) {
                            const int d = tl - (16 * st + 4 * q + r);
                            const float v = (d >= 0 && st <= wb) ? sc[st][r] * fexp(cum_t - cs4[r]) * dt4[r] : 0.f;
                            pv[r] = (d == 0) ? v + dsk : v;
                        }
                        pb[2 * u] = pk2(pv[0], pv[1]); pb[2 * u + 1] = pk2(pv[2], pv[3]);
                    }
                    const u32x4 pbv = {pb[0], pb[1], pb[2], pb[3]};
                    const s16x8 Bp = __builtin_bit_cast(s16x8, pbv);
#pragma unroll
                    for (int vt = 0; vt < 4; ++vt) {
                        const LAS unsigned char* vp = XT + (hl * 64 + 16 * vt + fr) * TRP + (32 * pa + 4 * q) * 2;
                        oacc[vt] = mfma32(cat8(ld4(vp), ld4(vp + 32)), Bp, oacc[vt]);
                    }
                }
            }
#pragma unroll
            for (int vt = 0; vt < 4; ++vt) {
                const u32x2 z2 = gz[hd][vt];
                const float y0 = oacc[vt].x * siluf(__uint_as_float(z2.x << 16)), y1 = oacc[vt].y * siluf(__uint_as_float(z2.x & 0xffff0000u));
                const float y2 = oacc[vt].z * siluf(__uint_as_float(z2.y << 16)), y3 = oacc[vt].w * siluf(__uint_as_float(z2.y & 0xffff0000u));
                ss += (y0 * y0 + y1 * y1) + (y2 * y2 + y3 * y3);
                y[p][hd][vt].x = pk2(y0, y1); y[p][hd][vt].y = pk2(y2, y3);
            }
        }
        ss += swz_xor<16>(ss); ss += xor32(ss, lane);
        ssum[p] = ss;
    }
    __syncthreads();
    if (q == 0) { aL[16 * j + fr] = ssum[0]; aL[128 + 16 * (7 - j) + fr] = ssum[1]; }
    __syncthreads();
    const float* gn = a.in[13] + (size_t)layer * 512 + g * 256;
#pragma unroll
    for (int p = 0; p < 2; ++p) {
        const int wb = (p == 0) ? j : 7 - j, tl = 16 * wb + fr;
        const float rinv = rsqrtf((aL[tl] + aL[128 + tl]) * (1.f / 256.f) + EPS);
#pragma unroll
        for (int hd = 0; hd < 2; ++hd)
#pragma unroll
            for (int vt = 0; vt < 4; ++vt) {
                const int col = (2 * p + hd) * 64 + 16 * vt + 4 * q;
                const f32x4 gv = *(const f32x4*)(gn + col);
                const u32x2 yy = y[p][hd][vt];
                u32x2 o; o.x = pk2(__uint_as_float(yy.x << 16) * rinv * gv.x, __uint_as_float(yy.x & 0xffff0000u) * rinv * gv.y); o.y = pk2(__uint_as_float(yy.y << 16) * rinv * gv.z, __uint_as_float(yy.y & 0xffff0000u) * rinv * gv.w);
                *(u32x2*)(mixed + rowp[p] * D + g * 256 + col) = o;
            }
    }
    __syncthreads();
}

constexpr int HG_QN = 0, HG_KN = 2 * 64 * NATP, HG_KH = 4 * 64 * NATP, HG_VT = 6 * 64 * NATP, HG_OB = 8 * 64 * NATP, HG_GL = HG_OB + 2 * 64 * TRP, HG_TOT = HG_GL + 2 * 8 * 64 * 4;
template <bool M3>
__device__ __forceinline__ void hgrn_stage_a(const Args& a, int layer, LAS unsigned char* lds, int b, int c, int half, int hc, int j, int lane) {
    const bf16* proj = (const bf16*)(a.ws + WS_PROJ);
    const int hd = j >> 2, sl = j & 3, h = 2 * half + hd, col = h * 64 + lane, jg = 4 * hc + sl;
    const size_t row0 = (size_t)b * L + c * 128 + 16 * jg;
    const float lbv = ((const float*)(a.ws + WS_LB))[layer * 256 + col];
    float qv[16], kin[16], clv[16], vv[16];
#pragma unroll
    for (int tt = 0; tt < 16; ++tt) {
        const float fr_ = bf2f(proj[(row0 + tt) * NP + C_HF + col]);
        vv[tt] = bf2f(proj[(row0 + tt) * NP + C_HI + col]);
        if (M3) qv[tt] = bf2f(proj[(row0 + tt) * NP + C_HQ + col]);
        const float f = lbv + (1.f - lbv) * sigmf(fr_);
        clv[tt] = flog(fmaxf(f, 1e-30f)); kin[tt] = 1.f - f;
    }
#pragma unroll
    for (int tt = 1; tt < 16; ++tt) clv[tt] += clv[tt - 1];
    const float total = clv[15];
    float x[16];
#pragma unroll
    for (int tt = 0; tt < 16; ++tt) x[tt] = kin[tt] * fexp(total - clv[tt]);
    wr_run_T(lds + HG_KH + (hd * 64 + lane) * NATP + 32 * sl, x);
    wr_run_T(lds + HG_VT + (hd * 64 + lane) * NATP + 32 * sl, vv);
    ((LAS float*)(lds + HG_GL))[(hd * 8 + jg) * 64 + lane] = M3 ? fexp(total) : total;
    if (M3) {
#pragma unroll
        for (int tt = 0; tt < 16; ++tt) x[tt] = qv[tt] * fexp(clv[tt]);
        wr_run_N(lds + HG_QN + (hd * 64 + 16 * sl) * NATP + lane * 2, x);
#pragma unroll
        for (int tt = 0; tt < 16; ++tt) x[tt] = kin[tt] * fexp(fminf(-clv[tt], 80.f));
        wr_run_N(lds + HG_KN + (hd * 64 + 16 * sl) * NATP + lane * 2, x);
    }
}
__device__ __forceinline__ s16x4 pk4(f32x4 v) { u32x2 u = {pk2(v.x, v.y), pk2(v.z, v.w)}; return __builtin_bit_cast(s16x4, u); }
__device__ __forceinline__ s16x4 ld4s(const LAS unsigned char* p) { return *(const LAS s16x4*)p; }
template <bool M3>
__device__ __forceinline__ void hgrn_unit(const Args& a, int layer, LAS unsigned char* lds, int b, int c, int half, int tid) {
    asm volatile("" : "+v"(tid), "+s"(b), "+s"(c));
    const int j = tid >> 6, lane = tid & 63, fr = lane & 15, q = lane >> 4;
    const int hd = j >> 2, vt = j & 3, head = 8 + 2 * half + hd;
    float* STp = (float*)(a.ws + WS_ST) + (((size_t)b * 64 + c) * 16 + head) * 4096;
    f32x4 S[4];
#pragma unroll
    for (int kt = 0; kt < 4; ++kt) {
        S[kt] = (f32x4){0.f, 0.f, 0.f, 0.f};
        if (M3) {
#pragma unroll
            for (int r = 0; r < 4; ++r) S[kt][r] = STp[(16 * kt + 4 * q + r) * 64 + 16 * vt + fr];
        }
    }
    const LAS float* gL = (const LAS float*)(lds + HG_GL);
#pragma unroll 1
    for (int hc = 0; hc < 2; ++hc) {
        hgrn_stage_a<M3>(a, layer, lds, b, c, half, hc, j, lane);
        __syncthreads();
#pragma unroll 1
        for (int sl = 0; sl < 4; ++sl) {
            const int jg = 4 * hc + sl;
            const s16x4 Bv = ld4s(lds + HG_VT + (hd * 64 + 16 * vt + fr) * NATP + (16 * sl + 4 * q) * 2);
            if (M3) {
                f32x4 pacc = {0.f, 0.f, 0.f, 0.f};
#pragma unroll
                for (int ks = 0; ks < 2; ++ks)
                    pacc = mfma32(ld8(lds + HG_KN + (hd * 64 + 16 * sl + fr) * NATP + (32 * ks + 8 * q) * 2), ld8(lds + HG_QN + (hd * 64 + 16 * sl + fr) * NATP + (32 * ks + 8 * q) * 2), pacc);
#pragma unroll
                for (int r = 0; r < 4; ++r) pacc[r] = (4 * q + r <= fr) ? pacc[r] : 0.f;
                f32x4 oacc = {0.f, 0.f, 0.f, 0.f};
#pragma unroll
                for (int kt = 0; kt < 4; ++kt) oacc = mfma16(ld4s(lds + HG_QN + (hd * 64 + 16 * sl + fr) * NATP + (16 * kt + 4 * q) * 2), pk4(S[kt]), oacc);
                oacc = mfma16(pk4(pacc), Bv, oacc);
                LAS float* ob = (LAS float*)(lds + HG_OB + (hd * 64 + 16 * sl + 4 * q) * TRP) + 16 * vt + fr;
#pragma unroll
                for (int r = 0; r < 4; ++r) ob[r * (TRP / 4)] = oacc[r];
            }
#pragma unroll
            for (int kt = 0; kt < 4; ++kt) {
                const f32x4 g4 = *(const LAS f32x4*)(gL + (hd * 8 + jg) * 64 + 16 * kt + 4 * q);
                f32x4 sc = S[kt];
                if (M3) sc = sc * g4; else { sc.x *= fexp(g4.x); sc.y *= fexp(g4.y); sc.z *= fexp(g4.z); sc.w *= fexp(g4.w); }
                S[kt] = mfma16(ld4s(lds + HG_KH + (hd * 64 + 16 * kt + fr) * NATP + (16 * sl + 4 * q) * 2), Bv, sc);
            }
        }
        __syncthreads();
        if (M3) {
            const int hd2 = tid >> 8, t = (tid >> 2) & 63, qu = tid & 3, h2 = 2 * half + hd2;
            const LAS float* ob = (const LAS float*)(lds + HG_OB + (hd2 * 64 + t) * TRP) + 16 * qu;
            f32x4 o[4]; float ss = 0.f;
#pragma unroll
            for (int i = 0; i < 4; ++i) { o[i] = *(const LAS f32x4*)(ob + 4 * i); ss += (o[i].x * o[i].x + o[i].y * o[i].y) + (o[i].z * o[i].z + o[i].w * o[i].w); }
            ss += swz_xor<1>(ss); ss += swz_xor<2>(ss);
            const float rinv = rsqrtf(ss * (1.f / 64.f) + EPS);
            const size_t row = (size_t)b * L + c * 128 + 64 * hc + t;
            const bf16* gp = (const bf16*)(a.ws + WS_PROJ) + row * NP + C_HG + h2 * 64 + 16 * qu;
            const u32x4 g0 = *(const u32x4*)gp, g1 = *(const u32x4*)(gp + 8);
            const float* ng = a.in[15] + (size_t)layer * 256 + h2 * 64 + 16 * qu;
            const unsigned gg[8] = {g0.x, g0.y, g0.z, g0.w, g1.x, g1.y, g1.z, g1.w};
            unsigned ow[8];
#pragma unroll
            for (int i = 0; i < 4; ++i) {
                const f32x4 nv = *(const f32x4*)(ng + 4 * i);
                ow[2 * i] = pk2(o[i].x * rinv * nv.x * sigmf(__uint_as_float(gg[2 * i] << 16)), o[i].y * rinv * nv.y * sigmf(__uint_as_float(gg[2 * i] & 0xffff0000u)));
                ow[2 * i + 1] = pk2(o[i].z * rinv * nv.z * sigmf(__uint_as_float(gg[2 * i + 1] << 16)), o[i].w * rinv * nv.w * sigmf(__uint_as_float(gg[2 * i + 1] & 0xffff0000u)));
            }
            bf16* mp = (bf16*)(a.ws + WS_MIXED) + row * D + 512 + h2 * 64 + 16 * qu;
            *(u32x4*)mp = (u32x4){ow[0], ow[1], ow[2], ow[3]}; *(u32x4*)(mp + 8) = (u32x4){ow[4], ow[5], ow[6], ow[7]};
            __syncthreads();
        }
    }
    if (!M3) {
#pragma unroll
        for (int kt = 0; kt < 4; ++kt)
#pragma unroll
            for (int r = 0; r < 4; ++r) STp[(16 * kt + 4 * q + r) * 64 + 16 * vt + fr] = S[kt][r];
        if (tid < 128) {
            const int hd2 = tid >> 6, k = tid & 63;
            float s = 0.f;
#pragma unroll
            for (int jg = 0; jg < 8; ++jg) s += gL[(hd2 * 8 + jg) * 64 + k];
            ((float*)(a.ws + WS_DEC))[(((size_t)b * 64 + c) * 16 + 8 + 2 * half + hd2) * 64 + k] = expf(s);
        }
        __syncthreads();
    }
}

__device__ __forceinline__ void phase_m1(const Args& a, int layer, LAS unsigned char* lds, int bid, int G, int tid) {
    for (int u = bid; u < NB * 64 * 2; u += G) {
        const int b = u >> 7, c = (u >> 1) & 63, half = u & 1;
        for (int r_ = 0; r_ < ((PROBE_SUB == 4) ? 3 : 1); ++r_) ssd_m1(a, layer, lds, b, c, half, tid);
        for (int r_ = 0; r_ < ((PROBE_SUB == 5) ? 3 : 1); ++r_) ret_m1(a, lds, b, c, half, tid);
        for (int r_ = 0; r_ < ((PROBE_SUB == 6) ? 3 : 1); ++r_) hgrn_unit<false>(a, layer, lds, b, c, half, tid);
    }
}
__device__ __forceinline__ void phase_m2(const Args& a, LAS unsigned char* lds, int bid, int G, int tid) {
    float* ST = (float*)(a.ws + WS_ST); const float* DEC = (const float*)(a.ws + WS_DEC);
    LAS float* dl = (LAS float*)lds;
    for (int u = bid; u < 256; u += G) {
        const int bh = u >> 3, b = bh >> 4, head = bh & 15, e = (u & 7) * 512 + tid;
        __syncthreads();
#pragma unroll
        for (int i = 0; i < 8; ++i) { const int x = tid + 512 * i, c = x >> 6; dl[x] = DEC[(((size_t)b * 64 + c) * 16 + head) * 64 + (x & 63)]; }
        float s[64];
#pragma unroll
        for (int c = 0; c < 64; ++c) s[c] = ST[(((size_t)b * 64 + c) * 16 + head) * 4096 + e];
        __syncthreads();
        float run = 0.f;
#pragma unroll
        for (int c = 0; c < 64; ++c) { const float prev = run; run = dl[c * 64 + (e >> 6)] * run + s[c]; ST[(((size_t)b * 64 + c) * 16 + head) * 4096 + e] = prev; }
    }
}
__device__ __forceinline__ void phase_m3(const Args& a, int layer, LAS unsigned char* lds, int bid, int G, int tid) {
    for (int u = bid; u < NB * 64 * 2; u += G) {
        const int b = u >> 7, c = (u >> 1) & 63, half = u & 1;
        for (int r_ = 0; r_ < ((PROBE_SUB == 1) ? 3 : 1); ++r_) ssd_m3(a, layer, lds, b, c, half, tid);
        for (int r_ = 0; r_ < ((PROBE_SUB == 2) ? 3 : 1); ++r_) ret_m3(a, lds, b, c, half, tid);
        for (int r_ = 0; r_ < ((PROBE_SUB == 3) ? 3 : 1); ++r_) hgrn_unit<true>(a, layer, lds, b, c, half, tid);
    }
}


__device__ __forceinline__ const void* rd_ptr(LAS const unsigned* p) {
    const unsigned lo = __builtin_amdgcn_readfirstlane(p[0]), hi = __builtin_amdgcn_readfirstlane(p[1]);
    return (const void*)(GAS const void*)(((unsigned long long)hi << 32) | lo);
}
__device__ __forceinline__ Args load_args(LAS unsigned char* lds) {
    LAS const unsigned* la = (LAS const unsigned*)(lds + LDS_ARGS);
    asm volatile("" : "+v"(la));
    Args A;
#pragma unroll
    for (int i = 0; i < 24; ++i) A.in[i] = (const float*)rd_ptr(la + 2 * i);
    A.out = (float*)rd_ptr(la + 48); A.ws = (unsigned char*)rd_ptr(la + 50);
    A.ph_lo = 0; A.ph_hi = 0; A.region = 0; A.pad = 0;
    return A;
}
#define PROBE_PH -1
#define PROBE_REP 2
#define REPS(p) ((PROBE_PH == (p)) ? 1 + PROBE_REP : 1)
__global__ void __launch_bounds__(NTHREADS, 2) fwd(Args a0) {
    extern __shared__ __attribute__((aligned(16))) unsigned char lds_raw[];
    LAS unsigned char* lds = (LAS unsigned char*)lds_raw;
    const int G0 = gridDim.x, bid0 = blockIdx.x;
    const int wave = __builtin_amdgcn_readfirstlane(threadIdx.x >> 6);
#define FRESH() int lane = __builtin_amdgcn_mbcnt_hi(~0u, __builtin_amdgcn_mbcnt_lo(~0u, 0u)); asm volatile("" : "+v"(lane)); int bid = bid0, G = G0; asm volatile("" : "+s"(bid), "+s"(G)); \
    const int tid = wave * 64 + lane, gw = bid * NWAVES + wave, ngw = G * NWAVES; (void)gw; (void)ngw; const Args a = load_args(lds)
    const int lo = a0.ph_lo, hi = a0.ph_hi;
    volatile LAS unsigned* misc = (volatile LAS unsigned*)(lds + LDS_MISC);
    if (threadIdx.x < 4) misc[threadIdx.x] = 0u;
    if (threadIdx.x < 56) ((LAS unsigned*)(lds + LDS_ARGS))[threadIdx.x] = ((const unsigned*)&a0)[threadIdx.x];
    __syncthreads();
    XcdBarrier bar; bar.bar = (unsigned*)(a0.ws + WS_CTL) + CW_BAR + a0.region * XCD_BAR_WORDS; bar.x = 0; bar.st = misc;
    if (hi - lo > 1) bar = xcd_barrier_post(bar.bar, misc);
#define IN(k) (lo <= (k) && (k) < hi)
#define SEAM(k) do { if (IN(k) && IN((k) + 1)) { asm volatile("" : "+s"(bar.bar)); xcd_barrier(bar); } } while (0)
    if (IN(PH_PRO)) { FRESH(); phase_prologue(a, lds, bid, G, tid); phase_convert(a, lds, gw, ngw, wave, lane); }
    SEAM(PH_PRO);
    for (int layer = 0; layer < DEPTH; ++layer) {
        const int pb = 1 + layer * PH_PER_LAYER;
        if (IN(pb + P_N1)) { _Pragma("unroll 1") for (int rep_ = 0; rep_ < REPS(P_N1); ++rep_) { FRESH(); if (layer > 0) cvt_ensure(a, lds, wave, lane, cv_need_out(layer)); phase_norm1(a, layer, lds, bid, G, wave, lane, rep_ > 0); } }
        SEAM(pb + P_N1);
        if (IN(pb + P_GIN)) { _Pragma("unroll 1") for (int rep_ = 0; rep_ < REPS(P_GIN); ++rep_) { FRESH(); phase_gemm_in(a, layer, lds, G, bid, wave); } }
        SEAM(pb + P_GIN);
        if (IN(pb + P_M1)) { _Pragma("unroll 1") for (int rep_ = 0; rep_ < REPS(P_M1); ++rep_) { FRESH(); phase_m1(a, layer, lds, bid, G, tid); } }
        SEAM(pb + P_M1);
        if (IN(pb + P_M2)) { _Pragma("unroll 1") for (int rep_ = 0; rep_ < REPS(P_M2); ++rep_) { FRESH(); phase_m2(a, lds, bid, G, tid); } }
        SEAM(pb + P_M2);
        if (IN(pb + P_M3)) { _Pragma("unroll 1") for (int rep_ = 0; rep_ < REPS(P_M3); ++rep_) { FRESH(); phase_m3(a, layer, lds, bid, G, tid); } }
        SEAM(pb + P_M3);
        if (IN(pb + P_GOUT)) { _Pragma("unroll 1") for (int rep_ = 0; rep_ < REPS(P_GOUT); ++rep_) { FRESH(); phase_gemm_out(a, layer, lds, G, bid, wave); } }
        SEAM(pb + P_GOUT);
        if (IN(pb + P_N2)) { _Pragma("unroll 1") for (int rep_ = 0; rep_ < REPS(P_N2); ++rep_) { FRESH(); cvt_ensure(a, lds, wave, lane, cv_need_dn(layer)); phase_norm2(a, layer, lds, bid, G, wave, lane, rep_ > 0); } }
        SEAM(pb + P_N2);
        if (IN(pb + P_GGU)) { _Pragma("unroll 1") for (int rep_ = 0; rep_ < REPS(P_GGU); ++rep_) { FRESH(); phase_gemm_gu(a, layer, lds, G, bid, tid, wave); } }
        SEAM(pb + P_GGU);
        if (IN(pb + P_GDN)) { _Pragma("unroll 1") for (int rep_ = 0; rep_ < REPS(P_GDN); ++rep_) { FRESH(); phase_gemm_dn(a, layer, lds, G, bid, tid, wave); } }
        SEAM(pb + P_GDN);
    }
    if (IN(PH_FINAL)) { FRESH(); phase_norm1(a, DEPTH, lds, bid, G, wave, lane); }
#undef IN
#undef SEAM
}

#ifndef N_LAUNCH_MODE
#define N_LAUNCH_MODE 1
#endif
extern "C" void kernel_launch(void* const* d_in, const int* in_sizes, int n_in, void* d_out, int out_size, void* d_ws, size_t ws_size, hipStream_t stream) {
    static int grid = 0;
    if (grid == 0) {
        if (n_in != 24 || ws_size < WS_END) { fprintf(stderr, "kernel_launch: unexpected n_in %d / ws %zu\n", n_in, ws_size); grid = -1; return; }
        int dev = 0, cus = 0, per_cu = 0;
        if (hipGetDevice(&dev) != hipSuccess || hipDeviceGetAttribute(&cus, hipDeviceAttributeMultiprocessorCount, dev) != hipSuccess) { grid = -1; return; }
        if (hipFuncSetAttribute((const void*)fwd, hipFuncAttributeMaxDynamicSharedMemorySize, LDS_BYTES) != hipSuccess) { fprintf(stderr, "kernel_launch: hipFuncSetAttribute failed\n"); grid = -1; return; }
        if (hipOccupancyMaxActiveBlocksPerMultiprocessor(&per_cu, (const void*)fwd, NTHREADS, LDS_BYTES) != hipSuccess || per_cu < 1) { fprintf(stderr, "kernel_launch: occupancy query says %d\n", per_cu); }
        (void)hipGetLastError();
        grid = cus;
    }
    if (grid < 0) return;
    unsigned char* ws = (unsigned char*)d_ws;
    (void)hipMemsetAsync(ws + WS_CTL, 0, CTL_BYTES, stream);
    Args a{};
    for (int i = 0; i < 24; ++i) a.in[i] = (const float*)d_in[i];
    a.out = (float*)d_out; a.ws = ws; a.region = 0; a.pad = 0;
#if N_LAUNCH_MODE == 1
    a.ph_lo = 0; a.ph_hi = NPH;
    hipLaunchKernelGGL(fwd, dim3(grid), dim3(NTHREADS), LDS_BYTES, stream, a);
#else
    for (int ph = 0; ph < NPH; ++ph) { a.ph_lo = ph; a.ph_hi = ph + 1; hipLaunchKernelGGL(fwd, dim3(grid), dim3(NTHREADS), LDS_BYTES, stream, a); }
#endif
}
```

```cpp
#include <hip/hip_runtime.h>
#include <stdint.h>
#include <stdio.h>

#define GAS __attribute__((address_space(1)))
#define LAS __attribute__((address_space(3)))
typedef unsigned short bf16;
typedef float f32x4 __attribute__((ext_vector_type(4)));
typedef unsigned u32x2 __attribute__((ext_vector_type(2)));
typedef unsigned u32x4 __attribute__((ext_vector_type(4)));

constexpr int D = 1024, NB = 2, L = 8192, T = NB * L, DEPTH = 4;
constexpr int DIN = 3336;
constexpr int NP = 3328;
constexpr int NE = 32, DE = 256;
constexpr float EPS = 1e-6f;
constexpr int R_DT = 1280;
constexpr int C_Z = 0, C_XBC = 512, C_HQ = 1280, C_HF = 1536, C_HI = 1792, C_HG = 2048, C_RQ = 2304, C_RK = 2560, C_RV = 2816, C_RG = 3072;
constexpr int PAIR_ROWS = 2 * T + NE * 256;

constexpr size_t MiB = 1u << 20;
constexpr size_t WS_CTL = 0, CTL_BYTES = 1 * MiB;
constexpr size_t WS_MOD = 1 * MiB;
constexpr size_t WS_LB = 1 * MiB + 512 * 1024;
constexpr size_t WS_ROPE = 2 * MiB;
constexpr size_t WS_DT = 4 * MiB;
constexpr size_t WS_EID = 5 * MiB;
constexpr size_t WS_EW = 5 * MiB + 128 * 1024;
constexpr size_t WS_SLOT = 5 * MiB + 256 * 1024;
constexpr size_t WS_LIST = 6 * MiB;
constexpr size_t WS_WL = 8 * MiB;
constexpr size_t WS_XW = 10 * MiB;
constexpr size_t WS_H = 74 * MiB;
constexpr size_t WS_PROJ = 106 * MiB;
constexpr size_t WS_HID = 106 * MiB;
constexpr size_t WS_Y = 126 * MiB;
constexpr size_t WS_MIXED = 210 * MiB;
constexpr size_t WS_O = 242 * MiB;
constexpr size_t WS_WIN = 306 * MiB;
constexpr size_t WS_WOUT = 332 * MiB;
constexpr size_t WS_WGU = 340 * MiB;
constexpr size_t WS_WD = 468 * MiB;
constexpr size_t WS_ST = 532 * MiB;
constexpr size_t WS_DEC = 4 * MiB + 512 * 1024;
constexpr size_t WS_WR = 564 * MiB;
constexpr size_t WS_WDT = 565 * MiB;
constexpr size_t WS_END = 566 * MiB;
constexpr int CW_CNT = 8192, CNT_STRIDE = 64;
constexpr int CW_BAR = 16384;
constexpr int LDS_STAGE = 0, LDS_TAB = 131072, LDS_TSTART = 139264, LDS_MISC = 143360, LDS_ARGS = 143424, LDS_BYTES = 147456;

struct Args { const float* in[24]; float* out; unsigned char* ws; int ph_lo, ph_hi, region, pad; };

__device__ __forceinline__ float bf2f(unsigned short u) { return __uint_as_float(((unsigned)u) << 16); }
typedef float f32x2_t __attribute__((ext_vector_type(2)));
typedef __bf16 bf16x2_t __attribute__((ext_vector_type(2)));
__device__ __forceinline__ unsigned pk2(float lo, float hi) { const f32x2_t v = {lo, hi}; const bf16x2_t b = __builtin_convertvector(v, bf16x2_t); return __builtin_bit_cast(unsigned, b); }
__device__ __forceinline__ unsigned f2bf(float f) { return pk2(f, f) & 0xffffu; }
__device__ __forceinline__ float fexp(float x) { return __builtin_amdgcn_exp2f(x * 1.4426950408889634f); }
__device__ __forceinline__ float fexp2(float x) { return __builtin_amdgcn_exp2f(x); }
__device__ __forceinline__ float flog(float x) { return __builtin_amdgcn_logf(x) * 0.6931471805599453f; }
__device__ __forceinline__ float frcp(float x) { return __builtin_amdgcn_rcpf(x); }
__device__ __forceinline__ float siluf(float x) { return x * frcp(1.f + fexp(-x)); }
__device__ __forceinline__ float sigmf(float x) { return frcp(1.f + fexp(-x)); }
__device__ __forceinline__ float softplusf(float x) { return fmaxf(x, 0.f) + log1pf(__expf(-fabsf(x))); }
template <int X> __device__ __forceinline__ float swz_xor(float v) { return __int_as_float(__builtin_amdgcn_ds_swizzle(__float_as_int(v), (X << 10) | 0x1f)); }
__device__ __forceinline__ float rdlane(float v, int l) { return __int_as_float(__builtin_amdgcn_readlane(__float_as_int(v), l)); }
__device__ __forceinline__ float wave_sum(float v) {
    v += swz_xor<1>(v); v += swz_xor<2>(v); v += swz_xor<4>(v); v += swz_xor<8>(v); v += swz_xor<16>(v);
    return rdlane(v, 0) + rdlane(v, 32);
}
__device__ __forceinline__ float xor32(float v, int lane) { return __int_as_float(__builtin_amdgcn_ds_bpermute((lane ^ 32) << 2, __float_as_int(v))); }
__constant__ double c_invf[32] = {1.0, 0.7498942093324559, 0.5623413251903491, 0.4216965034285822, 0.31622776601683794, 0.23713737056616552, 0.1778279410038923, 0.1333521432163324, 0.1, 0.07498942093324558, 0.05623413251903491, 0.042169650342858224, 0.03162277660168379, 0.023713737056616554, 0.01778279410038923, 0.01333521432163324, 0.01, 0.007498942093324558, 0.005623413251903491, 0.004216965034285823, 0.0031622776601683794, 0.0023713737056616554, 0.0017782794100389228, 0.001333521432163324, 0.001, 0.0007498942093324559, 0.0005623413251903491, 0.00042169650342858224, 0.00031622776601683794, 0.00023713737056616554, 0.00017782794100389227, 0.0001333521432163324};
constexpr int NWAVES = 8, NTHREADS = 512;
constexpr int PH_PRO = 0, PH_PER_LAYER = 9, PH_FINAL = 1 + DEPTH * PH_PER_LAYER, NPH = PH_FINAL + 1;
enum { P_N1 = 0, P_GIN, P_M1, P_M2, P_M3, P_GOUT, P_N2, P_GGU, P_GDN };

__device__ __forceinline__ void phase_prologue(const Args& a, LAS unsigned char* lds, int bid, int G, int tid) {
    const float* c = a.in[1]; const float* w_ada = a.in[5]; const float* b_ada = a.in[6];
    float* mod = (float*)(a.ws + WS_MOD);
    const int wave = tid >> 6, lane = tid & 63;
    LAS float* cact = (LAS float*)lds;
    LAS float* red = (LAS float*)(lds + 8192);
    for (int i = tid; i < NB * D; i += NTHREADS) { const float v = c[i]; cact[i] = siluf(v); }
    __syncthreads();
    for (int it = bid; it < DEPTH * 24; it += G) {
        const int l = it / 24, j0 = (it % 24) * 256;
        const float* W = w_ada + (size_t)l * D * 6144 + j0 + lane * 4;
        f32x4 a0 = {0.f, 0.f, 0.f, 0.f}, a1 = {0.f, 0.f, 0.f, 0.f};
        const int k0 = wave * 128;
#pragma unroll 8
        for (int k = 0; k < 128; ++k) {
            const f32x4 w = *(const f32x4*)(W + (size_t)(k0 + k) * 6144);
            const float c0 = cact[k0 + k], c1 = cact[D + k0 + k];
            a0 += w * c0; a1 += w * c1;
        }
        __syncthreads();
        *(LAS f32x4*)(red + (wave * 2 + 0) * 256 + lane * 4) = a0;
        *(LAS f32x4*)(red + (wave * 2 + 1) * 256 + lane * 4) = a1;
        __syncthreads();
        {
            const int b = tid >> 8, col = tid & 255;
            float s = 0.f;
#pragma unroll
            for (int w = 0; w < 8; ++w) s += red[(w * 2 + b) * 256 + col];
            mod[((size_t)l * NB + b) * 6144 + j0 + col] = s + b_ada[(size_t)l * 6144 + j0 + col];
        }
    }
    if (bid == G - 1 && tid < 256) {
        const float* hl = a.in[14]; float* lb = (float*)(a.ws + WS_LB);
        const float v0 = hl[tid], v1 = hl[256 + tid], v2 = hl[512 + tid], v3 = hl[768 + tid];
        const float m = fmaxf(fmaxf(v0, v1), fmaxf(v2, v3));
        const float e0 = expf(v0 - m), e1 = expf(v1 - m), e2 = expf(v2 - m), e3 = expf(v3 - m);
        const float inv = 1.f / (e0 + e1 + e2 + e3);
        lb[tid] = 0.f; lb[256 + tid] = e1 * inv; lb[512 + tid] = (e1 + e2) * inv; lb[768 + tid] = (e1 + e2 + e3) * inv;
    }
    {
        float* rope = (float*)(a.ws + WS_ROPE);
        for (int i = bid * NTHREADS + tid; i < L * 32; i += G * NTHREADS) {
            const int p = i >> 5, j = i & 31;
            const double f = c_invf[j];
            double r = (double)p * f * 0.15915494309189535;
            r -= floor(r);
            const float rf = (float)r;
            rope[2 * i] = __builtin_amdgcn_cosf(rf); rope[2 * i + 1] = __builtin_amdgcn_sinf(rf);
        }
    }
}

typedef short n2s8 __attribute__((ext_vector_type(8)));
__device__ __forceinline__ void phase_norm1(const Args& a, int layer, LAS unsigned char* lds, int bid, int G, int wave, int lane, bool rerun = false) {
    const float* xin = a.in[0];
    float* xw = (float*)(a.ws + WS_XW);
    const float* mod = (const float*)(a.ws + WS_MOD);
    bf16* h = (bf16*)(a.ws + WS_H);
    float* dtraw = (float*)(a.ws + WS_DT);
    const bf16* Y = (const bf16*)(a.ws + WS_Y);
    const int* eid = (const int*)(a.ws + WS_EID);
    const int* slot = (const int*)(a.ws + WS_SLOT);
    LAS float* part = (LAS float*)lds;
    LAS float* pdt = (LAS float*)(lds + 512);
    int mybase = 0;
    const bool gather = (layer > 0 && !rerun);
    if (gather) {
        const int* cnt = (const int*)(a.ws + WS_CTL) + CW_CNT + (layer - 1) * NE * CNT_STRIDE;
        int pc = (lane < NE) ? ((cnt[lane * CNT_STRIDE] + 255) & ~255) : 0;
        int run = 0;
#pragma unroll
        for (int i = 0; i < NE; ++i) { mybase = (lane == i) ? run : mybase; run += __builtin_amdgcn_readlane(pc, i); }
    }
    const float* gvec = (layer < DEPTH) ? a.in[2] + (size_t)layer * D : a.in[4];
    const bf16* wdt = (const bf16*)(a.ws + WS_WDT) + (size_t)(layer < DEPTH ? layer : 0) * 2 * 16 * D;
    LAS float* vec = (LAS float*)(lds + 32768);
    const int tile = wave >> 1, kh = wave & 1, t = lane & 15, q = lane >> 4;
    for (int blk = bid; blk < T / 64; blk += G) {
        const int row = blk * 64 + tile * 16 + t, b = row >> 13;
        const int cb = 512 * kh + 8 * q;
        if (layer < DEPTH) {
            const float* mbv = mod + ((size_t)layer * NB + b) * 6144;
            for (int i = wave * 64 + lane; i < D; i += NTHREADS) { vec[i] = gvec[i]; vec[D + i] = mbv[i]; vec[2 * D + i] = mbv[D + i] + 1.f; }
        }
        const float* src = ((layer == 0 && !rerun) ? xin : xw) + (size_t)row * D + cb;
        float* xo = xw + (size_t)row * D + cb;
        const bf16* y0p = Y; const bf16* y1p = Y;
        if (gather) {
            const int e0 = eid[2 * row], e1 = eid[2 * row + 1];
            const int b0 = __builtin_amdgcn_ds_bpermute(e0 << 2, mybase), b1 = __builtin_amdgcn_ds_bpermute(e1 << 2, mybase);
            y0p = Y + (size_t)(b0 + slot[2 * row]) * D + cb; y1p = Y + (size_t)(b1 + slot[2 * row + 1]) * D + cb;
        }
        const float* gf = mod + ((size_t)(layer > 0 ? layer - 1 : 0) * NB + b) * 6144 + 5 * D + cb;
        float ss = 0.f;
#pragma unroll 4
        for (int ks = 0; ks < 16; ++ks) {
            f32x4 x0 = *(const f32x4*)(src + 32 * ks), x1 = *(const f32x4*)(src + 32 * ks + 4);
            if (gather) {
                const u32x4 ya = *(const u32x4*)(y0p + 32 * ks), yb = *(const u32x4*)(y1p + 32 * ks);
                const f32x4 g0 = *(const f32x4*)(gf + 32 * ks), g1 = *(const f32x4*)(gf + 32 * ks + 4);
                x0.x += g0.x * (__uint_as_float(ya.x << 16) + __uint_as_float(yb.x << 16)); x0.y += g0.y * (__uint_as_float(ya.x & 0xffff0000u) + __uint_as_float(yb.x & 0xffff0000u));
                x0.z += g0.z * (__uint_as_float(ya.y << 16) + __uint_as_float(yb.y << 16)); x0.w += g0.w * (__uint_as_float(ya.y & 0xffff0000u) + __uint_as_float(yb.y & 0xffff0000u));
                x1.x += g1.x * (__uint_as_float(ya.z << 16) + __uint_as_float(yb.z << 16)); x1.y += g1.y * (__uint_as_float(ya.z & 0xffff0000u) + __uint_as_float(yb.z & 0xffff0000u));
                x1.z += g1.z * (__uint_as_float(ya.w << 16) + __uint_as_float(yb.w << 16)); x1.w += g1.w * (__uint_as_float(ya.w & 0xffff0000u) + __uint_as_float(yb.w & 0xffff0000u));
            }
            if (layer < DEPTH) { *(f32x4*)(xo + 32 * ks) = x0; *(f32x4*)(xo + 32 * ks + 4) = x1; }
            ss += ((x0.x * x0.x + x0.y * x0.y) + (x0.z * x0.z + x0.w * x0.w)) + ((x1.x * x1.x + x1.y * x1.y) + (x1.z * x1.z + x1.w * x1.w));
        }
        ss += swz_xor<16>(ss); ss += xor32(ss, lane);
        if (q == 0) part[(tile * 2 + kh) * 16 + t] = ss;
        __syncthreads();
        const float rstd = rsqrtf((part[(tile * 2) * 16 + t] + part[(tile * 2 + 1) * 16 + t]) * (1.f / D) + EPS);
        if (layer == DEPTH) {
            float* op = a.out + (size_t)row * D + cb;
#pragma unroll 4
            for (int ks = 0; ks < 16; ++ks) {
                f32x4 x0 = *(const f32x4*)(src + 32 * ks), x1 = *(const f32x4*)(src + 32 * ks + 4);
                {
                    const u32x4 ya = *(const u32x4*)(y0p + 32 * ks), yb = *(const u32x4*)(y1p + 32 * ks);
                    const f32x4 g0 = *(const f32x4*)(gf + 32 * ks), g1 = *(const f32x4*)(gf + 32 * ks + 4);
                    x0.x += g0.x * (__uint_as_float(ya.x << 16) + __uint_as_float(yb.x << 16)); x0.y += g0.y * (__uint_as_float(ya.x & 0xffff0000u) + __uint_as_float(yb.x & 0xffff0000u));
                    x0.z += g0.z * (__uint_as_float(ya.y << 16) + __uint_as_float(yb.y << 16)); x0.w += g0.w * (__uint_as_float(ya.y & 0xffff0000u) + __uint_as_float(yb.y & 0xffff0000u));
                    x1.x += g1.x * (__uint_as_float(ya.z << 16) + __uint_as_float(yb.z << 16)); x1.y += g1.y * (__uint_as_float(ya.z & 0xffff0000u) + __uint_as_float(yb.z & 0xffff0000u));
                    x1.z += g1.z * (__uint_as_float(ya.w << 16) + __uint_as_float(yb.w << 16)); x1.w += g1.w * (__uint_as_float(ya.w & 0xffff0000u) + __uint_as_float(yb.w & 0xffff0000u));
                }
                const f32x4 g0 = *(const f32x4*)(gvec + cb + 32 * ks), g1 = *(const f32x4*)(gvec + cb + 32 * ks + 4);
                *(f32x4*)(op + 32 * ks) = x0 * rstd * g0; *(f32x4*)(op + 32 * ks + 4) = x1 * rstd * g1;
            }
            __syncthreads();
            continue;
        }
        const LAS float* vp = vec + cb;
        bf16* hr = h + (size_t)row * D + cb;
        const bf16* wp = wdt + (size_t)t * D + cb;
        f32x4 acc = {0.f, 0.f, 0.f, 0.f};
#pragma unroll 4
        for (int ks = 0; ks < 16; ++ks) {
            unsigned hi[4], lo[4];
#pragma unroll
            for (int e = 0; e < 2; ++e) {
                const f32x4 g = *(const LAS f32x4*)(vp + 32 * ks + 4 * e), sh = *(const LAS f32x4*)(vp + D + 32 * ks + 4 * e), sc1 = *(const LAS f32x4*)(vp + 2 * D + 32 * ks + 4 * e);
                const f32x4 hv = *(const f32x4*)(xo + 32 * ks + 4 * e) * rstd * g * sc1 + sh;
                const unsigned p01 = pk2(hv.x, hv.y), p23 = pk2(hv.z, hv.w);
                hi[2 * e] = p01; hi[2 * e + 1] = p23;
                lo[2 * e] = pk2(hv.x - __uint_as_float(p01 << 16), hv.y - __uint_as_float(p01 & 0xffff0000u)); lo[2 * e + 1] = pk2(hv.z - __uint_as_float(p23 << 16), hv.w - __uint_as_float(p23 & 0xffff0000u));
            }
            const u32x4 hiv = {hi[0], hi[1], hi[2], hi[3]}, lov = {lo[0], lo[1], lo[2], lo[3]};
            *(u32x4*)(hr + 32 * ks) = hiv;
            const n2s8 Ah = __builtin_bit_cast(n2s8, hiv), Al = __builtin_bit_cast(n2s8, lov);
            const n2s8 Bh = *(const n2s8*)(wp + 32 * ks), Bl = *(const n2s8*)(wp + (size_t)16 * D + 32 * ks);
            acc = __builtin_amdgcn_mfma_f32_16x16x32_bf16(Ah, Bh, acc, 0, 0, 0);
            acc = __builtin_amdgcn_mfma_f32_16x16x32_bf16(Ah, Bl, acc, 0, 0, 0);
            acc = __builtin_amdgcn_mfma_f32_16x16x32_bf16(Al, Bh, acc, 0, 0, 0);
        }
#pragma unroll
        for (int r = 0; r < 4; ++r) pdt[((tile * 2 + kh) * 16 + 4 * q + r) * 16 + t] = acc[r];
        __syncthreads();
        {
            const int tid = wave * 64 + lane, tk = tid >> 3, d = tid & 7, tl = tk >> 4, tt = tk & 15;
            dtraw[(size_t)(blk * 64 + tk) * 8 + d] = pdt[((tl * 2) * 16 + tt) * 16 + d] + pdt[((tl * 2 + 1) * 16 + tt) * 16 + d];
        }
        __syncthreads();
    }
}

__device__ __forceinline__ void phase_norm2(const Args& a, int layer, LAS unsigned char* lds, int bid, int G, int wave, int lane, bool rerun = false) {
    const float* xw = (const float*)(a.ws + WS_XW);
    const float* mod = (const float*)(a.ws + WS_MOD);
    bf16* h = (bf16*)(a.ws + WS_H);
    int* eid = (int*)(a.ws + WS_EID); float* ew = (float*)(a.ws + WS_EW);
    int* slot = (int*)(a.ws + WS_SLOT); int* list = (int*)(a.ws + WS_LIST); float* wl = (float*)(a.ws + WS_WL);
    int* cnt = (int*)(a.ws + WS_CTL) + CW_CNT + layer * NE * CNT_STRIDE;
    const float* gvec = a.in[3] + (size_t)layer * D;
    const float* bg = a.in[18] + layer * 4; const float* be = a.in[20] + layer * NE;
    const bf16* wr = (const bf16*)(a.ws + WS_WR) + (size_t)layer * 2 * 48 * D;
    LAS float* part = (LAS float*)lds;
    LAS float* plog = (LAS float*)(lds + 512);
    LAS int* hist = (LAS int*)(lds + 512 + 4 * 2 * 16 * 48 * 4);
    LAS float* vec = (LAS float*)(lds + 32768);
    const int tile = wave >> 1, kh = wave & 1, t = lane & 15, q = lane >> 4, tid = wave * 64 + lane;
    for (int blk = bid; blk < T / 64; blk += G) {
        const int row = blk * 64 + tile * 16 + t, b = row >> 13;
        {
            const float* mbv = mod + ((size_t)layer * NB + b) * 6144 + 3 * D;
            for (int i = tid; i < D; i += NTHREADS) { vec[i] = gvec[i]; vec[D + i] = mbv[i]; vec[2 * D + i] = mbv[D + i] + 1.f; }
        }
        const float* xr = xw + (size_t)row * D + 512 * kh + 8 * q;
        float ss = 0.f;
#pragma unroll 8
        for (int ks = 0; ks < 16; ++ks) {
            const f32x4 x0 = *(const f32x4*)(xr + 32 * ks), x1 = *(const f32x4*)(xr + 32 * ks + 4);
            ss += ((x0.x * x0.x + x0.y * x0.y) + (x0.z * x0.z + x0.w * x0.w)) + ((x1.x * x1.x + x1.y * x1.y) + (x1.z * x1.z + x1.w * x1.w));
        }
        ss += swz_xor<16>(ss); ss += xor32(ss, lane);
        if (tid < 32) hist[tid] = 0;
        if (q == 0) part[(tile * 2 + kh) * 16 + t] = ss;
        __syncthreads();
        const float rstd = rsqrtf((part[(tile * 2) * 16 + t] + part[(tile * 2 + 1) * 16 + t]) * (1.f / D) + EPS);
        const LAS float* vp = vec + 512 * kh + 8 * q;
        bf16* hr = h + (size_t)row * D + 512 * kh + 8 * q;
        const bf16* wp = wr + (size_t)t * D + 512 * kh + 8 * q;
        f32x4 acc[3] = {{0.f, 0.f, 0.f, 0.f}, {0.f, 0.f, 0.f, 0.f}, {0.f, 0.f, 0.f, 0.f}};
#pragma unroll 4
        for (int ks = 0; ks < 16; ++ks) {
            unsigned hi[4], lo[4];
#pragma unroll
            for (int e = 0; e < 2; ++e) {
                const f32x4 g = *(const LAS f32x4*)(vp + 32 * ks + 4 * e), sh = *(const LAS f32x4*)(vp + D + 32 * ks + 4 * e), sc1 = *(const LAS f32x4*)(vp + 2 * D + 32 * ks + 4 * e);
                const f32x4 hv = *(const f32x4*)(xr + 32 * ks + 4 * e) * rstd * g * sc1 + sh;
                const unsigned p01 = pk2(hv.x, hv.y), p23 = pk2(hv.z, hv.w);
                hi[2 * e] = p01; hi[2 * e + 1] = p23;
                lo[2 * e] = pk2(hv.x - __uint_as_float(p01 << 16), hv.y - __uint_as_float(p01 & 0xffff0000u)); lo[2 * e + 1] = pk2(hv.z - __uint_as_float(p23 << 16), hv.w - __uint_as_float(p23 & 0xffff0000u));
            }
            const u32x4 hiv = {hi[0], hi[1], hi[2], hi[3]}, lov = {lo[0], lo[1], lo[2], lo[3]};
            *(u32x4*)(hr + 32 * ks) = hiv;
            const n2s8 Ah = __builtin_bit_cast(n2s8, hiv), Al = __builtin_bit_cast(n2s8, lov);
#pragma unroll
            for (int nt = 0; nt < 3; ++nt) {
                const n2s8 Bh = *(const n2s8*)(wp + (size_t)(16 * nt) * D + 32 * ks), Bl = *(const n2s8*)(wp + (size_t)(48 + 16 * nt) * D + 32 * ks);
                acc[nt] = __builtin_amdgcn_mfma_f32_16x16x32_bf16(Ah, Bh, acc[nt], 0, 0, 0);
                acc[nt] = __builtin_amdgcn_mfma_f32_16x16x32_bf16(Ah, Bl, acc[nt], 0, 0, 0);
                acc[nt] = __builtin_amdgcn_mfma_f32_16x16x32_bf16(Al, Bh, acc[nt], 0, 0, 0);
            }
        }
#pragma unroll
        for (int nt = 0; nt < 3; ++nt)
#pragma unroll
            for (int r = 0; r < 4; ++r) plog[((tile * 2 + kh) * 16 + 4 * q + r) * 48 + 16 * nt + t] = acc[nt][r];
        __syncthreads();
        int e0 = 0, e1 = 0, r0 = 0, r1 = 0; float w0 = 0.f, w1 = 0.f;
        const bool router = (kh == 0 && lane < 16 && !rerun);
        const int rrow = blk * 64 + tile * 16 + lane;
        if (router) {
            const LAS float* p0 = plog + ((tile * 2) * 16 + lane) * 48; const LAS float* p1 = p0 + 16 * 48;
            float lg[4];
#pragma unroll
            for (int i = 0; i < 4; ++i) lg[i] = p0[32 + i] + p1[32 + i] + bg[i];
            int gi = 0; float gm = lg[0];
#pragma unroll
            for (int i = 1; i < 4; ++i) if (lg[i] > gm) { gm = lg[i]; gi = i; }
            float se = 0.f;
#pragma unroll
            for (int i = 0; i < 4; ++i) se += expf(lg[i] - gm);
            const float pg = 1.f / se;
            float ig[8];
#pragma unroll
            for (int i = 0; i < 8; ++i) ig[i] = p0[gi * 8 + i] + p1[gi * 8 + i] + be[gi * 8 + i];
            int i0 = 0; float v0 = ig[0];
#pragma unroll
            for (int i = 1; i < 8; ++i) if (ig[i] > v0) { v0 = ig[i]; i0 = i; }
            int i1 = -1; float v1 = -3.0e38f;
#pragma unroll
            for (int i = 0; i < 8; ++i) if (i != i0 && ig[i] > v1) { v1 = ig[i]; i1 = i; }
            const float ex = expf(v1 - v0);
            w0 = pg / (1.f + ex); w1 = pg * ex / (1.f + ex);
            e0 = gi * 8 + i0; e1 = gi * 8 + i1;
            r0 = __hip_atomic_fetch_add(&hist[e0], 1, __ATOMIC_RELAXED, __HIP_MEMORY_SCOPE_WORKGROUP); r1 = __hip_atomic_fetch_add(&hist[e1], 1, __ATOMIC_RELAXED, __HIP_MEMORY_SCOPE_WORKGROUP);
        }
        __syncthreads();
        if (tid < 32) { const int c = hist[tid]; hist[32 + tid] = c ? atomicAdd(&cnt[tid * CNT_STRIDE], c) : 0; }
        __syncthreads();
        if (router) {
            const int s0 = hist[32 + e0] + r0, s1 = hist[32 + e1] + r1;
            eid[2 * rrow] = e0; eid[2 * rrow + 1] = e1; ew[2 * rrow] = w0; ew[2 * rrow + 1] = w1; slot[2 * rrow] = s0; slot[2 * rrow + 1] = s1;
            list[(size_t)e0 * T + s0] = rrow; wl[(size_t)e0 * T + s0] = w0; list[(size_t)e1 * T + s1] = rrow; wl[(size_t)e1 * T + s1] = w1;
        }
        __syncthreads();
    }
}

#define XB_TMO      128
#define XB_XCNT(j)  (256  + 64 * (j))
#define XB_XSUB(j)  (1280 + 64 * (j))
#define XB_XGEN(j)  (2304 + 64 * (j))
#define XB_TOP      3328
#define XB_TOPGEN   3392
#define XCD_BAR_WORDS 3456
#define XB_SPIN_CAP (1u << 18)

__device__ __forceinline__ unsigned xb_ld(unsigned* p)              { return __hip_atomic_load(p, __ATOMIC_RELAXED, __HIP_MEMORY_SCOPE_AGENT); }
__device__ __forceinline__ unsigned xb_add(unsigned* p, unsigned v) { return __hip_atomic_fetch_add(p, v, __ATOMIC_RELAXED, __HIP_MEMORY_SCOPE_AGENT); }
__device__ __forceinline__ unsigned xb_xcc_id() { return (unsigned)__builtin_amdgcn_s_getreg((3 << 11) | 20) & 0xFu; }
#define XB_SPIN(cond, bar) do { unsigned _sp = 0; while (cond) { __builtin_amdgcn_s_sleep(1); \
    if ((++_sp & 255u) == 0u) { if (xb_ld(&(bar)[XB_TMO])) break; if (_sp > XB_SPIN_CAP) { atomicAdd(&(bar)[XB_TMO], 1u); break; } } } } while (0)

struct XcdBarrier {
    unsigned* bar; unsigned x;
    volatile LAS unsigned* st;
};

__device__ __forceinline__ XcdBarrier xcd_barrier_post(unsigned* bar, volatile LAS unsigned* st) {
    XcdBarrier b; b.bar = bar; b.x = xb_xcc_id(); b.st = st;
    if (threadIdx.x == 0) (void)xb_add(&bar[XB_XCNT(b.x)], 1u);
    return b;
}
__device__ __forceinline__ void xcd_barrier_complete(unsigned* bar, unsigned x, unsigned& nloc, unsigned& nx) {
    const unsigned G = gridDim.x * gridDim.y * gridDim.z;
    unsigned sum, cnt, mine, sp = 0u;
    for (;;) {
        sum = 0u; cnt = 0u; mine = 0u;
#pragma unroll
        for (unsigned j = 0; j < 16; ++j) { const unsigned c = xb_ld(&bar[XB_XCNT(j)]); sum += c; cnt += (c > 0u) ? 1u : 0u; mine = (j == x) ? c : mine; }
        if (sum == G) break;
        __builtin_amdgcn_s_sleep(1);
        if ((++sp & 255u) == 0u) { if (xb_ld(&bar[XB_TMO])) break; if (sp > XB_SPIN_CAP) { atomicAdd(&bar[XB_TMO], 1u); break; } }
    }
    nloc = mine > 0u ? mine : 1u; nx = cnt > 0u ? cnt : 1u;
}

__device__ __forceinline__ void xcd_barrier(const XcdBarrier& b) {
    asm volatile("s_waitcnt vmcnt(0)" ::: "memory");
    __syncthreads();
    if (threadIdx.x == 0) {
        unsigned* bar = b.bar;
        __builtin_amdgcn_s_waitcnt(0);
        unsigned nloc = b.st[0], nx = b.st[1];
        if (nloc == 0u) { xcd_barrier_complete(bar, b.x, nloc, nx); b.st[0] = nloc; b.st[1] = nx; }
        const unsigned old = xb_add(&bar[XB_XSUB(b.x)], 1u);
        const unsigned gen = old / nloc;
        if (old + 1u == (gen + 1u) * nloc) {
            __builtin_amdgcn_fence(__ATOMIC_RELEASE, "agent");
            asm volatile("s_waitcnt vmcnt(0)" ::: "memory");
            const unsigned og = xb_add(&bar[XB_TOP], 1u);
            const unsigned tg = og / nx;
            if (og + 1u == (tg + 1u) * nx) xb_add(&bar[XB_TOPGEN], 1u);
            else XB_SPIN(xb_ld(&bar[XB_TOPGEN]) == tg, bar);
            __builtin_amdgcn_fence(__ATOMIC_ACQUIRE, "agent");
            xb_add(&bar[XB_XGEN(b.x)], 1u);
            asm volatile("s_waitcnt vmcnt(0)" ::: "memory");
        } else {
            XB_SPIN(xb_ld(&bar[XB_XGEN(b.x)]) == gen, bar);
            __builtin_amdgcn_fence(__ATOMIC_ACQUIRE, "agent");
            asm volatile("s_waitcnt vmcnt(0)" ::: "memory");
        }
    }
    __syncthreads();
}

namespace pg8 {
typedef unsigned short bf16_t;
typedef short bf16x8 __attribute__((ext_vector_type(8)));
constexpr int BM = 256, BK = 64, HALF = 128, HTB = HALF * BK * 2  , STAGE_BYTES = 8 * HTB, NXCD = 8, WGM = 8;

__host__ __device__ __forceinline__ int lds_byte(int r, int c) { const int st = (r >> 4) * 2 + (c >> 5), rr = r & 15, cc = c & 31, ob = rr * 64 + cc * 2; return st * 1024 + (ob ^ (((ob >> 9) & 1) << 5)); }
__host__ __device__ __forceinline__ void stage_rc(int b, int& R, int& C) { const int st = b / 1024, sb = b % 1024, swz = sb ^ (((sb >> 9) & 1) << 5); R = (st >> 1) * 16 + swz / 64; C = (st & 1) * 32 + (swz % 64) / 2; }
__host__ __device__ __forceinline__ int perm32(int rho) { const int n = rho >> 4, i = rho & 15; return 8 * (i >> 2) + 4 * n + (i & 3); }

struct Unit { int pm, pn, e, lu; };
struct Gemm { const bf16_t* A; const bf16_t* Bt; int K; size_t strideB; };

struct StaticOrder {
    int nM, nN, nwg, G, c;
    __host__ __device__ void init(int M, int N, int G_, int c_) { nM = M / BM; nN = N / BM; nwg = nM * nN; G = G_; c = c_; }
    __host__ __device__ bool next(int i, Unit& u) const {
        const long L = (long)i * G + c; if (L >= nwg) return false;
        int wgid = (int)L; { const int q = nwg / NXCD, r = nwg % NXCD, xcd = wgid % NXCD, off = wgid / NXCD; wgid = (xcd < r ? xcd * (q + 1) : r * (q + 1) + (xcd - r) * q) + off; }
        const int nig = WGM * nN, gid = wgid / nig, fm = gid * WGM, gsz = (nM - fm) < WGM ? (nM - fm) : WGM;
        u.pm = fm + ((wgid % nig) % gsz); u.pn = (wgid % nig) / gsz; u.e = 0; u.lu = 0; return true;
    }
};
struct GroupOrder {
    const LAS int* tstart; int NT, total, G, c;
    __device__ __forceinline__ bool next(int i, Unit& u) const {
        const int Lx = i * G + c; if (Lx >= total) return false;
        const int PM = Lx / NT; u.pn = Lx - PM * NT; u.pm = PM;
        int e = 0; while (__builtin_amdgcn_readfirstlane(tstart[e + 1]) <= PM) ++e;
        u.e = e; u.lu = i; return true;
    }
};

__device__ __forceinline__ unsigned cvt_pk_bf16(float lo, float hi) { unsigned r; asm volatile("v_cvt_pk_bf16_f32 %0, %1, %2" : "=v"(r) : "v"(lo), "v"(hi)); return r; }

struct EpiStoreBf16 {
    static constexpr bool PERM = true;
    bf16_t* O; int ldc;
    __device__ __forceinline__ void operator()(const f32x4 (&acc)[2][2][4][2], const Unit& u, int wr, int wc, int fr, int fq) const {
        const int row0 = u.pm * BM + wr * 64 + fr, col0 = u.pn * BM + wc * 32 + 8 * fq;
#pragma unroll
        for (int ai = 0; ai < 2; ++ai)
#pragma unroll
            for (int m = 0; m < 4; ++m) { bf16_t* rowp = O + (size_t)(row0 + ai * HALF + m * 16) * ldc + col0;
#pragma unroll
                for (int bj = 0; bj < 2; ++bj) { const f32x4 v0 = acc[ai][bj][m][0], v1 = acc[ai][bj][m][1];
                    u32x4 w; w.x = cvt_pk_bf16(v0[0], v0[1]); w.y = cvt_pk_bf16(v0[2], v0[3]); w.z = cvt_pk_bf16(v1[0], v1[1]); w.w = cvt_pk_bf16(v1[2], v1[3]);
                    *(u32x4*)(rowp + bj * HALF) = w; } }
    }
};
struct EpiResid {
    static constexpr bool PERM = false;
    float* X; const float* gate;
    __device__ __forceinline__ void operator()(const f32x4 (&acc)[2][2][4][2], const Unit& u, int wr, int wc, int fr, int fq) const {
        const int row0 = u.pm * BM + wr * 64 + fr, col0 = u.pn * BM + wc * 32 + 4 * fq;
        const int b = (u.pm * BM) >> 13;
        f32x4 gv[2][2];
#pragma unroll
        for (int bj = 0; bj < 2; ++bj)
#pragma unroll
            for (int n = 0; n < 2; ++n) gv[bj][n] = *(const f32x4*)(gate + (size_t)b * 6144 + col0 + bj * HALF + n * 16);
#pragma unroll
        for (int ai = 0; ai < 2; ++ai)
#pragma unroll
            for (int m = 0; m < 4; ++m) { float* rowp = X + (size_t)(row0 + ai * HALF + m * 16) * D + col0; f32x4 xv[2][2];
#pragma unroll
                for (int bj = 0; bj < 2; ++bj)
#pragma unroll
                    for (int n = 0; n < 2; ++n) xv[bj][n] = *(const f32x4*)(rowp + bj * HALF + n * 16);
#pragma unroll
                for (int bj = 0; bj < 2; ++bj)
#pragma unroll
                    for (int n = 0; n < 2; ++n) *(f32x4*)(rowp + bj * HALF + n * 16) = xv[bj][n] + gv[bj][n] * acc[ai][bj][m][n]; }
    }
};
struct EpiGU {
    static constexpr bool PERM = true;
    bf16_t* H; const LAS float* tabw;
    __device__ __forceinline__ void operator()(const f32x4 (&acc)[2][2][4][2], const Unit& u, int wr, int wc, int fr, int fq) const {
#pragma unroll
        for (int ai = 0; ai < 2; ++ai)
#pragma unroll
            for (int m = 0; m < 4; ++m) {
                const int rl = ai * HALF + wr * 64 + m * 16 + fr;
                const float w = tabw[u.lu * 256 + rl];
                bf16_t* rowp = H + (size_t)(u.pm * BM + rl) * DE + u.pn * HALF + wc * 32 + 8 * fq;
                float o[8];
#pragma unroll
                for (int n = 0; n < 2; ++n)
#pragma unroll
                    for (int j = 0; j < 4; ++j) { const float g = acc[ai][0][m][n][j], up = acc[ai][1][m][n][j]; o[n * 4 + j] = g * __builtin_amdgcn_rcpf(1.f + __builtin_amdgcn_exp2f(-1.4426950408889634f * g)) * up * w; }
                u32x4 wv; wv.x = cvt_pk_bf16(o[0], o[1]); wv.y = cvt_pk_bf16(o[2], o[3]); wv.z = cvt_pk_bf16(o[4], o[5]); wv.w = cvt_pk_bf16(o[6], o[7]);
                *(u32x4*)rowp = wv;
            }
    }
};

template <class Epi, class Sched, bool GATHER, bool ALIGN_EPI>
__device__ __forceinline__ void gemm_phase(LAS unsigned char* lds, const Gemm g, const Sched& S, const Epi& E, const LAS unsigned* taboff, int wave_id) {
    int lane = __builtin_amdgcn_mbcnt_hi(~0u, __builtin_amdgcn_mbcnt_lo(~0u, 0u)); asm volatile("" : "+v"(lane));
    const int wid = wave_id, tid = wid * 64 + lane, wr = wid >> 2, wc = wid & 3, fr = lane & 15, fq = lane >> 4;
    const int K = g.K, nt = K / BK;
    unsigned voffA[2], voffB[2]; int RA[2]; unsigned cA2[2];
#pragma unroll
    for (int i = 0; i < 2; ++i) { int R, C; stage_rc(tid * 16 + i * 8192, R, C); const int Rb = Epi::PERM ? ((R & ~31) + perm32(R & 31)) : R;
        voffA[i] = (unsigned)(R * K + C) * 2u; voffB[i] = (unsigned)(Rb * K + C) * 2u; RA[i] = R; cA2[i] = (unsigned)C * 2u; }
    const size_t kstep = (size_t)(BK * 2);
    const size_t hstep = (size_t)HALF * K * 2;
    const size_t tstep = 2 * hstep;
    const unsigned ldsw = (unsigned)wid * 1024u;
    const int aoff = lds_byte(wr * 64 + fr, fq * 8), boff = lds_byte(wc * 32 + fr, fq * 8);
#define PG8_SA(b, h) (((b) * 2 + (h)) * HTB)
#define PG8_SB(b, h) ((4 + (b) * 2 + (h)) * HTB)
#define PG8_STAGE(bufoff, gbase, voff) do { _Pragma("unroll") for (int _i = 0; _i < 2; ++_i) \
        __builtin_amdgcn_global_load_lds((const unsigned*)((const char*)(gbase) + (voff)[_i]), (LAS unsigned*)(lds + (bufoff) + ldsw + _i * 8192), 16, 0, 0); } while (0)
#define PG8_STAGE_A(bufoff, ap, h, GO) do { if constexpr (GATHER) { PG8_STAGE(bufoff, ap, (GO)[h]); } else { PG8_STAGE(bufoff, (ap) + (h) * hstep, voffA); } } while (0)
#define PG8_LDA(dst, b, h) do { _Pragma("unroll") for (int m = 0; m < 4; ++m) _Pragma("unroll") for (int k = 0; k < 2; ++k) dst[m][k] = *(const LAS bf16x8*)(lds + PG8_SA(b, h) + aoff + m * 2048 + k * 1024); } while (0)
#define PG8_LDB(dst, b, h) do { _Pragma("unroll") for (int n = 0; n < 2; ++n) _Pragma("unroll") for (int k = 0; k < 2; ++k) dst[n][k] = *(const LAS bf16x8*)(lds + PG8_SB(b, h) + boff + n * 2048 + k * 1024); } while (0)
#define PG8_MMA(ai, bj, At, Bt) do { __builtin_amdgcn_s_setprio(1); _Pragma("unroll") for (int m = 0; m < 4; ++m) _Pragma("unroll") for (int n = 0; n < 2; ++n) _Pragma("unroll") for (int k = 0; k < 2; ++k) \
        acc[ai][bj][m][n] = __builtin_amdgcn_mfma_f32_16x16x32_bf16(Bt[n][k], At[m][k], acc[ai][bj][m][n], 0, 0, 0); __builtin_amdgcn_s_setprio(0); } while (0)
#define PG8_WAIT_V(n) asm volatile("s_waitcnt vmcnt(" #n ")" ::: "memory")
#define PG8_WAIT_L(n) asm volatile("s_waitcnt lgkmcnt(" #n ")" ::: "memory")
#define PG8_BAR __builtin_amdgcn_s_barrier()
#define PG8_SCHED __builtin_amdgcn_sched_barrier(0)
#define PG8_GOLOAD(dst, un) do { _Pragma("unroll") for (int _h = 0; _h < 2; ++_h) _Pragma("unroll") for (int _i = 0; _i < 2; ++_i) dst[_h][_i] = taboff[(un).lu * 256 + _h * HALF + RA[_i]] + cA2[_i]; } while (0)
    Unit cur, nxt; int ui = 0;
    if (!S.next(0, cur)) return;
    f32x4 acc[2][2][4][2];
#pragma unroll
    for (int a = 0; a < 2; ++a)
#pragma unroll
        for (int b = 0; b < 2; ++b)
#pragma unroll
            for (int m = 0; m < 4; ++m)
#pragma unroll
                for (int n = 0; n < 2; ++n) acc[a][b][m][n] = (f32x4){0.f, 0.f, 0.f, 0.f};
    bf16x8 At[4][2], B0[2][2], B1[2][2];
    unsigned goC[2][2] = {{0u, 0u}, {0u, 0u}}, goN[2][2] = {{0u, 0u}, {0u, 0u}};
    const char* cA = GATHER ? (const char*)g.A : (const char*)g.A + (size_t)cur.pm * tstep;
    const char* cB = (const char*)g.Bt + (size_t)cur.e * g.strideB + (size_t)cur.pn * tstep;
    if constexpr (GATHER) { PG8_GOLOAD(goC, cur); PG8_WAIT_L(0); }
    PG8_STAGE(PG8_SB(0, 0), cB, voffB); PG8_STAGE(PG8_SB(0, 1), cB + hstep, voffB); PG8_STAGE_A(PG8_SA(0, 0), cA, 0, goC); PG8_STAGE_A(PG8_SA(0, 1), cA, 1, goC);
    if (wr == 1) PG8_BAR;
    PG8_WAIT_V(2); PG8_BAR;
    PG8_STAGE(PG8_SB(1, 0), cB + kstep, voffB); PG8_STAGE_A(PG8_SA(1, 0), cA + kstep, 0, goC); PG8_STAGE(PG8_SB(1, 1), cB + hstep + kstep, voffB);
    PG8_WAIT_V(6); PG8_BAR;
    for (;;) {
        const bool has_next = S.next(ui + 1, nxt);
        const char* nA = GATHER ? (const char*)g.A : (has_next ? (const char*)g.A + (size_t)nxt.pm * tstep : cA);
        const char* nB = has_next ? (const char*)g.Bt + (size_t)nxt.e * g.strideB + (size_t)nxt.pn * tstep : cB;
        if constexpr (GATHER) {
            if (has_next) { PG8_GOLOAD(goN, nxt); }
            else {
#pragma unroll
                for (int _h = 0; _h < 2; ++_h)
#pragma unroll
                    for (int _i = 0; _i < 2; ++_i) goN[_h][_i] = goC[_h][_i];
            }
        }
#pragma unroll 1
        for (int t = 0; t < nt; t += 2) {
            const bool last = (t == nt - 2);
            const char* a1 = cA + (size_t)(t + 1) * kstep;
            const char* a2 = last ? nA : cA + (size_t)(t + 2) * kstep; const char* b2 = last ? nB : cB + (size_t)(t + 2) * kstep;
            const char* a3 = a2 + kstep; const char* b3 = b2 + kstep;
            unsigned go2[2][2];
#pragma unroll
            for (int _h = 0; _h < 2; ++_h)
#pragma unroll
                for (int _i = 0; _i < 2; ++_i) go2[_h][_i] = last ? goN[_h][_i] : goC[_h][_i];
            PG8_LDB(B0, 0, 0); PG8_LDB(B1, 0, 1); PG8_SCHED; PG8_LDA(At, 0, 0); PG8_STAGE_A(PG8_SA(1, 1), a1, 1, goC);
            PG8_WAIT_V(8); PG8_WAIT_L(0); PG8_BAR; PG8_MMA(0, 0, At, B0); PG8_MMA(0, 1, At, B1); PG8_BAR; PG8_SCHED;
            PG8_LDA(At, 0, 1); PG8_STAGE(PG8_SB(0, 0), b2, voffB); PG8_STAGE(PG8_SB(0, 1), b2 + hstep, voffB); PG8_STAGE_A(PG8_SA(0, 0), a2, 0, go2);
            PG8_WAIT_V(8); PG8_WAIT_L(0); PG8_BAR; PG8_MMA(1, 0, At, B0); PG8_MMA(1, 1, At, B1); PG8_BAR; PG8_SCHED;
            PG8_LDB(B0, 1, 0); PG8_LDB(B1, 1, 1); PG8_SCHED; PG8_LDA(At, 1, 0); PG8_STAGE_A(PG8_SA(0, 1), a2, 1, go2);
            PG8_WAIT_V(8); PG8_WAIT_L(0); PG8_BAR; PG8_MMA(0, 0, At, B0); PG8_MMA(0, 1, At, B1); PG8_BAR; PG8_SCHED;
            PG8_LDA(At, 1, 1); PG8_STAGE(PG8_SB(1, 0), b3, voffB); PG8_STAGE(PG8_SB(1, 1), b3 + hstep, voffB); PG8_STAGE_A(PG8_SA(1, 0), a3, 0, go2);
            PG8_WAIT_V(8); PG8_WAIT_L(0); PG8_BAR; PG8_MMA(1, 0, At, B0); PG8_MMA(1, 1, At, B1); PG8_BAR; PG8_SCHED;
        }
        if constexpr (ALIGN_EPI) { if (wr == 0) PG8_BAR; }
        E(acc, cur, wr, wc, fr, fq);
        if (!has_next) break;
#pragma unroll
        for (int a = 0; a < 2; ++a)
#pragma unroll
            for (int b = 0; b < 2; ++b)
#pragma unroll
                for (int m = 0; m < 4; ++m)
#pragma unroll
                    for (int n = 0; n < 2; ++n) acc[a][b][m][n] = (f32x4){0.f, 0.f, 0.f, 0.f};
        cur = nxt; cA = nA; cB = nB; ++ui;
#pragma unroll
        for (int _h = 0; _h < 2; ++_h)
#pragma unroll
            for (int _i = 0; _i < 2; ++_i) goC[_h][_i] = goN[_h][_i];
        if constexpr (ALIGN_EPI) { if (wr == 1) PG8_BAR; }
    }
    PG8_WAIT_V(0);
    if constexpr (!ALIGN_EPI) { if (wr == 0) PG8_BAR; }
    PG8_BAR;
#undef PG8_SA
#undef PG8_SB
#undef PG8_STAGE
#undef PG8_STAGE_A
#undef PG8_LDA
#undef PG8_LDB
#undef PG8_MMA
#undef PG8_WAIT_V
#undef PG8_WAIT_L
#undef PG8_BAR
#undef PG8_SCHED
#undef PG8_GOLOAD
}
}

__device__ __forceinline__ void cvt_tile(const float* Wsrc, int ldn, bf16* dst, int Kd, LAS float* scr, int lane) {
#pragma unroll 8
    for (int i = 0; i < 32; ++i) { const int kk = 2 * i + (lane >> 5); scr[kk * 33 + (lane & 31)] = Wsrc[(size_t)kk * ldn + (lane & 31)]; }
    asm volatile("s_waitcnt lgkmcnt(0)" ::: "memory");
    const int c = lane & 7;
#pragma unroll
    for (int j = 0; j < 4; ++j) { const int n = (lane >> 3) + 8 * j; const LAS float* s = scr + (8 * c) * 33 + n;
        u32x4 o; o.x = pk2(s[0 * 33], s[1 * 33]); o.y = pk2(s[2 * 33], s[3 * 33]); o.z = pk2(s[4 * 33], s[5 * 33]); o.w = pk2(s[6 * 33], s[7 * 33]);
        *(u32x4*)(dst + (size_t)n * Kd + 8 * c) = o; }
    asm volatile("s_waitcnt lgkmcnt(0)" ::: "memory");
}
constexpr int CV_IN = 16 * 104, CV_OUT = 16 * 32, CV_GU = NE * 256, CV_DN = NE * 128, CV_LAYER = CV_IN + CV_OUT + CV_GU + CV_DN;
__device__ __forceinline__ void cvt_item(const Args& a, int l, int r, LAS float* scr, int lane) {
    if (r < CV_IN) {
        const int kb = r / 104, nb = r % 104, nd = nb * 32, ns = nd + (nd >= R_DT ? 8 : 0);
        cvt_tile(a.in[7] + (size_t)l * D * DIN + (size_t)kb * 64 * DIN + ns, DIN, (bf16*)(a.ws + WS_WIN) + (size_t)l * NP * D + (size_t)nd * D + kb * 64, D, scr, lane); return; }
    r -= CV_IN;
    if (r < CV_OUT) {
        const int kb = r / 32, nb = r % 32;
        cvt_tile(a.in[16] + (size_t)l * D * D + (size_t)kb * 64 * D + nb * 32, D, (bf16*)(a.ws + WS_WOUT) + (size_t)l * D * D + (size_t)nb * 32 * D + kb * 64, D, scr, lane); return; }
    r -= CV_OUT;
    if (r < CV_GU) {
        const int e = r / 256, q = r % 256, kb = q / 16, nb = q % 16, pn = nb / 8, half = (nb % 8) / 4, i0 = (nb % 4) * 32;
        const float* W = (half ? a.in[22] : a.in[21]) + ((size_t)l * NE + e) * D * DE;
        cvt_tile(W + (size_t)kb * 64 * DE + pn * 128 + i0, DE, (bf16*)(a.ws + WS_WGU) + ((size_t)l * NE + e) * 512 * D + (size_t)nb * 32 * D + kb * 64, D, scr, lane); return; }
    r -= CV_GU;
    {
        const int e = r / 128, q = r % 128, kb = q / 32, nb = q % 32;
        const float* W = a.in[23] + ((size_t)l * NE + e) * DE * D;
        cvt_tile(W + (size_t)kb * 64 * D + nb * 32, D, (bf16*)(a.ws + WS_WD) + ((size_t)l * NE + e) * D * DE + (size_t)nb * 32 * DE + kb * 64, DE, scr, lane);
    }
}
__device__ __forceinline__ void convert_router(const Args& a, int gtid, int gthreads) {
    bf16* wr = (bf16*)(a.ws + WS_WR);
    for (int i = gtid; i < DEPTH * 48 * D; i += gthreads) {
        const int l = i / (48 * D), n = (i / D) % 48, k = i % D;
        float w = 0.f;
        if (n < 32) w = a.in[19][((size_t)l * D + k) * NE + n]; else if (n < 36) w = a.in[17][((size_t)l * D + k) * 4 + (n - 32)];
        const unsigned hi = f2bf(w);
        wr[((size_t)l * 2 * 48 + n) * D + k] = (bf16)hi;
        wr[((size_t)l * 2 * 48 + 48 + n) * D + k] = (bf16)f2bf(w - __uint_as_float(hi << 16));
    }
}
__device__ __forceinline__ void convert_dt(const Args& a, int gtid, int gthreads) {
    bf16* wd = (bf16*)(a.ws + WS_WDT);
    for (int i = gtid; i < DEPTH * 16 * D; i += gthreads) {
        const int l = i / (16 * D), n = (i / D) % 16, k = i % D;
        const float w = (n < 8) ? a.in[7][((size_t)l * D + k) * DIN + R_DT + n] : 0.f;
        const unsigned hi = f2bf(w);
        wd[((size_t)l * 2 * 16 + n) * D + k] = (bf16)hi;
        wd[((size_t)l * 2 * 16 + 16 + n) * D + k] = (bf16)f2bf(w - __uint_as_float(hi << 16));
    }
}
constexpr int CW_CVCTR = 4096;
constexpr int CV_TOTAL = DEPTH * CV_LAYER;
constexpr int CV_QUOTA_IN = 3, CV_QUOTA_GU = 3, CV_QUOTA_DN = 1;
__device__ __forceinline__ int cv_need_out(int l) { return l * CV_LAYER + CV_IN + CV_OUT; }
__device__ __forceinline__ int cv_need_dn(int l) { return (l + 1) * CV_LAYER; }
__device__ __forceinline__ void cvt_pull(const Args& a, LAS unsigned char* lds, int wave, int lane, int upto, int quota) {
    int* ctr = (int*)(a.ws + WS_CTL) + CW_CVCTR;
    LAS float* scr = (LAS float*)(lds + LDS_STAGE + 32768 + wave * 8704);
    volatile LAS int* slot = (volatile LAS int*)(lds + LDS_MISC + 32);
    for (int n = 0; n < quota; ++n) {
        if (wave == 0 && lane == 0) {
            int base = CV_TOTAL;
            if (__hip_atomic_load(ctr, __ATOMIC_RELAXED, __HIP_MEMORY_SCOPE_AGENT) < upto) base = atomicAdd(ctr, 16);
            *slot = base;
        }
        __syncthreads();
        const int base = __builtin_amdgcn_readfirstlane(*slot);
        __syncthreads();
        if (base >= CV_TOTAL) break;
#pragma unroll 1
        for (int i = 0; i < 2; ++i) { const int it = base + wave * 2 + i; if (it < CV_TOTAL) cvt_item(a, it / CV_LAYER, it % CV_LAYER, scr, lane); }
    }
}
__device__ __forceinline__ void cvt_ensure(const Args& a, LAS unsigned char* lds, int wave, int lane, int upto) { cvt_pull(a, lds, wave, lane, upto, 1 << 30); __syncthreads(); }
__device__ __forceinline__ void phase_convert(const Args& a, LAS unsigned char* lds, int gw, int ngw, int wave, int lane) {
    convert_router(a, gw * 64 + lane, ngw * 64);
    convert_dt(a, gw * 64 + lane, ngw * 64);
    cvt_ensure(a, lds, wave, lane, cv_need_out(0));
}

__device__ __forceinline__ void phase_gemm_in(const Args& a, int layer, LAS unsigned char* lds, int G, int bid, int wave) {
    pg8::Gemm g{(const bf16*)(a.ws + WS_H), (const bf16*)(a.ws + WS_WIN) + (size_t)layer * NP * D, D, 0};
    pg8::StaticOrder S; S.init(T, NP, G, bid);
    pg8::EpiStoreBf16 E{(bf16*)(a.ws + WS_PROJ), NP};
    pg8::gemm_phase<pg8::EpiStoreBf16, pg8::StaticOrder, false, true>(lds + LDS_STAGE, g, S, E, nullptr, wave);
    if ((S.nwg - bid + G - 1) / G < (S.nwg + G - 1) / G) { int ln = __builtin_amdgcn_mbcnt_hi(~0u, __builtin_amdgcn_mbcnt_lo(~0u, 0u)); cvt_pull(a, lds, wave, ln, CV_TOTAL, CV_QUOTA_IN); }
}
__device__ __forceinline__ void phase_gemm_out(const Args& a, int layer, LAS unsigned char* lds, int G, int bid, int wave) {
    pg8::Gemm g{(const bf16*)(a.ws + WS_MIXED), (const bf16*)(a.ws + WS_WOUT) + (size_t)layer * D * D, D, 0};
    pg8::StaticOrder S; S.init(T, D, G, bid);
    pg8::EpiResid E{(float*)(a.ws + WS_XW), (const float*)(a.ws + WS_MOD) + (size_t)layer * NB * 6144 + 2 * D};
    pg8::gemm_phase<pg8::EpiResid, pg8::StaticOrder, false, false>(lds + LDS_STAGE, g, S, E, nullptr, wave);
}
__device__ __forceinline__ void build_tstart(const int* cnt, LAS int* tstart, int tid) {
    if (tid == 0) { int s = 0; for (int e = 0; e < NE; ++e) { tstart[e] = s; s += (cnt[e * CNT_STRIDE] + 255) >> 8; } tstart[NE] = s; }
    __syncthreads();
}
constexpr int MAXU = 4;
__device__ __forceinline__ void phase_gemm_gu(const Args& a, int layer, LAS unsigned char* lds, int G, int bid, int tid, int wave) {
    const int* cnt = (const int*)(a.ws + WS_CTL) + CW_CNT + layer * NE * CNT_STRIDE;
    LAS int* tstart = (LAS int*)(lds + LDS_TSTART);
    LAS unsigned* taboff = (LAS unsigned*)(lds + LDS_TAB);
    LAS float* tabw = (LAS float*)(lds + LDS_TAB + MAXU * 1024);
    build_tstart(cnt, tstart, tid);
    pg8::GroupOrder S{tstart, 2, __builtin_amdgcn_readfirstlane(tstart[NE]) * 2, G, bid};
    const int* list = (const int*)(a.ws + WS_LIST); const float* wl = (const float*)(a.ws + WS_WL);
    for (int i = 0; i < MAXU; ++i) {
        pg8::Unit u;
        if (!S.next(i, u)) break;
        if (tid < 256) {
            const int slot = (u.pm - tstart[u.e]) * 256 + tid;
            const bool v = slot < cnt[u.e * CNT_STRIDE];
            const int tok = v ? list[(size_t)u.e * T + slot] : 0;
            taboff[i * 256 + tid] = (unsigned)tok * (unsigned)(D * 2);
            tabw[i * 256 + tid] = v ? wl[(size_t)u.e * T + slot] : 0.f;
        }
    }
    __syncthreads();
    pg8::Gemm g{(const bf16*)(a.ws + WS_H), (const bf16*)(a.ws + WS_WGU) + (size_t)layer * NE * 512 * D, D, (size_t)512 * D * 2};
    pg8::EpiGU E{(bf16*)(a.ws + WS_HID), tabw};
    pg8::gemm_phase<pg8::EpiGU, pg8::GroupOrder, true, true>(lds + LDS_STAGE, g, S, E, taboff, wave);
    if ((S.total - bid + G - 1) / G < (S.total + G - 1) / G) { int ln = __builtin_amdgcn_mbcnt_hi(~0u, __builtin_amdgcn_mbcnt_lo(~0u, 0u)); cvt_pull(a, lds, wave, ln, CV_TOTAL, CV_QUOTA_GU); }
}
__device__ __forceinline__ void phase_gemm_dn(const Args& a, int layer, LAS unsigned char* lds, int G, int bid, int tid, int wave) {
    const int* cnt = (const int*)(a.ws + WS_CTL) + CW_CNT + layer * NE * CNT_STRIDE;
    LAS int* tstart = (LAS int*)(lds + LDS_TSTART);
    build_tstart(cnt, tstart, tid);
    pg8::GroupOrder S{tstart, 4, __builtin_amdgcn_readfirstlane(tstart[NE]) * 4, G, bid};
    pg8::Gemm g{(const bf16*)(a.ws + WS_HID), (const bf16*)(a.ws + WS_WD) + (size_t)layer * NE * D * DE, DE, (size_t)D * DE * 2};
    pg8::EpiStoreBf16 E{(bf16*)(a.ws + WS_Y), D};
    pg8::gemm_phase<pg8::EpiStoreBf16, pg8::GroupOrder, false, true>(lds + LDS_STAGE, g, S, E, nullptr, wave);
    if ((S.total - bid + G - 1) / G < (S.total + G - 1) / G) { int ln = __builtin_amdgcn_mbcnt_hi(~0u, __builtin_amdgcn_mbcnt_lo(~0u, 0u)); cvt_pull(a, lds, wave, ln, CV_TOTAL, CV_QUOTA_DN); }
}

#define PROBE_SUB 0
constexpr int NATP = 144, TRP = 272;
typedef short s16x8 __attribute__((ext_vector_type(8)));
typedef short s16x4 __attribute__((ext_vector_type(4)));
__device__ __forceinline__ f32x4 mfma32(s16x8 a, s16x8 b, f32x4 c) { return __builtin_amdgcn_mfma_f32_16x16x32_bf16(a, b, c, 0, 0, 0); }
__device__ __forceinline__ f32x4 mfma16(s16x4 a, s16x4 b, f32x4 c) { return __builtin_amdgcn_mfma_f32_16x16x16bf16_1k(a, b, c, 0, 0, 0); }
__device__ __forceinline__ s16x8 cat8(u32x2 lo, u32x2 hi) { u32x4 v = {lo.x, lo.y, hi.x, hi.y}; return __builtin_bit_cast(s16x8, v); }
__device__ __forceinline__ s16x8 ld8(const LAS unsigned char* p) { return *(const LAS s16x8*)p; }
__device__ __forceinline__ u32x2 ld4(const LAS unsigned char* p) { return *(const LAS u32x2*)p; }
__device__ __forceinline__ void wr_run_T(LAS unsigned char* rowp, const float (&x)[16]) {
    u32x4 w0 = {pk2(x[0], x[1]), pk2(x[2], x[3]), pk2(x[4], x[5]), pk2(x[6], x[7])}, w1 = {pk2(x[8], x[9]), pk2(x[10], x[11]), pk2(x[12], x[13]), pk2(x[14], x[15])};
    *(LAS u32x4*)rowp = w0; *(LAS u32x4*)(rowp + 16) = w1;
}
__device__ __forceinline__ void wr_run_N(LAS unsigned char* colp, const float (&x)[16]) {
#pragma unroll
    for (int tt = 0; tt < 16; tt += 2) { const unsigned p = pk2(x[tt], x[tt + 1]); *(LAS unsigned short*)(colp + tt * NATP) = (unsigned short)p; *(LAS unsigned short*)(colp + (tt + 1) * NATP) = (unsigned short)(p >> 16); }
}
__device__ __forceinline__ float ret_log2_gamma(int h) { return log2f(1.f - exp2f(-5.f - (float)h)); }

__device__ __forceinline__ void ld_run16(const bf16* proj, size_t row0, int col, unsigned (&r)[16]) {
#pragma unroll
    for (int tt = 0; tt < 16; ++tt) r[tt] = (unsigned)proj[(row0 + tt) * NP + col];
}
__device__ __forceinline__ void ret_rot(const unsigned (&r)[16], const float* rope, int p0, int lane, float scale, float (&x)[16]) {
#pragma unroll
    for (int tt = 0; tt < 16; ++tt) {
        const float own = __uint_as_float(r[tt] << 16), oth = xor32(own, lane);
        const float2 cs = *(const float2*)(rope + ((size_t)(p0 + tt) * 32 + (lane & 31)) * 2);
        x[tt] = ((lane < 32) ? (own * cs.x - oth * cs.y) : (oth * cs.y + own * cs.x)) * scale;
    }
}
__device__ __forceinline__ void ret_m1(const Args& a, LAS unsigned char* lds, int b, int c, int half, int tid) {
    asm volatile("" : "+v"(tid), "+s"(b), "+s"(c));
    const bf16* proj = (const bf16*)(a.ws + WS_PROJ); const float* rope = (const float*)(a.ws + WS_ROPE);
    float* ST = (float*)(a.ws + WS_ST); float* DEC = (float*)(a.ws + WS_DEC);
    const int j = tid >> 6, lane = tid & 63, fr = lane & 15, q = lane >> 4;
    LAS unsigned char* KT = lds; LAS unsigned char* VT = lds + 2 * 64 * TRP;
    const size_t row0 = (size_t)b * L + c * 128 + 16 * j; const int p0 = c * 128 + 16 * j;
    {
        unsigned rk[2][16], rv[2][16];
#pragma unroll
        for (int hd = 0; hd < 2; ++hd) { ld_run16(proj, row0, C_RK + (2 * half + hd) * 64 + lane, rk[hd]); ld_run16(proj, row0, C_RV + (2 * half + hd) * 64 + lane, rv[hd]); }
#pragma unroll
        for (int hd = 0; hd < 2; ++hd) {
            const float lg = ret_log2_gamma(2 * half + hd);
            float kr[16], vv[16];
            ret_rot(rk[hd], rope, p0, lane, 0.125f, kr);
#pragma unroll
            for (int tt = 0; tt < 16; ++tt) { kr[tt] *= fexp2((float)(127 - (16 * j + tt)) * lg); vv[tt] = __uint_as_float(rv[hd][tt] << 16); }
            wr_run_T(KT + (hd * 64 + lane) * TRP + 32 * j, kr);
            wr_run_T(VT + (hd * 64 + lane) * TRP + 32 * j, vv);
        }
    }
    __syncthreads();
    {
        const int hd = j >> 2, vt = j & 3, head = 12 + 2 * half + hd;
        s16x8 Af[4];
#pragma unroll
        for (int ss = 0; ss < 4; ++ss) Af[ss] = ld8(VT + (hd * 64 + 16 * vt + fr) * TRP + (32 * ss + 8 * q) * 2);
        float* dst = ST + (((size_t)b * 64 + c) * 16 + head) * 4096;
#pragma unroll
        for (int kt = 0; kt < 4; ++kt) {
            f32x4 acc = {0.f, 0.f, 0.f, 0.f};
#pragma unroll
            for (int ss = 0; ss < 4; ++ss) acc = mfma32(Af[ss], ld8(KT + (hd * 64 + 16 * kt + fr) * TRP + (32 * ss + 8 * q) * 2), acc);
#pragma unroll
            for (int r = 0; r < 4; ++r) dst[(16 * vt + 4 * q + r) * 64 + 16 * kt + fr] = acc[r];
        }
        if (tid < 128) { const int hd2 = tid >> 6, h2 = 2 * half + hd2; DEC[(((size_t)b * 64 + c) * 16 + 12 + h2) * 64 + (tid & 63)] = exp2f(128.f * ret_log2_gamma(h2)); }
    }
    __syncthreads();
}
__device__ __forceinline__ void ret_m3(const Args& a, LAS unsigned char* lds, int b, int c, int half, int tid) {
    asm volatile("" : "+v"(tid), "+s"(b), "+s"(c));
    const bf16* proj = (const bf16*)(a.ws + WS_PROJ); const float* rope = (const float*)(a.ws + WS_ROPE);
    const float* ST = (const float*)(a.ws + WS_ST); bf16* mixed = (bf16*)(a.ws + WS_MIXED);
    const int j = tid >> 6, lane = tid & 63, fr = lane & 15, q = lane >> 4;
    LAS unsigned char* QN = lds; LAS unsigned char* KN = QN + 2 * 128 * NATP; LAS unsigned char* VT = KN + 2 * 128 * NATP; LAS unsigned char* SN = VT + 2 * 64 * TRP;
    const size_t row0 = (size_t)b * L + c * 128 + 16 * j; const int p0 = c * 128 + 16 * j;
    {
        unsigned rq[2][16], rk[2][16], rv[2][16];
#pragma unroll
        for (int hd = 0; hd < 2; ++hd) { const int h = 2 * half + hd; ld_run16(proj, row0, C_RQ + h * 64 + lane, rq[hd]); ld_run16(proj, row0, C_RK + h * 64 + lane, rk[hd]); ld_run16(proj, row0, C_RV + h * 64 + lane, rv[hd]); }
#pragma unroll
        for (int hd = 0; hd < 2; ++hd) {
            float x[16];
            ret_rot(rq[hd], rope, p0, lane, 1.f, x);
            wr_run_N(QN + (hd * 128 + 16 * j) * NATP + lane * 2, x);
            ret_rot(rk[hd], rope, p0, lane, 0.125f, x);
            wr_run_N(KN + (hd * 128 + 16 * j) * NATP + lane * 2, x);
#pragma unroll
            for (int tt = 0; tt < 16; ++tt) x[tt] = __uint_as_float(rv[hd][tt] << 16);
            wr_run_T(VT + (hd * 64 + lane) * TRP + 32 * j, x);
        }
    }
    {
        const int idx = tid * 16, hd = idx >> 12, rem = idx & 4095, v = rem >> 6, k0 = rem & 63;
        const float* src = ST + (((size_t)b * 64 + c) * 16 + 12 + 2 * half + hd) * 4096 + v * 64 + k0;
        const f32x4 s0 = *(const f32x4*)src, s1 = *(const f32x4*)(src + 4), s2 = *(const f32x4*)(src + 8), s3 = *(const f32x4*)(src + 12);
        u32x4 w0 = {pk2(s0.x, s0.y), pk2(s0.z, s0.w), pk2(s1.x, s1.y), pk2(s1.z, s1.w)}, w1 = {pk2(s2.x, s2.y), pk2(s2.z, s2.w), pk2(s3.x, s3.y), pk2(s3.z, s3.w)};
        LAS unsigned char* d = SN + (hd * 64 + v) * NATP + k0 * 2;
        *(LAS u32x4*)d = w0; *(LAS u32x4*)(d + 16) = w1;
    }
    __syncthreads();
#pragma unroll 1
    for (int hd = 0; hd < 2; ++hd) {
        const int w = (hd == 0) ? j : 7 - j, tl = 16 * w + fr;
        const int h = 2 * half + hd; const float lg = ret_log2_gamma(h);
        const size_t row = (size_t)b * L + c * 128 + tl;
        u32x2 gzr[4];
#pragma unroll
        for (int vt = 0; vt < 4; ++vt) gzr[vt] = *(const u32x2*)(proj + row * NP + C_RG + h * 64 + 16 * vt + 4 * q);
        s16x8 Qf[2];
#pragma unroll
        for (int ks = 0; ks < 2; ++ks) Qf[ks] = ld8(QN + (hd * 128 + 16 * w + fr) * NATP + (32 * ks + 8 * q) * 2);
        f32x4 oacc[4];
#pragma unroll
        for (int vt = 0; vt < 4; ++vt) {
            f32x4 t = {0.f, 0.f, 0.f, 0.f};
#pragma unroll
            for (int ks = 0; ks < 2; ++ks) t = mfma32(ld8(SN + (hd * 64 + 16 * vt + fr) * NATP + (32 * ks + 8 * q) * 2), Qf[ks], t);
            oacc[vt] = t * fexp2((float)(tl + 1) * lg);
        }
#pragma unroll 1
        for (int pa = 0; pa <= (w >> 1); ++pa) {
            unsigned pb[4];
#pragma unroll
            for (int u = 0; u < 2; ++u) {
                const int st = 2 * pa + u;
                f32x4 sc = {0.f, 0.f, 0.f, 0.f};
                if (st <= w) {
#pragma unroll
                    for (int ks = 0; ks < 2; ++ks) sc = mfma32(ld8(KN + (hd * 128 + 16 * st + fr) * NATP + (32 * ks + 8 * q) * 2), Qf[ks], sc);
                }
                float p[4];
#pragma unroll
                for (int r = 0; r < 4; ++r) { const int d = tl - (16 * st + 4 * q + r); p[r] = (d >= 0 && st <= w) ? sc[r] * fexp2((float)d * lg) : 0.f; }
                pb[2 * u] = pk2(p[0], p[1]); pb[2 * u + 1] = pk2(p[2], p[3]);
            }
            const u32x4 pbv = {pb[0], pb[1], pb[2], pb[3]};
            const s16x8 Bp = __builtin_bit_cast(s16x8, pbv);
#pragma unroll
            for (int vt = 0; vt < 4; ++vt) {
                const LAS unsigned char* vp = VT + (hd * 64 + 16 * vt + fr) * TRP + (32 * pa + 4 * q) * 2;
                oacc[vt] = mfma32(cat8(ld4(vp), ld4(vp + 32)), Bp, oacc[vt]);
            }
        }
        float ss = 0.f;
#pragma unroll
        for (int vt = 0; vt < 4; ++vt) ss += (oacc[vt].x * oacc[vt].x + oacc[vt].y * oacc[vt].y) + (oacc[vt].z * oacc[vt].z + oacc[vt].w * oacc[vt].w);
        ss += swz_xor<16>(ss); ss += xor32(ss, lane);
        const float rinv = rsqrtf(ss * (1.f / 64.f) + EPS);
#pragma unroll
        for (int vt = 0; vt < 4; ++vt) {
            const int col = h * 64 + 16 * vt + 4 * q;
            const u32x2 gz = gzr[vt];
            const float g0 = __uint_as_float(gz.x << 16), g1 = __uint_as_float(gz.x & 0xffff0000u), g2 = __uint_as_float(gz.y << 16), g3 = __uint_as_float(gz.y & 0xffff0000u);
            u32x2 o; o.x = pk2(oacc[vt].x * rinv * siluf(g0), oacc[vt].y * rinv * siluf(g1)); o.y = pk2(oacc[vt].z * rinv * siluf(g2), oacc[vt].w * rinv * siluf(g3));
            *(u32x2*)(mixed + row * D + 768 + col) = o;
        }
    }
    __syncthreads();
}

__device__ __forceinline__ void ssd_load_raw(const bf16* proj, size_t row0, int p0, int ch, unsigned (&r)[19]) {
#pragma unroll
    for (int i = 0; i < 19; ++i) { const int p = p0 - 3 + i; r[i] = (p >= 0) ? (unsigned)proj[(row0 + i - 3) * NP + C_XBC + ch] : 0u; }
}
__device__ __forceinline__ void ssd_conv(const unsigned (&r)[19], int ch, const float* cw, const float* cb, float (&x)[16]) {
    const float w0 = cw[ch], w1 = cw[768 + ch], w2 = cw[2 * 768 + ch], w3 = cw[3 * 768 + ch], bb = cb[ch];
#pragma unroll
    for (int tt = 0; tt < 16; ++tt) x[tt] = siluf(bb + w0 * __uint_as_float(r[tt] << 16) + w1 * __uint_as_float(r[tt + 1] << 16) + w2 * __uint_as_float(r[tt + 2] << 16) + w3 * __uint_as_float(r[tt + 3] << 16));
}
__device__ __forceinline__ void ssd_scalars(const Args& a, int layer, int b, int c, int g, int tid, LAS float* aL, LAS float* cumL, LAS float* dtL) {
    const float* dtraw = (const float*)(a.ws + WS_DT);
    const int hl = tid >> 7, t = tid & 127, h = 4 * g + hl;
    const float dt = softplusf(dtraw[((size_t)b * L + c * 128 + t) * 8 + h] + a.in[10][layer * 8 + h]);
    dtL[tid] = dt; aL[tid] = -expf(a.in[11][layer * 8 + h]) * dt;
    __syncthreads();
    float cs = 0.f;
    for (int s = 0; s <= t; ++s) cs += aL[hl * 128 + s];
    cumL[tid] = cs;
    __syncthreads();
}
__device__ __forceinline__ void ssd_m1(const Args& a, int layer, LAS unsigned char* lds, int b, int c, int g, int tid) {
    asm volatile("" : "+v"(tid), "+s"(b), "+s"(c));
    const bf16* proj = (const bf16*)(a.ws + WS_PROJ);
    const float* cw = a.in[8] + (size_t)layer * 4 * 768; const float* cb = a.in[9] + (size_t)layer * 768;
    float* ST = (float*)(a.ws + WS_ST); float* DEC = (float*)(a.ws + WS_DEC);
    const int j = tid >> 6, lane = tid & 63, fr = lane & 15, q = lane >> 4;
    LAS unsigned char* XT = lds; LAS unsigned char* BT = lds + 4 * 64 * TRP;
    LAS float* aL = (LAS float*)(lds + 5 * 64 * TRP); LAS float* cumL = aL + 512; LAS float* dtL = cumL + 512; LAS float* wL = dtL + 512;
    const size_t row0 = (size_t)b * L + c * 128 + 16 * j; const int p0 = c * 128 + 16 * j;
    {
        unsigned raw[5][19];
#pragma unroll
        for (int i = 0; i < 5; ++i) ssd_load_raw(proj, row0, p0, (i < 4 ? (4 * g + i) * 64 : 512 + g * 64) + lane, raw[i]);
        float x[16];
#pragma unroll
        for (int hl = 0; hl < 4; ++hl) {
            ssd_conv(raw[hl], (4 * g + hl) * 64 + lane, cw, cb, x);
            wr_run_T(XT + (hl * 64 + lane) * TRP + 32 * j, x);
        }
        ssd_conv(raw[4], 512 + g * 64 + lane, cw, cb, x);
        wr_run_T(BT + lane * TRP + 32 * j, x);
    }
    ssd_scalars(a, layer, b, c, g, tid, aL, cumL, dtL);
    {
        const int hl = tid >> 7, t = tid & 127;
        const float cl = cumL[hl * 128 + 127];
        wL[tid] = expf(cl - cumL[tid]) * dtL[tid];
        if (t < 64) DEC[(((size_t)b * 64 + c) * 16 + 4 * g + hl) * 64 + t] = expf(cl);
    }
    __syncthreads();
    {
        const int hl = j >> 1;
        float* dst = ST + (((size_t)b * 64 + c) * 16 + 4 * g + hl) * 4096;
#pragma unroll 1
        for (int vi = 0; vi < 2; ++vi) {
            const int vt = (j & 1) * 2 + vi;
            s16x8 Af[4];
#pragma unroll
            for (int ss = 0; ss < 4; ++ss) {
                const u32x4 au = *(const LAS u32x4*)(XT + (hl * 64 + 16 * vt + fr) * TRP + (32 * ss + 8 * q) * 2);
                const f32x4 w0 = *(const LAS f32x4*)(wL + hl * 128 + 32 * ss + 8 * q), w1 = *(const LAS f32x4*)(wL + hl * 128 + 32 * ss + 8 * q + 4);
                u32x4 o;
                o.x = pk2(__uint_as_float(au.x << 16) * w0.x, __uint_as_float(au.x & 0xffff0000u) * w0.y);
                o.y = pk2(__uint_as_float(au.y << 16) * w0.z, __uint_as_float(au.y & 0xffff0000u) * w0.w);
                o.z = pk2(__uint_as_float(au.z << 16) * w1.x, __uint_as_float(au.z & 0xffff0000u) * w1.y);
                o.w = pk2(__uint_as_float(au.w << 16) * w1.z, __uint_as_float(au.w & 0xffff0000u) * w1.w);
                Af[ss] = __builtin_bit_cast(s16x8, o);
            }
#pragma unroll
            for (int kt = 0; kt < 4; ++kt) {
                f32x4 acc = {0.f, 0.f, 0.f, 0.f};
#pragma unroll
                for (int ss = 0; ss < 4; ++ss) acc = mfma32(Af[ss], ld8(BT + (16 * kt + fr) * TRP + (32 * ss + 8 * q) * 2), acc);
#pragma unroll
                for (int r = 0; r < 4; ++r) dst[(16 * vt + 4 * q + r) * 64 + 16 * kt + fr] = acc[r];
            }
        }
    }
    __syncthreads();
}
__device__ __forceinline__ void stage_states2(const float* ST, int b, int c, int head0, LAS unsigned char* SN, int tid) {
    const int idx = tid * 16, hd = idx >> 12, rem = idx & 4095, v = rem >> 6, k0 = rem & 63;
    const float* src = ST + (((size_t)b * 64 + c) * 16 + head0 + hd) * 4096 + v * 64 + k0;
    const f32x4 s0 = *(const f32x4*)src, s1 = *(const f32x4*)(src + 4), s2 = *(const f32x4*)(src + 8), s3 = *(const f32x4*)(src + 12);
    u32x4 w0 = {pk2(s0.x, s0.y), pk2(s0.z, s0.w), pk2(s1.x, s1.y), pk2(s1.z, s1.w)}, w1 = {pk2(s2.x, s2.y), pk2(s2.z, s2.w), pk2(s3.x, s3.y), pk2(s3.z, s3.w)};
    LAS unsigned char* d = SN + (hd * 64 + v) * NATP + k0 * 2;
    *(LAS u32x4*)d = w0; *(LAS u32x4*)(d + 16) = w1;
}
__device__ __forceinline__ void ssd_m3(const Args& a, int layer, LAS unsigned char* lds, int b, int c, int g, int tid) {
    asm volatile("" : "+v"(tid), "+s"(b), "+s"(c));
    const bf16* proj = (const bf16*)(a.ws + WS_PROJ);
    const float* cw = a.in[8] + (size_t)layer * 4 * 768; const float* cb = a.in[9] + (size_t)layer * 768;
    const float* ST = (const float*)(a.ws + WS_ST); bf16* mixed = (bf16*)(a.ws + WS_MIXED);
    const int j = tid >> 6, lane = tid & 63, fr = lane & 15, q = lane >> 4;
    LAS unsigned char* XT = lds; LAS unsigned char* KN = XT + 4 * 64 * TRP; LAS unsigned char* QN = KN + 128 * NATP; LAS unsigned char* SN = QN + 128 * NATP;
    LAS float* aL = (LAS float*)(SN + 2 * 64 * NATP); LAS float* cumL = aL + 512; LAS float* dtL = cumL + 512;
    const size_t row0 = (size_t)b * L + c * 128 + 16 * j; const int p0 = c * 128 + 16 * j;
    {
        unsigned raw[6][19];
#pragma unroll
        for (int i = 0; i < 6; ++i) ssd_load_raw(proj, row0, p0, (i < 4 ? (4 * g + i) * 64 : (i == 4 ? 512 : 640) + g * 64) + lane, raw[i]);
        float x[16];
#pragma unroll
        for (int hl = 0; hl < 4; ++hl) {
            ssd_conv(raw[hl], (4 * g + hl) * 64 + lane, cw, cb, x);
            wr_run_T(XT + (hl * 64 + lane) * TRP + 32 * j, x);
        }
        ssd_conv(raw[4], 512 + g * 64 + lane, cw, cb, x);
        wr_run_N(KN + (16 * j) * NATP + lane * 2, x);
        ssd_conv(raw[5], 640 + g * 64 + lane, cw, cb, x);
        wr_run_N(QN + (16 * j) * NATP + lane * 2, x);
    }
    stage_states2(ST, b, c, 4 * g, SN, tid);
    ssd_scalars(a, layer, b, c, g, tid, aL, cumL, dtL);
    u32x2 y[2][2][4]; float ssum[2];
    size_t rowp[2];
#pragma unroll
    for (int p = 0; p < 2; ++p) {
        if (p == 1) { __syncthreads(); stage_states2(ST, b, c, 4 * g + 2, SN, tid); __syncthreads(); }
        const int wb = (p == 0) ? j : 7 - j, tl = 16 * wb + fr;
        rowp[p] = (size_t)b * L + c * 128 + tl;
        u32x2 gz[2][4];
#pragma unroll
        for (int hd = 0; hd < 2; ++hd)
#pragma unroll
            for (int vt = 0; vt < 4; ++vt) gz[hd][vt] = *(const u32x2*)(proj + rowp[p] * NP + C_Z + (4 * g + 2 * p + hd) * 64 + 16 * vt + 4 * q);
        s16x8 Qf[2];
#pragma unroll
        for (int ks = 0; ks < 2; ++ks) Qf[ks] = ld8(QN + (16 * wb + fr) * NATP + (32 * ks + 8 * q) * 2);
        f32x4 sc[8];
#pragma unroll
        for (int st = 0; st < 8; ++st) {
            sc[st] = (f32x4){0.f, 0.f, 0.f, 0.f};
            if (st <= wb) {
#pragma unroll
                for (int ks = 0; ks < 2; ++ks) sc[st] = mfma32(ld8(KN + (16 * st + fr) * NATP + (32 * ks + 8 * q) * 2), Qf[ks], sc[st]);
            }
        }
        float ss = 0.f;
#pragma unroll
        for (int hd = 0; hd < 2; ++hd) {
            const int hl = 2 * p + hd, h = 4 * g + hl;
            const float cum_t = cumL[hl * 128 + tl], dsk = a.in[12][layer * 8 + h];
            f32x4 oacc[4];
            const float et = fexp(cum_t);
#pragma unroll
            for (int vt = 0; vt < 4; ++vt) {
                f32x4 t = {0.f, 0.f, 0.f, 0.f};
#pragma unroll
                for (int ks = 0; ks < 2; ++ks) t = mfma32(ld8(SN + (hd * 64 + 16 * vt + fr) * NATP + (32 * ks + 8 * q) * 2), Qf[ks], t);
                oacc[vt] = t * et;
            }
#pragma unroll
            for (int pa = 0; pa < 4; ++pa) {
                if (2 * pa <= wb) {
                    unsigned pb[4];
#pragma unroll
                    for (int u = 0; u < 2; ++u) {
                        const int st = 2 * pa + u;
                        const f32x4 cs4 = *(const LAS f32x4*)(cumL + hl * 128 + 16 * st + 4 * q), dt4 = *(const LAS f32x4*)(dtL + hl * 128 + 16 * st + 4 * q);
                        float pv[4];
#pragma unroll
                        for (int r = 0; r < 4; ++r) {
                            const int d = tl - (16 * st + 4 * q + r);
                            const float v = (d >= 0 && st <= wb) ? sc[st][r] * fexp(cum_t - cs4[r]) * dt4[r] : 0.f;
                            pv[r] = (d == 0) ? v + dsk : v;
                        }
                        pb[2 * u] = pk2(pv[0], pv[1]); pb[2 * u + 1] = pk2(pv[2], pv[3]);
                    }
                    const u32x4 pbv = {pb[0], pb[1], pb[2], pb[3]};
                    const s16x8 Bp = __builtin_bit_cast(s16x8, pbv);
#pragma unroll
                    for (int vt = 0; vt < 4; ++vt) {
                        const LAS unsigned char* vp = XT + (hl * 64 + 16 * vt + fr) * TRP + (32 * pa + 4 * q) * 2;
                        oacc[vt] = mfma32(cat8(ld4(vp), ld4(vp + 32)), Bp, oacc[vt]);
                    }
                }
            }
#pragma unroll
            for (int vt = 0; vt < 4; ++vt) {
                const u32x2 z2 = gz[hd][vt];
                const float y0 = oacc[vt].x * siluf(__uint_as_float(z2.x << 16)), y1 = oacc[vt].y * siluf(__uint_as_float(z2.x & 0xffff0000u));
                const float y2 = oacc[vt].z * siluf(__uint_as_float(z2.y << 16)), y3 = oacc[vt].w * siluf(__uint_as_float(z2.y & 0xffff0000u));
                ss += (y0 * y0 + y1 * y1) + (y2 * y2 + y3 * y3);
                y[p][hd][vt].x = pk2(y0, y1); y[p][hd][vt].y = pk2(y2, y3);
            }
        }
        ss += swz_xor<16>(ss); ss += xor32(ss, lane);
        ssum[p] = ss;
    }
    __syncthreads();
    if (q == 0) { aL[16 * j + fr] = ssum[0]; aL[128 + 16 * (7 - j) + fr] = ssum[1]; }
    __syncthreads();
    const float* gn = a.in[13] + (size_t)layer * 512 + g * 256;
#pragma unroll
    for (int p = 0; p < 2; ++p) {
        const int wb = (p == 0) ? j : 7 - j, tl = 16 * wb + fr;
        const float rinv = rsqrtf((aL[tl] + aL[128 + tl]) * (1.f / 256.f) + EPS);
#pragma unroll
        for (int hd = 0; hd < 2; ++hd)
#pragma unroll
            for (int vt = 0; vt < 4; ++vt) {
                const int col = (2 * p + hd) * 64 + 16 * vt + 4 * q;
                const f32x4 gv = *(const f32x4*)(gn + col);
                const u32x2 yy = y[p][hd][vt];
                u32x2 o; o.x = pk2(__uint_as_float(yy.x << 16) * rinv * gv.x, __uint_as_float(yy.x & 0xffff0000u) * rinv * gv.y); o.y = pk2(__uint_as_float(yy.y << 16) * rinv * gv.z, __uint_as_float(yy.y & 0xffff0000u) * rinv * gv.w);
                *(u32x2*)(mixed + rowp[p] * D + g * 256 + col) = o;
            }
    }
    __syncthreads();
}

constexpr int HG_QN = 0, HG_KN = 2 * 64 * NATP, HG_KH = 4 * 64 * NATP, HG_VT = 6 * 64 * NATP, HG_OB = 8 * 64 * NATP, HG_GL = HG_OB + 2 * 64 * TRP, HG_TOT = HG_GL + 2 * 8 * 64 * 4;
template <bool M3>
__device__ __forceinline__ void hgrn_stage_a(const Args& a, int layer, LAS unsigned char* lds, int b, int c, int half, int hc, int j, int lane) {
    const bf16* proj = (const bf16*)(a.ws + WS_PROJ);
    const int hd = j >> 2, sl = j & 3, h = 2 * half + hd, col = h * 64 + lane, jg = 4 * hc + sl;
    const size_t row0 = (size_t)b * L + c * 128 + 16 * jg;
    const float lbv = ((const float*)(a.ws + WS_LB))[layer * 256 + col];
    float qv[16], kin[16], clv[16], vv[16];
#pragma unroll
    for (int tt = 0; tt < 16; ++tt) {
        const float fr_ = bf2f(proj[(row0 + tt) * NP + C_HF + col]);
        vv[tt] = bf2f(proj[(row0 + tt) * NP + C_HI + col]);
        if (M3) qv[tt] = bf2f(proj[(row0 + tt) * NP + C_HQ + col]);
        const float f = lbv + (1.f - lbv) * sigmf(fr_);
        clv[tt] = flog(fmaxf(f, 1e-30f)); kin[tt] = 1.f - f;
    }
#pragma unroll
    for (int tt = 1; tt < 16; ++tt) clv[tt] += clv[tt - 1];
    const float total = clv[15];
    float x[16];
#pragma unroll
    for (int tt = 0; tt < 16; ++tt) x[tt] = kin[tt] * fexp(total - clv[tt]);
    wr_run_T(lds + HG_KH + (hd * 64 + lane) * NATP + 32 * sl, x);
    wr_run_T(lds + HG_VT + (hd * 64 + lane) * NATP + 32 * sl, vv);
    ((LAS float*)(lds + HG_GL))[(hd * 8 + jg) * 64 + lane] = M3 ? fexp(total) : total;
    if (M3) {
#pragma unroll
        for (int tt = 0; tt < 16; ++tt) x[tt] = qv[tt] * fexp(clv[tt]);
        wr_run_N(lds + HG_QN + (hd * 64 + 16 * sl) * NATP + lane * 2, x);
#pragma unroll
        for (int tt = 0; tt < 16; ++tt) x[tt] = kin[tt] * fexp(fminf(-clv[tt], 80.f));
        wr_run_N(lds + HG_KN + (hd * 64 + 16 * sl) * NATP + lane * 2, x);
    }
}
__device__ __forceinline__ s16x4 pk4(f32x4 v) { u32x2 u = {pk2(v.x, v.y), pk2(v.z, v.w)}; return __builtin_bit_cast(s16x4, u); }
__device__ __forceinline__ s16x4 ld4s(const LAS unsigned char* p) { return *(const LAS s16x4*)p; }
template <bool M3>
__device__ __forceinline__ void hgrn_unit(const Args& a, int layer, LAS unsigned char* lds, int b, int c, int half, int tid) {
    asm volatile("" : "+v"(tid), "+s"(b), "+s"(c));
    const int j = tid >> 6, lane = tid & 63, fr = lane & 15, q = lane >> 4;
    const int hd = j >> 2, vt = j & 3, head = 8 + 2 * half + hd;
    float* STp = (float*)(a.ws + WS_ST) + (((size_t)b * 64 + c) * 16 + head) * 4096;
    f32x4 S[4];
#pragma unroll
    for (int kt = 0; kt < 4; ++kt) {
        S[kt] = (f32x4){0.f, 0.f, 0.f, 0.f};
        if (M3) {
#pragma unroll
            for (int r = 0; r < 4; ++r) S[kt][r] = STp[(16 * kt + 4 * q + r) * 64 + 16 * vt + fr];
        }
    }
    const LAS float* gL = (const LAS float*)(lds + HG_GL);
#pragma unroll 1
    for (int hc = 0; hc < 2; ++hc) {
        hgrn_stage_a<M3>(a, layer, lds, b, c, half, hc, j, lane);
        __syncthreads();
#pragma unroll 1
        for (int sl = 0; sl < 4; ++sl) {
            const int jg = 4 * hc + sl;
            const s16x4 Bv = ld4s(lds + HG_VT + (hd * 64 + 16 * vt + fr) * NATP + (16 * sl + 4 * q) * 2);
            if (M3) {
                f32x4 pacc = {0.f, 0.f, 0.f, 0.f};
#pragma unroll
                for (int ks = 0; ks < 2; ++ks)
                    pacc = mfma32(ld8(lds + HG_KN + (hd * 64 + 16 * sl + fr) * NATP + (32 * ks + 8 * q) * 2), ld8(lds + HG_QN + (hd * 64 + 16 * sl + fr) * NATP + (32 * ks + 8 * q) * 2), pacc);
#pragma unroll
                for (int r = 0; r < 4; ++r) pacc[r] = (4 * q + r <= fr) ? pacc[r] : 0.f;
                f32x4 oacc = {0.f, 0.f, 0.f, 0.f};
#pragma unroll
                for (int kt = 0; kt < 4; ++kt) oacc = mfma16(ld4s(lds + HG_QN + (hd * 64 + 16 * sl + fr) * NATP + (16 * kt + 4 * q) * 2), pk4(S[kt]), oacc);
                oacc = mfma16(pk4(pacc), Bv, oacc);
                LAS float* ob = (LAS float*)(lds + HG_OB + (hd * 64 + 16 * sl + 4 * q) * TRP) + 16 * vt + fr;
#pragma unroll
                for (int r = 0; r < 4; ++r) ob[r * (TRP / 4)] = oacc[r];
            }
#pragma unroll
            for (int kt = 0; kt < 4; ++kt) {
                const f32x4 g4 = *(const LAS f32x4*)(gL + (hd * 8 + jg) * 64 + 16 * kt + 4 * q);
                f32x4 sc = S[kt];
                if (M3) sc = sc * g4; else { sc.x *= fexp(g4.x); sc.y *= fexp(g4.y); sc.z *= fexp(g4.z); sc.w *= fexp(g4.w); }
                S[kt] = mfma16(ld4s(lds + HG_KH + (hd * 64 + 16 * kt + fr) * NATP + (16 * sl + 4 * q) * 2), Bv, sc);
            }
        }
        __syncthreads();
        if (M3) {
            const int hd2 = tid >> 8, t = (tid >> 2) & 63, qu = tid & 3, h2 = 2 * half + hd2;
            const LAS float* ob = (const LAS float*)(lds + HG_OB + (hd2 * 64 + t) * TRP) + 16 * qu;
            f32x4 o[4]; float ss = 0.f;
#pragma unroll
            for (int i = 0; i < 4; ++i) { o[i] = *(const LAS f32x4*)(ob + 4 * i); ss += (o[i].x * o[i].x + o[i].y * o[i].y) + (o[i].z * o[i].z + o[i].w * o[i].w); }
            ss += swz_xor<1>(ss); ss += swz_xor<2>(ss);
            const float rinv = rsqrtf(ss * (1.f / 64.f) + EPS);
            const size_t row = (size_t)b * L + c * 128 + 64 * hc + t;
            const bf16* gp = (const bf16*)(a.ws + WS_PROJ) + row * NP + C_HG + h2 * 64 + 16 * qu;
            const u32x4 g0 = *(const u32x4*)gp, g1 = *(const u32x4*)(gp + 8);
            const float* ng = a.in[15] + (size_t)layer * 256 + h2 * 64 + 16 * qu;
            const unsigned gg[8] = {g0.x, g0.y, g0.z, g0.w, g1.x, g1.y, g1.z, g1.w};
            unsigned ow[8];
#pragma unroll
            for (int i = 0; i < 4; ++i) {
                const f32x4 nv = *(const f32x4*)(ng + 4 * i);
                ow[2 * i] = pk2(o[i].x * rinv * nv.x * sigmf(__uint_as_float(gg[2 * i] << 16)), o[i].y * rinv * nv.y * sigmf(__uint_as_float(gg[2 * i] & 0xffff0000u)));
                ow[2 * i + 1] = pk2(o[i].z * rinv * nv.z * sigmf(__uint_as_float(gg[2 * i + 1] << 16)), o[i].w * rinv * nv.w * sigmf(__uint_as_float(gg[2 * i + 1] & 0xffff0000u)));
            }
            bf16* mp = (bf16*)(a.ws + WS_MIXED) + row * D + 512 + h2 * 64 + 16 * qu;
            *(u32x4*)mp = (u32x4){ow[0], ow[1], ow[2], ow[3]}; *(u32x4*)(mp + 8) = (u32x4){ow[4], ow[5], ow[6], ow[7]};
            __syncthreads();
        }
    }
    if (!M3) {
#pragma unroll
        for (int kt = 0; kt < 4; ++kt)
#pragma unroll
            for (int r = 0; r < 4; ++r) STp[(16 * kt + 4 * q + r) * 64 + 16 * vt + fr] = S[kt][r];
        if (tid < 128) {
            const int hd2 = tid >> 6, k = tid & 63;
            float s = 0.f;
#pragma unroll
            for (int jg = 0; jg < 8; ++jg) s += gL[(hd2 * 8 + jg) * 64 + k];
            ((float*)(a.ws + WS_DEC))[(((size_t)b * 64 + c) * 16 + 8 + 2 * half + hd2) * 64 + k] = expf(s);
        }
        __syncthreads();
    }
}

__device__ __forceinline__ void phase_m1(const Args& a, int layer, LAS unsigned char* lds, int bid, int G, int tid) {
    for (int u = bid; u < NB * 64 * 2; u += G) {
        const int b = u >> 7, c = (u >> 1) & 63, half = u & 1;
        for (int r_ = 0; r_ < ((PROBE_SUB == 4) ? 3 : 1); ++r_) ssd_m1(a, layer, lds, b, c, half, tid);
        for (int r_ = 0; r_ < ((PROBE_SUB == 5) ? 3 : 1); ++r_) ret_m1(a, lds, b, c, half, tid);
        for (int r_ = 0; r_ < ((PROBE_SUB == 6) ? 3 : 1); ++r_) hgrn_unit<false>(a, layer, lds, b, c, half, tid);
    }
}
__device__ __forceinline__ void phase_m2(const Args& a, LAS unsigned char* lds, int bid, int G, int tid) {
    float* ST = (float*)(a.ws + WS_ST); const float* DEC = (const float*)(a.ws + WS_DEC);
    LAS float* dl = (LAS float*)lds;
    for (int u = bid; u < 256; u += G) {
        const int bh = u >> 3, b = bh >> 4, head = bh & 15, e = (u & 7) * 512 + tid;
        __syncthreads();
#pragma unroll
        for (int i = 0; i < 8; ++i) { const int x = tid + 512 * i, c = x >> 6; dl[x] = DEC[(((size_t)b * 64 + c) * 16 + head) * 64 + (x & 63)]; }
        float s[64];
#pragma unroll
        for (int c = 0; c < 64; ++c) s[c] = ST[(((size_t)b * 64 + c) * 16 + head) * 4096 + e];
        __syncthreads();
        float run = 0.f;
#pragma unroll
        for (int c = 0; c < 64; ++c) { const float prev = run; run = dl[c * 64 + (e >> 6)] * run + s[c]; ST[(((size_t)b * 64 + c) * 16 + head) * 4096 + e] = prev; }
    }
}
__device__ __forceinline__ void phase_m3(const Args& a, int layer, LAS unsigned char* lds, int bid, int G, int tid) {
    for (int u = bid; u < NB * 64 * 2; u += G) {
        const int b = u >> 7, c = (u >> 1) & 63, half = u & 1;
        for (int r_ = 0; r_ < ((PROBE_SUB == 1) ? 3 : 1); ++r_) ssd_m3(a, layer, lds, b, c, half, tid);
        for (int r_ = 0; r_ < ((PROBE_SUB == 2) ? 3 : 1); ++r_) ret_m3(a, lds, b, c, half, tid);
        for (int r_ = 0; r_ < ((PROBE_SUB == 3) ? 3 : 1); ++r_) hgrn_unit<true>(a, layer, lds, b, c, half, tid);
    }
}


__device__ __forceinline__ const void* rd_ptr(LAS const unsigned* p) {
    const unsigned lo = __builtin_amdgcn_readfirstlane(p[0]), hi = __builtin_amdgcn_readfirstlane(p[1]);
    return (const void*)(GAS const void*)(((unsigned long long)hi << 32) | lo);
}
__device__ __forceinline__ Args load_args(LAS unsigned char* lds) {
    LAS const unsigned* la = (LAS const unsigned*)(lds + LDS_ARGS);
    asm volatile("" : "+v"(la));
    Args A;
#pragma unroll
    for (int i = 0; i < 24; ++i) A.in[i] = (const float*)rd_ptr(la + 2 * i);
    A.out = (float*)rd_ptr(la + 48); A.ws = (unsigned char*)rd_ptr(la + 50);
    A.ph_lo = 0; A.ph_hi = 0; A.region = 0; A.pad = 0;
    return A;
}
#define PROBE_PH -1
#define PROBE_REP 2
#define REPS(p) ((PROBE_PH == (p)) ? 1 + PROBE_REP : 1)
__global__ void __launch_bounds__(NTHREADS, 2) fwd(Args a0) {
    extern __shared__ __attribute__((aligned(16))) unsigned char lds_raw[];
    LAS unsigned char* lds = (LAS unsigned char*)lds_raw;
    const int G0 = gridDim.x, bid0 = blockIdx.x;
    const int wave = __builtin_amdgcn_readfirstlane(threadIdx.x >> 6);
#define FRESH() int lane = __builtin_amdgcn_mbcnt_hi(~0u, __builtin_amdgcn_mbcnt_lo(~0u, 0u)); asm volatile("" : "+v"(lane)); int bid = bid0, G = G0; asm volatile("" : "+s"(bid), "+s"(G)); \
    const int tid = wave * 64 + lane, gw = bid * NWAVES + wave, ngw = G * NWAVES; (void)gw; (void)ngw; const Args a = load_args(lds)
    const int lo = a0.ph_lo, hi = a0.ph_hi;
    volatile LAS unsigned* misc = (volatile LAS unsigned*)(lds + LDS_MISC);
    if (threadIdx.x < 4) misc[threadIdx.x] = 0u;
    if (threadIdx.x < 56) ((LAS unsigned*)(lds + LDS_ARGS))[threadIdx.x] = ((const unsigned*)&a0)[threadIdx.x];
    __syncthreads();
    XcdBarrier bar; bar.bar = (unsigned*)(a0.ws + WS_CTL) + CW_BAR + a0.region * XCD_BAR_WORDS; bar.x = 0; bar.st = misc;
    if (hi - lo > 1) bar = xcd_barrier_post(bar.bar, misc);
#define IN(k) (lo <= (k) && (k) < hi)
#define SEAM(k) do { if (IN(k) && IN((k) + 1)) { asm volatile("" : "+s"(bar.bar)); xcd_barrier(bar); } } while (0)
    if (IN(PH_PRO)) { FRESH(); phase_prologue(a, lds, bid, G, tid); phase_convert(a, lds, gw, ngw, wave, lane); }
    SEAM(PH_PRO);
    for (int layer = 0; layer < DEPTH; ++layer) {
        const int pb = 1 + layer * PH_PER_LAYER;
        if (IN(pb + P_N1)) { _Pragma("unroll 1") for (int rep_ = 0; rep_ < REPS(P_N1); ++rep_) { FRESH(); if (layer > 0) cvt_ensure(a, lds, wave, lane, cv_need_out(layer)); phase_norm1(a, layer, lds, bid, G, wave, lane, rep_ > 0); } }
        SEAM(pb + P_N1);
        if (IN(pb + P_GIN)) { _Pragma("unroll 1") for (int rep_ = 0; rep_ < REPS(P_GIN); ++rep_) { FRESH(); phase_gemm_in(a, layer, lds, G, bid, wave); } }
        SEAM(pb + P_GIN);
        if (IN(pb + P_M1)) { _Pragma("unroll 1") for (int rep_ = 0; rep_ < REPS(P_M1); ++rep_) { FRESH(); phase_m1(a, layer, lds, bid, G, tid); } }
        SEAM(pb + P_M1);
        if (IN(pb + P_M2)) { _Pragma("unroll 1") for (int rep_ = 0; rep_ < REPS(P_M2); ++rep_) { FRESH(); phase_m2(a, lds, bid, G, tid); } }
        SEAM(pb + P_M2);
        if (IN(pb + P_M3)) { _Pragma("unroll 1") for (int rep_ = 0; rep_ < REPS(P_M3); ++rep_) { FRESH(); phase_m3(a, layer, lds, bid, G, tid); } }
        SEAM(pb + P_M3);
        if (IN(pb + P_GOUT)) { _Pragma("unroll 1") for (int rep_ = 0; rep_ < REPS(P_GOUT); ++rep_) { FRESH(); phase_gemm_out(a, layer, lds, G, bid, wave); } }
        SEAM(pb + P_GOUT);
        if (IN(pb + P_N2)) { _Pragma("unroll 1") for (int rep_ = 0; rep_ < REPS(P_N2); ++rep_) { FRESH(); cvt_ensure(a, lds, wave, lane, cv_need_dn(layer)); phase_norm2(a, layer, lds, bid, G, wave, lane, rep_ > 0); } }
        SEAM(pb + P_N2);
        if (IN(pb + P_GGU)) { _Pragma("unroll 1") for (int rep_ = 0; rep_ < REPS(P_GGU); ++rep_) { FRESH(); phase_gemm_gu(a, layer, lds, G, bid, tid, wave); } }
        SEAM(pb + P_GGU);
        if (IN(pb + P_GDN)) { _Pragma("unroll 1") for (int rep_ = 0; rep_ < REPS(P_GDN); ++rep_) { FRESH(); phase_gemm_dn(a, layer, lds, G, bid, tid, wave); } }
        SEAM(pb + P_GDN);
    }
    if (IN(PH_FINAL)) { FRESH(); phase_norm1(a, DEPTH, lds, bid, G, wave, lane); }
#undef IN
#undef SEAM
}

#ifndef N_LAUNCH_MODE
#define N_LAUNCH_MODE 1
#endif
extern "C" void kernel_launch(void* const* d_in, const int* in_sizes, int n_in, void* d_out, int out_size, void* d_ws, size_t ws_size, hipStream_t stream) {
    static int grid = 0;
    if (grid == 0) {
        if (n_in != 24 || ws_size < WS_END) { fprintf(stderr, "kernel_launch: unexpected n_in %d / ws %zu\n", n_in, ws_size); grid = -1; return; }
        int dev = 0, cus = 0, per_cu = 0;
        if (hipGetDevice(&dev) != hipSuccess || hipDeviceGetAttribute(&cus, hipDeviceAttributeMultiprocessorCount, dev) != hipSuccess) { grid = -1; return; }
        if (hipFuncSetAttribute((const void*)fwd, hipFuncAttributeMaxDynamicSharedMemorySize, LDS_BYTES) != hipSuccess) { fprintf(stderr, "kernel_launch: hipFuncSetAttribute failed\n"); grid = -1; return; }
        if (hipOccupancyMaxActiveBlocksPerMultiprocessor(&per_cu, (const void*)fwd, NTHREADS, LDS_BYTES) != hipSuccess || per_cu < 1) { fprintf(stderr, "kernel_launch: occupancy query says %d\n", per_cu); }
        (void)hipGetLastError();
        grid = cus;
    }
    if (grid < 0) return;
    unsigned char* ws = (unsigned char*)d_ws;
    (void)hipMemsetAsync(ws + WS_CTL, 0, CTL_BYTES, stream);
    Args a{};
    for (int i = 0; i < 24; ++i) a.in[i] = (const float*)d_in[i];
    a.out = (float*)d_out; a.ws = ws; a.region = 0; a.pad = 0;
#if N_LAUNCH_MODE == 1
    a.ph_lo = 0; a.ph_hi = NPH;
    hipLaunchKernelGGL(fwd, dim3(grid), dim3(NTHREADS), LDS_BYTES, stream, a);
#else
    for (int ph = 0; ph < NPH; ++ph) { a.ph_lo = ph; a.ph_hi = ph + 1; hipLaunchKernelGGL(fwd, dim3(grid), dim3(NTHREADS), LDS_BYTES, stream, a); }
#endif
}
```

```cpp
#include <hip/hip_runtime.h>
#include <stdint.h>
#include <stdio.h>

#define GAS __attribute__((address_space(1)))
#define LAS __attribute__((address_space(3)))
typedef unsigned short bf16;
typedef float f32x4 __attribute__((ext_vector_type(4)));
typedef unsigned u32x2 __attribute__((ext_vector_type(2)));
typedef unsigned u32x4 __attribute__((ext_vector_type(4)));

constexpr int D = 1024, NB = 2, L = 8192, T = NB * L, DEPTH = 4;
constexpr int DIN = 3336;
constexpr int NP = 3328;
constexpr int NE = 32, DE = 256;
constexpr float EPS = 1e-6f;
constexpr int R_DT = 1280;
constexpr int C_Z = 0, C_XBC = 512, C_HQ = 1280, C_HF = 1536, C_HI = 1792, C_HG = 2048, C_RQ = 2304, C_RK = 2560, C_RV = 2816, C_RG = 3072;
constexpr int PAIR_ROWS = 2 * T + NE * 256;

constexpr size_t MiB = 1u << 20;
constexpr size_t WS_CTL = 0, CTL_BYTES = 1 * MiB;
constexpr size_t WS_MOD = 1 * MiB;
constexpr size_t WS_LB = 1 * MiB + 512 * 1024;
constexpr size_t WS_ROPE = 2 * MiB;
constexpr size_t WS_DT = 4 * MiB;
constexpr size_t WS_EID = 5 * MiB;
constexpr size_t WS_EW = 5 * MiB + 128 * 1024;
constexpr size_t WS_SLOT = 5 * MiB + 256 * 1024;
constexpr size_t WS_LIST = 6 * MiB;
constexpr size_t WS_WL = 8 * MiB;
constexpr size_t WS_XW = 10 * MiB;
constexpr size_t WS_H = 74 * MiB;
constexpr size_t WS_PROJ = 106 * MiB;
constexpr size_t WS_HID = 106 * MiB;
constexpr size_t WS_Y = 126 * MiB;
constexpr size_t WS_MIXED = 210 * MiB;
constexpr size_t WS_O = 242 * MiB;
constexpr size_t WS_WIN = 306 * MiB;
constexpr size_t WS_WOUT = 332 * MiB;
constexpr size_t WS_WGU = 340 * MiB;
constexpr size_t WS_WD = 468 * MiB;
constexpr size_t WS_ST = 532 * MiB;
constexpr size_t WS_DEC = 4 * MiB + 512 * 1024;
constexpr size_t WS_WR = 564 * MiB;
constexpr size_t WS_WDT = 565 * MiB;
constexpr size_t WS_END = 566 * MiB;
constexpr int CW_CNT = 8192, CNT_STRIDE = 64;
constexpr int CW_BAR = 16384;
constexpr int LDS_STAGE = 0, LDS_TAB = 131072, LDS_TSTART = 139264, LDS_MISC = 143360, LDS_ARGS = 143424, LDS_BYTES = 147456;

struct Args { const float* in[24]; float* out; unsigned char* ws; int ph_lo, ph_hi, region, pad; };

__device__ __forceinline__ float bf2f(unsigned short u) { return __uint_as_float(((unsigned)u) << 16); }
typedef float f32x2_t __attribute__((ext_vector_type(2)));
typedef __bf16 bf16x2_t __attribute__((ext_vector_type(2)));
__device__ __forceinline__ unsigned pk2(float lo, float hi) { const f32x2_t v = {lo, hi}; const bf16x2_t b = __builtin_convertvector(v, bf16x2_t); return __builtin_bit_cast(unsigned, b); }
__device__ __forceinline__ unsigned f2bf(float f) { return pk2(f, f) & 0xffffu; }
__device__ __forceinline__ float fexp(float x) { return __builtin_amdgcn_exp2f(x * 1.4426950408889634f); }
__device__ __forceinline__ float fexp2(float x) { return __builtin_amdgcn_exp2f(x); }
__device__ __forceinline__ float flog(float x) { return __builtin_amdgcn_logf(x) * 0.6931471805599453f; }
__device__ __forceinline__ float frcp(float x) { return __builtin_amdgcn_rcpf(x); }
__device__ __forceinline__ float siluf(float x) { return x * frcp(1.f + fexp(-x)); }
__device__ __forceinline__ float sigmf(float x) { return frcp(1.f + fexp(-x)); }
__device__ __forceinline__ float softplusf(float x) { return fmaxf(x, 0.f) + log1pf(__expf(-fabsf(x))); }
template <int X> __device__ __forceinline__ float swz_xor(float v) { return __int_as_float(__builtin_amdgcn_ds_swizzle(__float_as_int(v), (X << 10) | 0x1f)); }
__device__ __forceinline__ float rdlane(float v, int l) { return __int_as_float(__builtin_amdgcn_readlane(__float_as_int(v), l)); }
__device__ __forceinline__ float wave_sum(float v) {
    v += swz_xor<1>(v); v += swz_xor<2>(v); v += swz_xor<4>(v); v += swz_xor<8>(v); v += swz_xor<16>(v);
    return rdlane(v, 0) + rdlane(v, 32);
}
__device__ __forceinline__ float xor32(float v, int lane) { return __int_as_float(__builtin_amdgcn_ds_bpermute((lane ^ 32) << 2, __float_as_int(v))); }
__constant__ double c_invf[32] = {1.0, 0.7498942093324559, 0.5623413251903491, 0.4216965034285822, 0.31622776601683794, 0.23713737056616552, 0.1778279410038923, 0.1333521432163324, 0.1, 0.07498942093324558, 0.05623413251903491, 0.042169650342858224, 0.03162277660168379, 0.023713737056616554, 0.01778279410038923, 0.01333521432163324, 0.01, 0.007498942093324558, 0.005623413251903491, 0.004216965034285823, 0.0031622776601683794, 0.0023713737056616554, 0.0017782794100389228, 0.001333521432163324, 0.001, 0.0007498942093324559, 0.0005623413251903491, 0.00042169650342858224, 0.00031622776601683794, 0.00023713737056616554, 0.00017782794100389227, 0.0001333521432163324};
constexpr int NWAVES = 8, NTHREADS = 512;
constexpr int PH_PRO = 0, PH_PER_LAYER = 9, PH_FINAL = 1 + DEPTH * PH_PER_LAYER, NPH = PH_FINAL + 1;
enum { P_N1 = 0, P_GIN, P_M1, P_M2, P_M3, P_GOUT, P_N2, P_GGU, P_GDN };

__device__ __forceinline__ void phase_prologue(const Args& a, LAS unsigned char* lds, int bid, int G, int tid) {
    const float* c = a.in[1]; const float* w_ada = a.in[5]; const float* b_ada = a.in[6];
    float* mod = (float*)(a.ws + WS_MOD);
    const int wave = tid >> 6, lane = tid & 63;
    LAS float* cact = (LAS float*)lds;
    LAS float* red = (LAS float*)(lds + 8192);
    for (int i = tid; i < NB * D; i += NTHREADS) { const float v = c[i]; cact[i] = siluf(v); }
    __syncthreads();
    for (int it = bid; it < DEPTH * 24; it += G) {
        const int l = it / 24, j0 = (it % 24) * 256;
        const float* W = w_ada + (size_t)l * D * 6144 + j0 + lane * 4;
        f32x4 a0 = {0.f, 0.f, 0.f, 0.f}, a1 = {0.f, 0.f, 0.f, 0.f};
        const int k0 = wave * 128;
#pragma unroll 8
        for (int k = 0; k < 128; ++k) {
            const f32x4 w = *(const f32x4*)(W + (size_t)(k0 + k) * 6144);
            const float c0 = cact[k0 + k], c1 = cact[D + k0 + k];
            a0 += w * c0; a1 += w * c1;
        }
        __syncthreads();
        *(LAS f32x4*)(red + (wave * 2 + 0) * 256 + lane * 4) = a0;
        *(LAS f32x4*)(red + (wave * 2 + 1) * 256 + lane * 4) = a1;
        __syncthreads();
        {
            const int b = tid >> 8, col = tid & 255;
            float s = 0.f;
#pragma unroll
            for (int w = 0; w < 8; ++w) s += red[(w * 2 + b) * 256 + col];
            mod[((size_t)l * NB + b) * 6144 + j0 + col] = s + b_ada[(size_t)l * 6144 + j0 + col];
        }
    }
    if (bid == G - 1 && tid < 256) {
        const float* hl = a.in[14]; float* lb = (float*)(a.ws + WS_LB);
        const float v0 = hl[tid], v1 = hl[256 + tid], v2 = hl[512 + tid], v3 = hl[768 + tid];
        const float m = fmaxf(fmaxf(v0, v1), fmaxf(v2, v3));
        const float e0 = expf(v0 - m), e1 = expf(v1 - m), e2 = expf(v2 - m), e3 = expf(v3 - m);
        const float inv = 1.f / (e0 + e1 + e2 + e3);
        lb[tid] = 0.f; lb[256 + tid] = e1 * inv; lb[512 + tid] = (e1 + e2) * inv; lb[768 + tid] = (e1 + e2 + e3) * inv;
    }
    {
        float* rope = (float*)(a.ws + WS_ROPE);
        for (int i = bid * NTHREADS + tid; i < L * 32; i += G * NTHREADS) {
            const int p = i >> 5, j = i & 31;
            const double f = c_invf[j];
            double r = (double)p * f * 0.15915494309189535;
            r -= floor(r);
            const float rf = (float)r;
            rope[2 * i] = __builtin_amdgcn_cosf(rf); rope[2 * i + 1] = __builtin_amdgcn_sinf(rf);
        }
    }
}

typedef short n2s8 __attribute__((ext_vector_type(8)));
__device__ __forceinline__ void phase_norm1(const Args& a, int layer, LAS unsigned char* lds, int bid, int G, int wave, int lane, bool rerun = false) {
    const float* xin = a.in[0];
    float* xw = (float*)(a.ws + WS_XW);
    const float* mod = (const float*)(a.ws + WS_MOD);
    bf16* h = (bf16*)(a.ws + WS_H);
    float* dtraw = (float*)(a.ws + WS_DT);
    const bf16* Y = (const bf16*)(a.ws + WS_Y);
    const int* eid = (const int*)(a.ws + WS_EID);
    const int* slot = (const int*)(a.ws + WS_SLOT);
    LAS float* part = (LAS float*)lds;
    LAS float* pdt = (LAS float*)(lds + 512);
    int mybase = 0;
    const bool gather = (layer > 0 && !rerun);
    if (gather) {
        const int* cnt = (const int*)(a.ws + WS_CTL) + CW_CNT + (layer - 1) * NE * CNT_STRIDE;
        int pc = (lane < NE) ? ((cnt[lane * CNT_STRIDE] + 255) & ~255) : 0;
        int run = 0;
#pragma unroll
        for (int i = 0; i < NE; ++i) { mybase = (lane == i) ? run : mybase; run += __builtin_amdgcn_readlane(pc, i); }
    }
    const float* gvec = (layer < DEPTH) ? a.in[2] + (size_t)layer * D : a.in[4];
    const bf16* wdt = (const bf16*)(a.ws + WS_WDT) + (size_t)(layer < DEPTH ? layer : 0) * 2 * 16 * D;
    LAS float* vec = (LAS float*)(lds + 32768);
    const int tile = wave >> 1, kh = wave & 1, t = lane & 15, q = lane >> 4;
    for (int blk = bid; blk < T / 64; blk += G) {
        const int row = blk * 64 + tile * 16 + t, b = row >> 13;
        const int cb = 512 * kh + 8 * q;
        if (layer < DEPTH) {
            const float* mbv = mod + ((size_t)layer * NB + b) * 6144;
            for (int i = wave * 64 + lane; i < D; i += NTHREADS) { vec[i] = gvec[i]; vec[D + i] = mbv[i]; vec[2 * D + i] = mbv[D + i] + 1.f; }
        }
        const float* src = ((layer == 0 && !rerun) ? xin : xw) + (size_t)row * D + cb;
        float* xo = xw + (size_t)row * D + cb;
        const bf16* y0p = Y; const bf16* y1p = Y;
        if (gather) {
            const int e0 = eid[2 * row], e1 = eid[2 * row + 1];
            const int b0 = __builtin_amdgcn_ds_bpermute(e0 << 2, mybase), b1 = __builtin_amdgcn_ds_bpermute(e1 << 2, mybase);
            y0p = Y + (size_t)(b0 + slot[2 * row]) * D + cb; y1p = Y + (size_t)(b1 + slot[2 * row + 1]) * D + cb;
        }
        const float* gf = mod + ((size_t)(layer > 0 ? layer - 1 : 0) * NB + b) * 6144 + 5 * D + cb;
        float ss = 0.f;
#pragma unroll 4
        for (int ks = 0; ks < 16; ++ks) {
            f32x4 x0 = *(const f32x4*)(src + 32 * ks), x1 = *(const f32x4*)(src + 32 * ks + 4);
            if (gather) {
                const u32x4 ya = *(const u32x4*)(y0p + 32 * ks), yb = *(const u32x4*)(y1p + 32 * ks);
                const f32x4 g0 = *(const f32x4*)(gf + 32 * ks), g1 = *(const f32x4*)(gf + 32 * ks + 4);
                x0.x += g0.x * (__uint_as_float(ya.x << 16) + __uint_as_float(yb.x << 16)); x0.y += g0.y * (__uint_as_float(ya.x & 0xffff0000u) + __uint_as_float(yb.x & 0xffff0000u));
                x0.z += g0.z * (__uint_as_float(ya.y << 16) + __uint_as_float(yb.y << 16)); x0.w += g0.w * (__uint_as_float(ya.y & 0xffff0000u) + __uint_as_float(yb.y & 0xffff0000u));
                x1.x += g1.x * (__uint_as_float(ya.z << 16) + __uint_as_float(yb.z << 16)); x1.y += g1.y * (__uint_as_float(ya.z & 0xffff0000u) + __uint_as_float(yb.z & 0xffff0000u));
                x1.z += g1.z * (__uint_as_float(ya.w << 16) + __uint_as_float(yb.w << 16)); x1.w += g1.w * (__uint_as_float(ya.w & 0xffff0000u) + __uint_as_float(yb.w & 0xffff0000u));
            }
            if (layer < DEPTH) { *(f32x4*)(xo + 32 * ks) = x0; *(f32x4*)(xo + 32 * ks + 4) = x1; }
            ss += ((x0.x * x0.x + x0.y * x0.y) + (x0.z * x0.z + x0.w * x0.w)) + ((x1.x * x1.x + x1.y * x1.y) + (x1.z * x1.z + x1.w * x1.w));
        }
        ss += swz_xor<16>(ss); ss += xor32(ss, lane);
        if (q == 0) part[(tile * 2 + kh) * 16 + t] = ss;
        __syncthreads();
        const float rstd = rsqrtf((part[(tile * 2) * 16 + t] + part[(tile * 2 + 1) * 16 + t]) * (1.f / D) + EPS);
        if (layer == DEPTH) {
            float* op = a.out + (size_t)row * D + cb;
#pragma unroll 4
            for (int ks = 0; ks < 16; ++ks) {
                f32x4 x0 = *(const f32x4*)(src + 32 * ks), x1 = *(const f32x4*)(src + 32 * ks + 4);
                {
                    const u32x4 ya = *(const u32x4*)(y0p + 32 * ks), yb = *(const u32x4*)(y1p + 32 * ks);
                    const f32x4 g0 = *(const f32x4*)(gf + 32 * ks), g1 = *(const f32x4*)(gf + 32 * ks + 4);
                    x0.x += g0.x * (__uint_as_float(ya.x << 16) + __uint_as_float(yb.x << 16)); x0.y += g0.y * (__uint_as_float(ya.x & 0xffff0000u) + __uint_as_float(yb.x & 0xffff0000u));
                    x0.z += g0.z * (__uint_as_float(ya.y << 16) + __uint_as_float(yb.y << 16)); x0.w += g0.w * (__uint_as_float(ya.y & 0xffff0000u) + __uint_as_float(yb.y & 0xffff0000u));
                    x1.x += g1.x * (__uint_as_float(ya.z << 16) + __uint_as_float(yb.z << 16)); x1.y += g1.y * (__uint_as_float(ya.z & 0xffff0000u) + __uint_as_float(yb.z & 0xffff0000u));
                    x1.z += g1.z * (__uint_as_float(ya.w << 16) + __uint_as_float(yb.w << 16)); x1.w += g1.w * (__uint_as_float(ya.w & 0xffff0000u) + __uint_as_float(yb.w & 0xffff0000u));
                }
                const f32x4 g0 = *(const f32x4*)(gvec + cb + 32 * ks), g1 = *(const f32x4*)(gvec + cb + 32 * ks + 4);
                *(f32x4*)(op + 32 * ks) = x0 * rstd * g0; *(f32x4*)(op + 32 * ks + 4) = x1 * rstd * g1;
            }
            __syncthreads();
            continue;
        }
        const LAS float* vp = vec + cb;
        bf16* hr = h + (size_t)row * D + cb;
        const bf16* wp = wdt + (size_t)t * D + cb;
        f32x4 acc = {0.f, 0.f, 0.f, 0.f};
#pragma unroll 4
        for (int ks = 0; ks < 16; ++ks) {
            unsigned hi[4], lo[4];
#pragma unroll
            for (int e = 0; e < 2; ++e) {
                const f32x4 g = *(const LAS f32x4*)(vp + 32 * ks + 4 * e), sh = *(const LAS f32x4*)(vp + D + 32 * ks + 4 * e), sc1 = *(const LAS f32x4*)(vp + 2 * D + 32 * ks + 4 * e);
                const f32x4 hv = *(const f32x4*)(xo + 32 * ks + 4 * e) * rstd * g * sc1 + sh;
                const unsigned p01 = pk2(hv.x, hv.y), p23 = pk2(hv.z, hv.w);
                hi[2 * e] = p01; hi[2 * e + 1] = p23;
                lo[2 * e] = pk2(hv.x - __uint_as_float(p01 << 16), hv.y - __uint_as_float(p01 & 0xffff0000u)); lo[2 * e + 1] = pk2(hv.z - __uint_as_float(p23 << 16), hv.w - __uint_as_float(p23 & 0xffff0000u));
            }
            const u32x4 hiv = {hi[0], hi[1], hi[2], hi[3]}, lov = {lo[0], lo[1], lo[2], lo[3]};
            *(u32x4*)(hr + 32 * ks) = hiv;
            const n2s8 Ah = __builtin_bit_cast(n2s8, hiv), Al = __builtin_bit_cast(n2s8, lov);
            const n2s8 Bh = *(const n2s8*)(wp + 32 * ks), Bl = *(const n2s8*)(wp + (size_t)16 * D + 32 * ks);
            acc = __builtin_amdgcn_mfma_f32_16x16x32_bf16(Ah, Bh, acc, 0, 0, 0);
            acc = __builtin_amdgcn_mfma_f32_16x16x32_bf16(Ah, Bl, acc, 0, 0, 0);
            acc = __builtin_amdgcn_mfma_f32_16x16x32_bf16(Al, Bh, acc, 0, 0, 0);
        }
#pragma unroll
        for (int r = 0; r < 4; ++r) pdt[((tile * 2 + kh) * 16 + 4 * q + r) * 16 + t] = acc[r];
        __syncthreads();
        {
            const int tid = wave * 64 + lane, tk = tid >> 3, d = tid & 7, tl = tk >> 4, tt = tk & 15;
            dtraw[(size_t)(blk * 64 + tk) * 8 + d] = pdt[((tl * 2) * 16 + tt) * 16 + d] + pdt[((tl * 2 + 1) * 16 + tt) * 16 + d];
        }
        __syncthreads();
    }
}

__device__ __forceinline__ void phase_norm2(const Args& a, int layer, LAS unsigned char* lds, int bid, int G, int wave, int lane, bool rerun = false) {
    const float* xw = (const float*)(a.ws + WS_XW);
    const float* mod = (const float*)(a.ws + WS_MOD);
    bf16* h = (bf16*)(a.ws + WS_H);
    int* eid = (int*)(a.ws + WS_EID); float* ew = (float*)(a.ws + WS_EW);
    int* slot = (int*)(a.ws + WS_SLOT); int* list = (int*)(a.ws + WS_LIST); float* wl = (float*)(a.ws + WS_WL);
    int* cnt = (int*)(a.ws + WS_CTL) + CW_CNT + layer * NE * CNT_STRIDE;
    const float* gvec = a.in[3] + (size_t)layer * D;
    const float* bg = a.in[18] + layer * 4; const float* be = a.in[20] + layer * NE;
    const bf16* wr = (const bf16*)(a.ws + WS_WR) + (size_t)layer * 2 * 48 * D;
    LAS float* part = (LAS float*)lds;
    LAS float* plog = (LAS float*)(lds + 512);
    LAS int* hist = (LAS int*)(lds + 512 + 4 * 2 * 16 * 48 * 4);
    LAS float* vec = (LAS float*)(lds + 32768);
    const int tile = wave >> 1, kh = wave & 1, t = lane & 15, q = lane >> 4, tid = wave * 64 + lane;
    for (int blk = bid; blk < T / 64; blk += G) {
        const int row = blk * 64 + tile * 16 + t, b = row >> 13;
        {
            const float* mbv = mod + ((size_t)layer * NB + b) * 6144 + 3 * D;
            for (int i = tid; i < D; i += NTHREADS) { vec[i] = gvec[i]; vec[D + i] = mbv[i]; vec[2 * D + i] = mbv[D + i] + 1.f; }
        }
        const float* xr = xw + (size_t)row * D + 512 * kh + 8 * q;
        float ss = 0.f;
#pragma unroll 8
        for (int ks = 0; ks < 16; ++ks) {
            const f32x4 x0 = *(const f32x4*)(xr + 32 * ks), x1 = *(const f32x4*)(xr + 32 * ks + 4);
            ss += ((x0.x * x0.x + x0.y * x0.y) + (x0.z * x0.z + x0.w * x0.w)) + ((x1.x * x1.x + x1.y * x1.y) + (x1.z * x1.z + x1.w * x1.w));
        }
        ss += swz_xor<16>(ss); ss += xor32(ss, lane);
        if (tid < 32) hist[tid] = 0;
        if (q == 0) part[(tile * 2 + kh) * 16 + t] = ss;
        __syncthreads();
        const float rstd = rsqrtf((part[(tile * 2) * 16 + t] + part[(tile * 2 + 1) * 16 + t]) * (1.f / D) + EPS);
        const LAS float* vp = vec + 512 * kh + 8 * q;
        bf16* hr = h + (size_t)row * D + 512 * kh + 8 * q;
        const bf16* wp = wr + (size_t)t * D + 512 * kh + 8 * q;
        f32x4 acc[3] = {{0.f, 0.f, 0.f, 0.f}, {0.f, 0.f, 0.f, 0.f}, {0.f, 0.f, 0.f, 0.f}};
#pragma unroll 4
        for (int ks = 0; ks < 16; ++ks) {
            unsigned hi[4], lo[4];
#pragma unroll
            for (int e = 0; e < 2; ++e) {
                const f32x4 g = *(const LAS f32x4*)(vp + 32 * ks + 4 * e), sh = *(const LAS f32x4*)(vp + D + 32 * ks + 4 * e), sc1 = *(const LAS f32x4*)(vp + 2 * D + 32 * ks + 4 * e);
                const f32x4 hv = *(const f32x4*)(xr + 32 * ks + 4 * e) * rstd * g * sc1 + sh;
                const unsigned p01 = pk2(hv.x, hv.y), p23 = pk2(hv.z, hv.w);
                hi[2 * e] = p01; hi[2 * e + 1] = p23;
                lo[2 * e] = pk2(hv.x - __uint_as_float(p01 << 16), hv.y - __uint_as_float(p01 & 0xffff0000u)); lo[2 * e + 1] = pk2(hv.z - __uint_as_float(p23 << 16), hv.w - __uint_as_float(p23 & 0xffff0000u));
            }
            const u32x4 hiv = {hi[0], hi[1], hi[2], hi[3]}, lov = {lo[0], lo[1], lo[2], lo[3]};
            *(u32x4*)(hr + 32 * ks) = hiv;
            const n2s8 Ah = __builtin_bit_cast(n2s8, hiv), Al = __builtin_bit_cast(n2s8, lov);
#pragma unroll
            for (int nt = 0; nt < 3; ++nt) {
                const n2s8 Bh = *(const n2s8*)(wp + (size_t)(16 * nt) * D + 32 * ks), Bl = *(const n2s8*)(wp + (size_t)(48 + 16 * nt) * D + 32 * ks);
                acc[nt] = __builtin_amdgcn_mfma_f32_16x16x32_bf16(Ah, Bh, acc[nt], 0, 0, 0);
                acc[nt] = __builtin_amdgcn_mfma_f32_16x16x32_bf16(Ah, Bl, acc[nt], 0, 0, 0);
                acc[nt] = __builtin_amdgcn_mfma_f32_16x16x32_bf16(Al, Bh, acc[nt], 0, 0, 0);
            }
        }
#pragma unroll
        for (int nt = 0; nt < 3; ++nt)
#pragma unroll
            for (int r = 0; r < 4; ++r) plog[((tile * 2 + kh) * 16 + 4 * q + r) * 48 + 16 * nt + t] = acc[nt][r];
        __syncthreads();
        int e0 = 0, e1 = 0, r0 = 0, r1 = 0; float w0 = 0.f, w1 = 0.f;
        const bool router = (kh == 0 && lane < 16 && !rerun);
        const int rrow = blk * 64 + tile * 16 + lane;
        if (router) {
            const LAS float* p0 = plog + ((tile * 2) * 16 + lane) * 48; const LAS float* p1 = p0 + 16 * 48;
            float lg[4];
#pragma unroll
            for (int i = 0; i < 4; ++i) lg[i] = p0[32 + i] + p1[32 + i] + bg[i];
            int gi = 0; float gm = lg[0];
#pragma unroll
            for (int i = 1; i < 4; ++i) if (lg[i] > gm) { gm = lg[i]; gi = i; }
            float se = 0.f;
#pragma unroll
            for (int i = 0; i < 4; ++i) se += expf(lg[i] - gm);
            const float pg = 1.f / se;
            float ig[8];
#pragma unroll
            for (int i = 0; i < 8; ++i) ig[i] = p0[gi * 8 + i] + p1[gi * 8 + i] + be[gi * 8 + i];
            int i0 = 0; float v0 = ig[0];
#pragma unroll
            for (int i = 1; i < 8; ++i) if (ig[i] > v0) { v0 = ig[i]; i0 = i; }
            int i1 = -1; float v1 = -3.0e38f;
#pragma unroll
            for (int i = 0; i < 8; ++i) if (i != i0 && ig[i] > v1) { v1 = ig[i]; i1 = i; }
            const float ex = expf(v1 - v0);
            w0 = pg / (1.f + ex); w1 = pg * ex / (1.f + ex);
            e0 = gi * 8 + i0; e1 = gi * 8 + i1;
            r0 = __hip_atomic_fetch_add(&hist[e0], 1, __ATOMIC_RELAXED, __HIP_MEMORY_SCOPE_WORKGROUP); r1 = __hip_atomic_fetch_add(&hist[e1], 1, __ATOMIC_RELAXED, __HIP_MEMORY_SCOPE_WORKGROUP);
        }
        __syncthreads();
        if (tid < 32) { const int c = hist[tid]; hist[32 + tid] = c ? atomicAdd(&cnt[tid * CNT_STRIDE], c) : 0; }
        __syncthreads();
        if (router) {
            const int s0 = hist[32 + e0] + r0, s1 = hist[32 + e1] + r1;
            eid[2 * rrow] = e0; eid[2 * rrow + 1] = e1; ew[2 * rrow] = w0; ew[2 * rrow + 1] = w1; slot[2 * rrow] = s0; slot[2 * rrow + 1] = s1;
            list[(size_t)e0 * T + s0] = rrow; wl[(size_t)e0 * T + s0] = w0; list[(size_t)e1 * T + s1] = rrow; wl[(size_t)e1 * T + s1] = w1;
        }
        __syncthreads();
    }
}

#define XB_TMO      128
#define XB_XCNT(j)  (256  + 64 * (j))
#define XB_XSUB(j)  (1280 + 64 * (j))
#define XB_XGEN(j)  (2304 + 64 * (j))
#define XB_TOP      3328
#define XB_TOPGEN   3392
#define XCD_BAR_WORDS 3456
#define XB_SPIN_CAP (1u << 18)

__device__ __forceinline__ unsigned xb_ld(unsigned* p)              { return __hip_atomic_load(p, __ATOMIC_RELAXED, __HIP_MEMORY_SCOPE_AGENT); }
__device__ __forceinline__ unsigned xb_add(unsigned* p, unsigned v) { return __hip_atomic_fetch_add(p, v, __ATOMIC_RELAXED, __HIP_MEMORY_SCOPE_AGENT); }
__device__ __forceinline__ unsigned xb_xcc_id() { return (unsigned)__builtin_amdgcn_s_getreg((3 << 11) | 20) & 0xFu; }
#define XB_SPIN(cond, bar) do { unsigned _sp = 0; while (cond) { __builtin_amdgcn_s_sleep(1); \
    if ((++_sp & 255u) == 0u) { if (xb_ld(&(bar)[XB_TMO])) break; if (_sp > XB_SPIN_CAP) { atomicAdd(&(bar)[XB_TMO], 1u); break; } } } } while (0)

struct XcdBarrier {
    unsigned* bar; unsigned x;
    volatile LAS unsigned* st;
};

__device__ __forceinline__ XcdBarrier xcd_barrier_post(unsigned* bar, volatile LAS unsigned* st) {
    XcdBarrier b; b.bar = bar; b.x = xb_xcc_id(); b.st = st;
    if (threadIdx.x == 0) (void)xb_add(&bar[XB_XCNT(b.x)], 1u);
    return b;
}
__device__ __forceinline__ void xcd_barrier_complete(unsigned* bar, unsigned x, unsigned& nloc, unsigned& nx) {
    const unsigned G = gridDim.x * gridDim.y * gridDim.z;
    unsigned sum, cnt, mine, sp = 0u;
    for (;;) {
        sum = 0u; cnt = 0u; mine = 0u;
#pragma unroll
        for (unsigned j = 0; j < 16; ++j) { const unsigned c = xb_ld(&bar[XB_XCNT(j)]); sum += c; cnt += (c > 0u) ? 1u : 0u; mine = (j == x) ? c : mine; }
        if (sum == G) break;
        __builtin_amdgcn_s_sleep(1);
        if ((++sp & 255u) == 0u) { if (xb_ld(&bar[XB_TMO])) break; if (sp > XB_SPIN_CAP) { atomicAdd(&bar[XB_TMO], 1u); break; } }
    }
    nloc = mine > 0u ? mine : 1u; nx = cnt > 0u ? cnt : 1u;
}

__device__ __forceinline__ void xcd_barrier(const XcdBarrier& b) {
    asm volatile("s_waitcnt vmcnt(0)" ::: "memory");
    __syncthreads();
    if (threadIdx.x == 0) {
        unsigned* bar = b.bar;
        __builtin_amdgcn_s_waitcnt(0);
        unsigned nloc = b.st[0], nx = b.st[1];
        if (nloc == 0u) { xcd_barrier_complete(bar, b.x, nloc, nx); b.st[0] = nloc; b.st[1] = nx; }
        const unsigned old = xb_add(&bar[XB_XSUB(b.x)], 1u);
        const unsigned gen = old / nloc;
        if (old + 1u == (gen + 1u) * nloc) {
            __builtin_amdgcn_fence(__ATOMIC_RELEASE, "agent");
            asm volatile("s_waitcnt vmcnt(0)" ::: "memory");
            const unsigned og = xb_add(&bar[XB_TOP], 1u);
            const unsigned tg = og / nx;
            if (og + 1u == (tg + 1u) * nx) xb_add(&bar[XB_TOPGEN], 1u);
            else XB_SPIN(xb_ld(&bar[XB_TOPGEN]) == tg, bar);
            __builtin_amdgcn_fence(__ATOMIC_ACQUIRE, "agent");
            xb_add(&bar[XB_XGEN(b.x)], 1u);
            asm volatile("s_waitcnt vmcnt(0)" ::: "memory");
        } else {
            XB_SPIN(xb_ld(&bar[XB_XGEN(b.x)]) == gen, bar);
            __builtin_amdgcn_fence(__ATOMIC_ACQUIRE, "agent");
            asm volatile("s_waitcnt vmcnt(0)" ::: "memory");
        }
    }
    __syncthreads();
}

namespace pg8 {
typedef unsigned short bf16_t;
typedef short bf16x8 __attribute__((ext_vector_type(8)));
constexpr int BM = 256, BK = 64, HALF = 128, HTB = HALF * BK * 2  , STAGE_BYTES = 8 * HTB, NXCD = 8, WGM = 8;

__host__ __device__ __forceinline__ int lds_byte(int r, int c) { const int st = (r >> 4) * 2 + (c >> 5), rr = r & 15, cc = c & 31, ob = rr * 64 + cc * 2; return st * 1024 + (ob ^ (((ob >> 9) & 1) << 5)); }
__host__ __device__ __forceinline__ void stage_rc(int b, int& R, int& C) { const int st = b / 1024, sb = b % 1024, swz = sb ^ (((sb >> 9) & 1) << 5); R = (st >> 1) * 16 + swz / 64; C = (st & 1) * 32 + (swz % 64) / 2; }
__host__ __device__ __forceinline__ int perm32(int rho) { const int n = rho >> 4, i = rho & 15; return 8 * (i >> 2) + 4 * n + (i & 3); }

struct Unit { int pm, pn, e, lu; };
struct Gemm { const bf16_t* A; const bf16_t* Bt; int K; size_t strideB; };

struct StaticOrder {
    int nM, nN, nwg, G, c;
    __host__ __device__ void init(int M, int N, int G_, int c_) { nM = M / BM; nN = N / BM; nwg = nM * nN; G = G_; c = c_; }
    __host__ __device__ bool next(int i, Unit& u) const {
        const long L = (long)i * G + c; if (L >= nwg) return false;
        int wgid = (int)L; { const int q = nwg / NXCD, r = nwg % NXCD, xcd = wgid % NXCD, off = wgid / NXCD; wgid = (xcd < r ? xcd * (q + 1) : r * (q + 1) + (xcd - r) * q) + off; }
        const int nig = WGM * nN, gid = wgid / nig, fm = gid * WGM, gsz = (nM - fm) < WGM ? (nM - fm) : WGM;
        u.pm = fm + ((wgid % nig) % gsz); u.pn = (wgid % nig) / gsz; u.e = 0; u.lu = 0; return true;
    }
};
struct GroupOrder {
    const LAS int* tstart; int NT, total, G, c;
    __device__ __forceinline__ bool next(int i, Unit& u) const {
        const int Lx = i * G + c; if (Lx >= total) return false;
        const int PM = Lx / NT; u.pn = Lx - PM * NT; u.pm = PM;
        int e = 0; while (__builtin_amdgcn_readfirstlane(tstart[e + 1]) <= PM) ++e;
        u.e = e; u.lu = i; return true;
    }
};

__device__ __forceinline__ unsigned cvt_pk_bf16(float lo, float hi) { unsigned r; asm volatile("v_cvt_pk_bf16_f32 %0, %1, %2" : "=v"(r) : "v"(lo), "v"(hi)); return r; }

struct EpiStoreBf16 {
    static constexpr bool PERM = true;
    bf16_t* O; int ldc;
    __device__ __forceinline__ void operator()(const f32x4 (&acc)[2][2][4][2], const Unit& u, int wr, int wc, int fr, int fq) const {
        const int row0 = u.pm * BM + wr * 64 + fr, col0 = u.pn * BM + wc * 32 + 8 * fq;
#pragma unroll
        for (int ai = 0; ai < 2; ++ai)
#pragma unroll
            for (int m = 0; m < 4; ++m) { bf16_t* rowp = O + (size_t)(row0 + ai * HALF + m * 16) * ldc + col0;
#pragma unroll
                for (int bj = 0; bj < 2; ++bj) { const f32x4 v0 = acc[ai][bj][m][0], v1 = acc[ai][bj][m][1];
                    u32x4 w; w.x = cvt_pk_bf16(v0[0], v0[1]); w.y = cvt_pk_bf16(v0[2], v0[3]); w.z = cvt_pk_bf16(v1[0], v1[1]); w.w = cvt_pk_bf16(v1[2], v1[3]);
                    *(u32x4*)(rowp + bj * HALF) = w; } }
    }
};
struct EpiResid {
    static constexpr bool PERM = false;
    float* X; const float* gate;
    __device__ __forceinline__ void operator()(const f32x4 (&acc)[2][2][4][2], const Unit& u, int wr, int wc, int fr, int fq) const {
        const int row0 = u.pm * BM + wr * 64 + fr, col0 = u.pn * BM + wc * 32 + 4 * fq;
        const int b = (u.pm * BM) >> 13;
        f32x4 gv[2][2];
#pragma unroll
        for (int bj = 0; bj < 2; ++bj)
#pragma unroll
            for (int n = 0; n < 2; ++n) gv[bj][n] = *(const f32x4*)(gate + (size_t)b * 6144 + col0 + bj * HALF + n * 16);
#pragma unroll
        for (int ai = 0; ai < 2; ++ai)
#pragma unroll
            for (int m = 0; m < 4; ++m) { float* rowp = X + (size_t)(row0 + ai * HALF + m * 16) * D + col0; f32x4 xv[2][2];
#pragma unroll
                for (int bj = 0; bj < 2; ++bj)
#pragma unroll
                    for (int n = 0; n < 2; ++n) xv[bj][n] = *(const f32x4*)(rowp + bj * HALF + n * 16);
#pragma unroll
                for (int bj = 0; bj < 2; ++bj)
#pragma unroll
                    for (int n = 0; n < 2; ++n) *(f32x4*)(rowp + bj * HALF + n * 16) = xv[bj][n] + gv[bj][n] * acc[ai][bj][m][n]; }
    }
};
struct EpiGU {
    static constexpr bool PERM = true;
    bf16_t* H; const LAS float* tabw;
    __device__ __forceinline__ void operator()(const f32x4 (&acc)[2][2][4][2], const Unit& u, int wr, int wc, int fr, int fq) const {
#pragma unroll
        for (int ai = 0; ai < 2; ++ai)
#pragma unroll
            for (int m = 0; m < 4; ++m) {
                const int rl = ai * HALF + wr * 64 + m * 16 + fr;
                const float w = tabw[u.lu * 256 + rl];
                bf16_t* rowp = H + (size_t)(u.pm * BM + rl) * DE + u.pn * HALF + wc * 32 + 8 * fq;
                float o[8];
#pragma unroll
                for (int n = 0; n < 2; ++n)
#pragma unroll
                    for (int j = 0; j < 4; ++j) { const float g = acc[ai][0][m][n][j], up = acc[ai][1][m][n][j]; o[n * 4 + j] = g * __builtin_amdgcn_rcpf(1.f + __builtin_amdgcn_exp2f(-1.4426950408889634f * g)) * up * w; }
                u32x4 wv; wv.x = cvt_pk_bf16(o[0], o[1]); wv.y = cvt_pk_bf16(o[2], o[3]); wv.z = cvt_pk_bf16(o[4], o[5]); wv.w = cvt_pk_bf16(o[6], o[7]);
                *(u32x4*)rowp = wv;
            }
    }
};

template <class Epi, class Sched, bool GATHER, bool ALIGN_EPI>
__device__ __forceinline__ void gemm_phase(LAS unsigned char* lds, const Gemm g, const Sched& S, const Epi& E, const LAS unsigned* taboff, int wave_id) {
    int lane = __builtin_amdgcn_mbcnt_hi(~0u, __builtin_amdgcn_mbcnt_lo(~0u, 0u)); asm volatile("" : "+v"(lane));
    const int wid = wave_id, tid = wid * 64 + lane, wr = wid >> 2, wc = wid & 3, fr = lane & 15, fq = lane >> 4;
    const int K = g.K, nt = K / BK;
    unsigned voffA[2], voffB[2]; int RA[2]; unsigned cA2[2];
#pragma unroll
    for (int i = 0; i < 2; ++i) { int R, C; stage_rc(tid * 16 + i * 8192, R, C); const int Rb = Epi::PERM ? ((R & ~31) + perm32(R & 31)) : R;
        voffA[i] = (unsigned)(R * K + C) * 2u; voffB[i] = (unsigned)(Rb * K + C) * 2u; RA[i] = R; cA2[i] = (unsigned)C * 2u; }
    const size_t kstep = (size_t)(BK * 2);
    const size_t hstep = (size_t)HALF * K * 2;
    const size_t tstep = 2 * hstep;
    const unsigned ldsw = (unsigned)wid * 1024u;
    const int aoff = lds_byte(wr * 64 + fr, fq * 8), boff = lds_byte(wc * 32 + fr, fq * 8);
#define PG8_SA(b, h) (((b) * 2 + (h)) * HTB)
#define PG8_SB(b, h) ((4 + (b) * 2 + (h)) * HTB)
#define PG8_STAGE(bufoff, gbase, voff) do { _Pragma("unroll") for (int _i = 0; _i < 2; ++_i) \
        __builtin_amdgcn_global_load_lds((const unsigned*)((const char*)(gbase) + (voff)[_i]), (LAS unsigned*)(lds + (bufoff) + ldsw + _i * 8192), 16, 0, 0); } while (0)
#define PG8_STAGE_A(bufoff, ap, h, GO) do { if constexpr (GATHER) { PG8_STAGE(bufoff, ap, (GO)[h]); } else { PG8_STAGE(bufoff, (ap) + (h) * hstep, voffA); } } while (0)
#define PG8_LDA(dst, b, h) do { _Pragma("unroll") for (int m = 0; m < 4; ++m) _Pragma("unroll") for (int k = 0; k < 2; ++k) dst[m][k] = *(const LAS bf16x8*)(lds + PG8_SA(b, h) + aoff + m * 2048 + k * 1024); } while (0)
#define PG8_LDB(dst, b, h) do { _Pragma("unroll") for (int n = 0; n < 2; ++n) _Pragma("unroll") for (int k = 0; k < 2; ++k) dst[n][k] = *(const LAS bf16x8*)(lds + PG8_SB(b, h) + boff + n * 2048 + k * 1024); } while (0)
#define PG8_MMA(ai, bj, At, Bt) do { __builtin_amdgcn_s_setprio(1); _Pragma("unroll") for (int m = 0; m < 4; ++m) _Pragma("unroll") for (int n = 0; n < 2; ++n) _Pragma("unroll") for (int k = 0; k < 2; ++k) \
        acc[ai][bj][m][n] = __builtin_amdgcn_mfma_f32_16x16x32_bf16(Bt[n][k], At[m][k], acc[ai][bj][m][n], 0, 0, 0); __builtin_amdgcn_s_setprio(0); } while (0)
#define PG8_WAIT_V(n) asm volatile("s_waitcnt vmcnt(" #n ")" ::: "memory")
#define PG8_WAIT_L(n) asm volatile("s_waitcnt lgkmcnt(" #n ")" ::: "memory")
#define PG8_BAR __builtin_amdgcn_s_barrier()
#define PG8_SCHED __builtin_amdgcn_sched_barrier(0)
#define PG8_GOLOAD(dst, un) do { _Pragma("unroll") for (int _h = 0; _h < 2; ++_h) _Pragma("unroll") for (int _i = 0; _i < 2; ++_i) dst[_h][_i] = taboff[(un).lu * 256 + _h * HALF + RA[_i]] + cA2[_i]; } while (0)
    Unit cur, nxt; int ui = 0;
    if (!S.next(0, cur)) return;
    f32x4 acc[2][2][4][2];
#pragma unroll
    for (int a = 0; a < 2; ++a)
#pragma unroll
        for (int b = 0; b < 2; ++b)
#pragma unroll
            for (int m = 0; m < 4; ++m)
#pragma unroll
                for (int n = 0; n < 2; ++n) acc[a][b][m][n] = (f32x4){0.f, 0.f, 0.f, 0.f};
    bf16x8 At[4][2], B0[2][2], B1[2][2];
    unsigned goC[2][2] = {{0u, 0u}, {0u, 0u}}, goN[2][2] = {{0u, 0u}, {0u, 0u}};
    const char* cA = GATHER ? (const char*)g.A : (const char*)g.A + (size_t)cur.pm * tstep;
    const char* cB = (const char*)g.Bt + (size_t)cur.e * g.strideB + (size_t)cur.pn * tstep;
    if constexpr (GATHER) { PG8_GOLOAD(goC, cur); PG8_WAIT_L(0); }
    PG8_STAGE(PG8_SB(0, 0), cB, voffB); PG8_STAGE(PG8_SB(0, 1), cB + hstep, voffB); PG8_STAGE_A(PG8_SA(0, 0), cA, 0, goC); PG8_STAGE_A(PG8_SA(0, 1), cA, 1, goC);
    if (wr == 1) PG8_BAR;
    PG8_WAIT_V(2); PG8_BAR;
    PG8_STAGE(PG8_SB(1, 0), cB + kstep, voffB); PG8_STAGE_A(PG8_SA(1, 0), cA + kstep, 0, goC); PG8_STAGE(PG8_SB(1, 1), cB + hstep + kstep, voffB);
    PG8_WAIT_V(6); PG8_BAR;
    for (;;) {
        const bool has_next = S.next(ui + 1, nxt);
        const char* nA = GATHER ? (const char*)g.A : (has_next ? (const char*)g.A + (size_t)nxt.pm * tstep : cA);
        const char* nB = has_next ? (const char*)g.Bt + (size_t)nxt.e * g.strideB + (size_t)nxt.pn * tstep : cB;
        if constexpr (GATHER) {
            if (has_next) { PG8_GOLOAD(goN, nxt); }
            else {
#pragma unroll
                for (int _h = 0; _h < 2; ++_h)
#pragma unroll
                    for (int _i = 0; _i < 2; ++_i) goN[_h][_i] = goC[_h][_i];
            }
        }
#pragma unroll 1
        for (int t = 0; t < nt; t += 2) {
            const bool last = (t == nt - 2);
            const char* a1 = cA + (size_t)(t + 1) * kstep;
            const char* a2 = last ? nA : cA + (size_t)(t + 2) * kstep; const char* b2 = last ? nB : cB + (size_t)(t + 2) * kstep;
            const char* a3 = a2 + kstep; const char* b3 = b2 + kstep;
            unsigned go2[2][2];
#pragma unroll
            for (int _h = 0; _h < 2; ++_h)
#pragma unroll
                for (int _i = 0; _i < 2; ++_i) go2[_h][_i] = last ? goN[_h][_i] : goC[_h][_i];
            PG8_LDB(B0, 0, 0); PG8_LDB(B1, 0, 1); PG8_SCHED; PG8_LDA(At, 0, 0); PG8_STAGE_A(PG8_SA(1, 1), a1, 1, goC);
            PG8_WAIT_V(8); PG8_WAIT_L(0); PG8_BAR; PG8_MMA(0, 0, At, B0); PG8_MMA(0, 1, At, B1); PG8_BAR; PG8_SCHED;
            PG8_LDA(At, 0, 1); PG8_STAGE(PG8_SB(0, 0), b2, voffB); PG8_STAGE(PG8_SB(0, 1), b2 + hstep, voffB); PG8_STAGE_A(PG8_SA(0, 0), a2, 0, go2);
            PG8_WAIT_V(8); PG8_WAIT_L(0); PG8_BAR; PG8_MMA(1, 0, At, B0); PG8_MMA(1, 1, At, B1); PG8_BAR; PG8_SCHED;
            PG8_LDB(B0, 1, 0); PG8_LDB(B1, 1, 1); PG8_SCHED; PG8_LDA(At, 1, 0); PG8_STAGE_A(PG8_SA(0, 1), a2, 1, go2);
            PG8_WAIT_V(8); PG8_WAIT_L(0); PG8_BAR; PG8_MMA(0, 0, At, B0); PG8_MMA(0, 1, At, B1); PG8_BAR; PG8_SCHED;
            PG8_LDA(At, 1, 1); PG8_STAGE(PG8_SB(1, 0), b3, voffB); PG8_STAGE(PG8_SB(1, 1), b3 + hstep, voffB); PG8_STAGE_A(PG8_SA(1, 0), a3, 0, go2);
            PG8_WAIT_V(8); PG8_WAIT_L(0); PG8_BAR; PG8_MMA(1, 0, At, B0); PG8_MMA(1, 1, At, B1); PG8_BAR; PG8_SCHED;
        }
        if constexpr (ALIGN_EPI) { if (wr == 0) PG8_BAR; }
        E(acc, cur, wr, wc, fr, fq);
        if (!has_next) break;
#pragma unroll
        for (int a = 0; a < 2; ++a)
#pragma unroll
            for (int b = 0; b < 2; ++b)
#pragma unroll
                for (int m = 0; m < 4; ++m)
#pragma unroll
                    for (int n = 0; n < 2; ++n) acc[a][b][m][n] = (f32x4){0.f, 0.f, 0.f, 0.f};
        cur = nxt; cA = nA; cB = nB; ++ui;
#pragma unroll
        for (int _h = 0; _h < 2; ++_h)
#pragma unroll
            for (int _i = 0; _i < 2; ++_i) goC[_h][_i] = goN[_h][_i];
        if constexpr (ALIGN_EPI) { if (wr == 1) PG8_BAR; }
    }
    PG8_WAIT_V(0);
    if constexpr (!ALIGN_EPI) { if (wr == 0) PG8_BAR; }
    PG8_BAR;
#undef PG8_SA
#undef PG8_SB
#undef PG8_STAGE
#undef PG8_STAGE_A
#undef PG8_LDA
#undef PG8_LDB
#undef PG8_MMA
#undef PG8_WAIT_V
#undef PG8_WAIT_L
#undef PG8_BAR
#undef PG8_SCHED
#undef PG8_GOLOAD
}
}

__device__ __forceinline__ void cvt_tile(const float* Wsrc, int ldn, bf16* dst, int Kd, LAS float* scr, int lane) {
#pragma unroll 8
    for (int i = 0; i < 32; ++i) { const int kk = 2 * i + (lane >> 5); scr[kk * 33 + (lane & 31)] = Wsrc[(size_t)kk * ldn + (lane & 31)]; }
    asm volatile("s_waitcnt lgkmcnt(0)" ::: "memory");
    const int c = lane & 7;
#pragma unroll
    for (int j = 0; j < 4; ++j) { const int n = (lane >> 3) + 8 * j; const LAS float* s = scr + (8 * c) * 33 + n;
        u32x4 o; o.x = pk2(s[0 * 33], s[1 * 33]); o.y = pk2(s[2 * 33], s[3 * 33]); o.z = pk2(s[4 * 33], s[5 * 33]); o.w = pk2(s[6 * 33], s[7 * 33]);
        *(u32x4*)(dst + (size_t)n * Kd + 8 * c) = o; }
    asm volatile("s_waitcnt lgkmcnt(0)" ::: "memory");
}
constexpr int CV_IN = 16 * 104, CV_OUT = 16 * 32, CV_GU = NE * 256, CV_DN = NE * 128, CV_LAYER = CV_IN + CV_OUT + CV_GU + CV_DN;
__device__ __forceinline__ void cvt_item(const Args& a, int l, int r, LAS float* scr, int lane) {
    if (r < CV_IN) {
        const int kb = r / 104, nb = r % 104, nd = nb * 32, ns = nd + (nd >= R_DT ? 8 : 0);
        cvt_tile(a.in[7] + (size_t)l * D * DIN + (size_t)kb * 64 * DIN + ns, DIN, (bf16*)(a.ws + WS_WIN) + (size_t)l * NP * D + (size_t)nd * D + kb * 64, D, scr, lane); return; }
    r -= CV_IN;
    if (r < CV_OUT) {
        const int kb = r / 32, nb = r % 32;
        cvt_tile(a.in[16] + (size_t)l * D * D + (size_t)kb * 64 * D + nb * 32, D, (bf16*)(a.ws + WS_WOUT) + (size_t)l * D * D + (size_t)nb * 32 * D + kb * 64, D, scr, lane); return; }
    r -= CV_OUT;
    if (r < CV_GU) {
        const int e = r / 256, q = r % 256, kb = q / 16, nb = q % 16, pn = nb / 8, half = (nb % 8) / 4, i0 = (nb % 4) * 32;
        const float* W = (half ? a.in[22] : a.in[21]) + ((size_t)l * NE + e) * D * DE;
        cvt_tile(W + (size_t)kb * 64 * DE + pn * 128 + i0, DE, (bf16*)(a.ws + WS_WGU) + ((size_t)l * NE + e) * 512 * D + (size_t)nb * 32 * D + kb * 64, D, scr, lane); return; }
    r -= CV_GU;
    {
        const int e = r / 128, q = r % 128, kb = q / 32, nb = q % 32;
        const float* W = a.in[23] + ((size_t)l * NE + e) * DE * D;
        cvt_tile(W + (size_t)kb * 64 * D + nb * 32, D, (bf16*)(a.ws + WS_WD) + ((size_t)l * NE + e) * D * DE + (size_t)nb * 32 * DE + kb * 64, DE, scr, lane);
    }
}
__device__ __forceinline__ void convert_router(const Args& a, int gtid, int gthreads) {
    bf16* wr = (bf16*)(a.ws + WS_WR);
    for (int i = gtid; i < DEPTH * 48 * D; i += gthreads) {
        const int l = i / (48 * D), n = (i / D) % 48, k = i % D;
        float w = 0.f;
        if (n < 32) w = a.in[19][((size_t)l * D + k) * NE + n]; else if (n < 36) w = a.in[17][((size_t)l * D + k) * 4 + (n - 32)];
        const unsigned hi = f2bf(w);
        wr[((size_t)l * 2 * 48 + n) * D + k] = (bf16)hi;
        wr[((size_t)l * 2 * 48 + 48 + n) * D + k] = (bf16)f2bf(w - __uint_as_float(hi << 16));
    }
}
__device__ __forceinline__ void convert_dt(const Args& a, int gtid, int gthreads) {
    bf16* wd = (bf16*)(a.ws + WS_WDT);
    for (int i = gtid; i < DEPTH * 16 * D; i += gthreads) {
        const int l = i / (16 * D), n = (i / D) % 16, k = i % D;
        const float w = (n < 8) ? a.in[7][((size_t)l * D + k) * DIN + R_DT + n] : 0.f;
        const unsigned hi = f2bf(w);
        wd[((size_t)l * 2 * 16 + n) * D + k] = (bf16)hi;
        wd[((size_t)l * 2 * 16 + 16 + n) * D + k] = (bf16)f2bf(w - __uint_as_float(hi << 16));
    }
}
__device__ __forceinline__ void phase_convert(const Args& a, LAS unsigned char* lds, int gw, int ngw, int wave, int lane) {
    convert_router(a, gw * 64 + lane, ngw * 64);
    convert_dt(a, gw * 64 + lane, ngw * 64);
    LAS float* scr = (LAS float*)(lds + LDS_STAGE + 32768 + wave * 8704);
    for (int it = gw; it < DEPTH * CV_LAYER; it += ngw) cvt_item(a, it / CV_LAYER, it % CV_LAYER, scr, lane);
}

__device__ __forceinline__ void phase_gemm_in(const Args& a, int layer, LAS unsigned char* lds, int G, int bid, int wave) {
    pg8::Gemm g{(const bf16*)(a.ws + WS_H), (const bf16*)(a.ws + WS_WIN) + (size_t)layer * NP * D, D, 0};
    pg8::StaticOrder S; S.init(T, NP, G, bid);
    pg8::EpiStoreBf16 E{(bf16*)(a.ws + WS_PROJ), NP};
    pg8::gemm_phase<pg8::EpiStoreBf16, pg8::StaticOrder, false, true>(lds + LDS_STAGE, g, S, E, nullptr, wave);
}
__device__ __forceinline__ void phase_gemm_out(const Args& a, int layer, LAS unsigned char* lds, int G, int bid, int wave) {
    pg8::Gemm g{(const bf16*)(a.ws + WS_MIXED), (const bf16*)(a.ws + WS_WOUT) + (size_t)layer * D * D, D, 0};
    pg8::StaticOrder S; S.init(T, D, G, bid);
    pg8::EpiResid E{(float*)(a.ws + WS_XW), (const float*)(a.ws + WS_MOD) + (size_t)layer * NB * 6144 + 2 * D};
    pg8::gemm_phase<pg8::EpiResid, pg8::StaticOrder, false, false>(lds + LDS_STAGE, g, S, E, nullptr, wave);
}
__device__ __forceinline__ void build_tstart(const int* cnt, LAS int* tstart, int tid) {
    if (tid == 0) { int s = 0; for (int e = 0; e < NE; ++e) { tstart[e] = s; s += (cnt[e * CNT_STRIDE] + 255) >> 8; } tstart[NE] = s; }
    __syncthreads();
}
constexpr int MAXU = 4;
__device__ __forceinline__ void phase_gemm_gu(const Args& a, int layer, LAS unsigned char* lds, int G, int bid, int tid, int wave) {
    const int* cnt = (const int*)(a.ws + WS_CTL) + CW_CNT + layer * NE * CNT_STRIDE;
    LAS int* tstart = (LAS int*)(lds + LDS_TSTART);
    LAS unsigned* taboff = (LAS unsigned*)(lds + LDS_TAB);
    LAS float* tabw = (LAS float*)(lds + LDS_TAB + MAXU * 1024);
    build_tstart(cnt, tstart, tid);
    pg8::GroupOrder S{tstart, 2, __builtin_amdgcn_readfirstlane(tstart[NE]) * 2, G, bid};
    const int* list = (const int*)(a.ws + WS_LIST); const float* wl = (const float*)(a.ws + WS_WL);
    for (int i = 0; i < MAXU; ++i) {
        pg8::Unit u;
        if (!S.next(i, u)) break;
        if (tid < 256) {
            const int slot = (u.pm - tstart[u.e]) * 256 + tid;
            const bool v = slot < cnt[u.e * CNT_STRIDE];
            const int tok = v ? list[(size_t)u.e * T + slot] : 0;
            taboff[i * 256 + tid] = (unsigned)tok * (unsigned)(D * 2);
            tabw[i * 256 + tid] = v ? wl[(size_t)u.e * T + slot] : 0.f;
        }
    }
    __syncthreads();
    pg8::Gemm g{(const bf16*)(a.ws + WS_H), (const bf16*)(a.ws + WS_WGU) + (size_t)layer * NE * 512 * D, D, (size_t)512 * D * 2};
    pg8::EpiGU E{(bf16*)(a.ws + WS_HID), tabw};
    pg8::gemm_phase<pg8::EpiGU, pg8::GroupOrder, true, true>(lds + LDS_STAGE, g, S, E, taboff, wave);
}
__device__ __forceinline__ void phase_gemm_dn(const Args& a, int layer, LAS unsigned char* lds, int G, int bid, int tid, int wave) {
    const int* cnt = (const int*)(a.ws + WS_CTL) + CW_CNT + layer * NE * CNT_STRIDE;
    LAS int* tstart = (LAS int*)(lds + LDS_TSTART);
    build_tstart(cnt, tstart, tid);
    pg8::GroupOrder S{tstart, 4, __builtin_amdgcn_readfirstlane(tstart[NE]) * 4, G, bid};
    pg8::Gemm g{(const bf16*)(a.ws + WS_HID), (const bf16*)(a.ws + WS_WD) + (size_t)layer * NE * D * DE, DE, (size_t)D * DE * 2};
    pg8::EpiStoreBf16 E{(bf16*)(a.ws + WS_Y), D};
    pg8::gemm_phase<pg8::EpiStoreBf16, pg8::GroupOrder, false, true>(lds + LDS_STAGE, g, S, E, nullptr, wave);
}

#define PROBE_SUB 0
constexpr int NATP = 144, TRP = 272;
typedef short s16x8 __attribute__((ext_vector_type(8)));
typedef short s16x4 __attribute__((ext_vector_type(4)));
__device__ __forceinline__ f32x4 mfma32(s16x8 a, s16x8 b, f32x4 c) { return __builtin_amdgcn_mfma_f32_16x16x32_bf16(a, b, c, 0, 0, 0); }
__device__ __forceinline__ f32x4 mfma16(s16x4 a, s16x4 b, f32x4 c) { return __builtin_amdgcn_mfma_f32_16x16x16bf16_1k(a, b, c, 0, 0, 0); }
__device__ __forceinline__ s16x8 cat8(u32x2 lo, u32x2 hi) { u32x4 v = {lo.x, lo.y, hi.x, hi.y}; return __builtin_bit_cast(s16x8, v); }
__device__ __forceinline__ s16x8 ld8(const LAS unsigned char* p) { return *(const LAS s16x8*)p; }
__device__ __forceinline__ u32x2 ld4(const LAS unsigned char* p) { return *(const LAS u32x2*)p; }
__device__ __forceinline__ void wr_run_T(LAS unsigned char* rowp, const float (&x)[16]) {
    u32x4 w0 = {pk2(x[0], x[1]), pk2(x[2], x[3]), pk2(x[4], x[5]), pk2(x[6], x[7])}, w1 = {pk2(x[8], x[9]), pk2(x[10], x[11]), pk2(x[12], x[13]), pk2(x[14], x[15])};
    *(LAS u32x4*)rowp = w0; *(LAS u32x4*)(rowp + 16) = w1;
}
__device__ __forceinline__ void wr_run_N(LAS unsigned char* colp, const float (&x)[16]) {
#pragma unroll
    for (int tt = 0; tt < 16; tt += 2) { const unsigned p = pk2(x[tt], x[tt + 1]); *(LAS unsigned short*)(colp + tt * NATP) = (unsigned short)p; *(LAS unsigned short*)(colp + (tt + 1) * NATP) = (unsigned short)(p >> 16); }
}
__device__ __forceinline__ float ret_log2_gamma(int h) { return log2f(1.f - exp2f(-5.f - (float)h)); }

__device__ __forceinline__ void ld_run16(const bf16* proj, size_t row0, int col, unsigned (&r)[16]) {
#pragma unroll
    for (int tt = 0; tt < 16; ++tt) r[tt] = (unsigned)proj[(row0 + tt) * NP + col];
}
__device__ __forceinline__ void ret_rot(const unsigned (&r)[16], const float* rope, int p0, int lane, float scale, float (&x)[16]) {
#pragma unroll
    for (int tt = 0; tt < 16; ++tt) {
        const float own = __uint_as_float(r[tt] << 16), oth = xor32(own, lane);
        const float2 cs = *(const float2*)(rope + ((size_t)(p0 + tt) * 32 + (lane & 31)) * 2);
        x[tt] = ((lane < 32) ? (own * cs.x - oth * cs.y) : (oth * cs.y + own * cs.x)) * scale;
    }
}
__device__ __forceinline__ void ret_m1(const Args& a, LAS unsigned char* lds, int b, int c, int half, int tid) {
    asm volatile("" : "+v"(tid), "+s"(b), "+s"(c));
    const bf16* proj = (const bf16*)(a.ws + WS_PROJ); const float* rope = (const float*)(a.ws + WS_ROPE);
    float* ST = (float*)(a.ws + WS_ST); float* DEC = (float*)(a.ws + WS_DEC);
    const int j = tid >> 6, lane = tid & 63, fr = lane & 15, q = lane >> 4;
    LAS unsigned char* KT = lds; LAS unsigned char* VT = lds + 2 * 64 * TRP;
    const size_t row0 = (size_t)b * L + c * 128 + 16 * j; const int p0 = c * 128 + 16 * j;
    {
        unsigned rk[2][16], rv[2][16];
#pragma unroll
        for (int hd = 0; hd < 2; ++hd) { ld_run16(proj, row0, C_RK + (2 * half + hd) * 64 + lane, rk[hd]); ld_run16(proj, row0, C_RV + (2 * half + hd) * 64 + lane, rv[hd]); }
#pragma unroll
        for (int hd = 0; hd < 2; ++hd) {
            const float lg = ret_log2_gamma(2 * half + hd);
            float kr[16], vv[16];
            ret_rot(rk[hd], rope, p0, lane, 0.125f, kr);
#pragma unroll
            for (int tt = 0; tt < 16; ++tt) { kr[tt] *= fexp2((float)(127 - (16 * j + tt)) * lg); vv[tt] = __uint_as_float(rv[hd][tt] << 16); }
            wr_run_T(KT + (hd * 64 + lane) * TRP + 32 * j, kr);
            wr_run_T(VT + (hd * 64 + lane) * TRP + 32 * j, vv);
        }
    }
    __syncthreads();
    {
        const int hd = j >> 2, vt = j & 3, head = 12 + 2 * half + hd;
        s16x8 Af[4];
#pragma unroll
        for (int ss = 0; ss < 4; ++ss) Af[ss] = ld8(VT + (hd * 64 + 16 * vt + fr) * TRP + (32 * ss + 8 * q) * 2);
        float* dst = ST + (((size_t)b * 64 + c) * 16 + head) * 4096;
#pragma unroll
        for (int kt = 0; kt < 4; ++kt) {
            f32x4 acc = {0.f, 0.f, 0.f, 0.f};
#pragma unroll
            for (int ss = 0; ss < 4; ++ss) acc = mfma32(Af[ss], ld8(KT + (hd * 64 + 16 * kt + fr) * TRP + (32 * ss + 8 * q) * 2), acc);
#pragma unroll
            for (int r = 0; r < 4; ++r) dst[(16 * vt + 4 * q + r) * 64 + 16 * kt + fr] = acc[r];
        }
        if (tid < 128) { const int hd2 = tid >> 6, h2 = 2 * half + hd2; DEC[(((size_t)b * 64 + c) * 16 + 12 + h2) * 64 + (tid & 63)] = exp2f(128.f * ret_log2_gamma(h2)); }
    }
    __syncthreads();
}
__device__ __forceinline__ void ret_m3(const Args& a, LAS unsigned char* lds, int b, int c, int half, int tid) {
    asm volatile("" : "+v"(tid), "+s"(b), "+s"(c));
    const bf16* proj = (const bf16*)(a.ws + WS_PROJ); const float* rope = (const float*)(a.ws + WS_ROPE);
    const float* ST = (const float*)(a.ws + WS_ST); bf16* mixed = (bf16*)(a.ws + WS_MIXED);
    const int j = tid >> 6, lane = tid & 63, fr = lane & 15, q = lane >> 4;
    LAS unsigned char* QN = lds; LAS unsigned char* KN = QN + 2 * 128 * NATP; LAS unsigned char* VT = KN + 2 * 128 * NATP; LAS unsigned char* SN = VT + 2 * 64 * TRP;
    const size_t row0 = (size_t)b * L + c * 128 + 16 * j; const int p0 = c * 128 + 16 * j;
    {
        unsigned rq[2][16], rk[2][16], rv[2][16];
#pragma unroll
        for (int hd = 0; hd < 2; ++hd) { const int h = 2 * half + hd; ld_run16(proj, row0, C_RQ + h * 64 + lane, rq[hd]); ld_run16(proj, row0, C_RK + h * 64 + lane, rk[hd]); ld_run16(proj, row0, C_RV + h * 64 + lane, rv[hd]); }
#pragma unroll
        for (int hd = 0; hd < 2; ++hd) {
            float x[16];
            ret_rot(rq[hd], rope, p0, lane, 1.f, x);
            wr_run_N(QN + (hd * 128 + 16 * j) * NATP + lane * 2, x);
            ret_rot(rk[hd], rope, p0, lane, 0.125f, x);
            wr_run_N(KN + (hd * 128 + 16 * j) * NATP + lane * 2, x);
#pragma unroll
            for (int tt = 0; tt < 16; ++tt) x[tt] = __uint_as_float(rv[hd][tt] << 16);
            wr_run_T(VT + (hd * 64 + lane) * TRP + 32 * j, x);
        }
    }
    {
        const int idx = tid * 16, hd = idx >> 12, rem = idx & 4095, v = rem >> 6, k0 = rem & 63;
        const float* src = ST + (((size_t)b * 64 + c) * 16 + 12 + 2 * half + hd) * 4096 + v * 64 + k0;
        const f32x4 s0 = *(const f32x4*)src, s1 = *(const f32x4*)(src + 4), s2 = *(const f32x4*)(src + 8), s3 = *(const f32x4*)(src + 12);
        u32x4 w0 = {pk2(s0.x, s0.y), pk2(s0.z, s0.w), pk2(s1.x, s1.y), pk2(s1.z, s1.w)}, w1 = {pk2(s2.x, s2.y), pk2(s2.z, s2.w), pk2(s3.x, s3.y), pk2(s3.z, s3.w)};
        LAS unsigned char* d = SN + (hd * 64 + v) * NATP + k0 * 2;
        *(LAS u32x4*)d = w0; *(LAS u32x4*)(d + 16) = w1;
    }
    __syncthreads();
#pragma unroll 1
    for (int hd = 0; hd < 2; ++hd) {
        const int w = (hd == 0) ? j : 7 - j, tl = 16 * w + fr;
        const int h = 2 * half + hd; const float lg = ret_log2_gamma(h);
        const size_t row = (size_t)b * L + c * 128 + tl;
        u32x2 gzr[4];
#pragma unroll
        for (int vt = 0; vt < 4; ++vt) gzr[vt] = *(const u32x2*)(proj + row * NP + C_RG + h * 64 + 16 * vt + 4 * q);
        s16x8 Qf[2];
#pragma unroll
        for (int ks = 0; ks < 2; ++ks) Qf[ks] = ld8(QN + (hd * 128 + 16 * w + fr) * NATP + (32 * ks + 8 * q) * 2);
        f32x4 oacc[4];
#pragma unroll
        for (int vt = 0; vt < 4; ++vt) {
            f32x4 t = {0.f, 0.f, 0.f, 0.f};
#pragma unroll
            for (int ks = 0; ks < 2; ++ks) t = mfma32(ld8(SN + (hd * 64 + 16 * vt + fr) * NATP + (32 * ks + 8 * q) * 2), Qf[ks], t);
            oacc[vt] = t * fexp2((float)(tl + 1) * lg);
        }
#pragma unroll 1
        for (int pa = 0; pa <= (w >> 1); ++pa) {
            unsigned pb[4];
#pragma unroll
            for (int u = 0; u < 2; ++u) {
                const int st = 2 * pa + u;
                f32x4 sc = {0.f, 0.f, 0.f, 0.f};
                if (st <= w) {
#pragma unroll
                    for (int ks = 0; ks < 2; ++ks) sc = mfma32(ld8(KN + (hd * 128 + 16 * st + fr) * NATP + (32 * ks + 8 * q) * 2), Qf[ks], sc);
                }
                float p[4];
#pragma unroll
                for (int r = 0; r < 4; ++r) { const int d = tl - (16 * st + 4 * q + r); p[r] = (d >= 0 && st <= w) ? sc[r] * fexp2((float)d * lg) : 0.f; }
                pb[2 * u] = pk2(p[0], p[1]); pb[2 * u + 1] = pk2(p[2], p[3]);
            }
            const u32x4 pbv = {pb[0], pb[1], pb[2], pb[3]};
            const s16x8 Bp = __builtin_bit_cast(s16x8, pbv);
#pragma unroll
            for (int vt = 0; vt < 4; ++vt) {
                const LAS unsigned char* vp = VT + (hd * 64 + 16 * vt + fr) * TRP + (32 * pa + 4 * q) * 2;
                oacc[vt] = mfma32(cat8(ld4(vp), ld4(vp + 32)), Bp, oacc[vt]);
            }
        }
        float ss = 0.f;
#pragma unroll
        for (int vt = 0; vt < 4; ++vt) ss += (oacc[vt].x * oacc[vt].x + oacc[vt].y * oacc[vt].y) + (oacc[vt].z * oacc[vt].z + oacc[vt].w * oacc[vt].w);
        ss += swz_xor<16>(ss); ss += xor32(ss, lane);
        const float rinv = rsqrtf(ss * (1.f / 64.f) + EPS);
#pragma unroll
        for (int vt = 0; vt < 4; ++vt) {
            const int col = h * 64 + 16 * vt + 4 * q;
            const u32x2 gz = gzr[vt];
            const float g0 = __uint_as_float(gz.x << 16), g1 = __uint_as_float(gz.x & 0xffff0000u), g2 = __uint_as_float(gz.y << 16), g3 = __uint_as_float(gz.y & 0xffff0000u);
            u32x2 o; o.x = pk2(oacc[vt].x * rinv * siluf(g0), oacc[vt].y * rinv * siluf(g1)); o.y = pk2(oacc[vt].z * rinv * siluf(g2), oacc[vt].w * rinv * siluf(g3));
            *(u32x2*)(mixed + row * D + 768 + col) = o;
        }
    }
    __syncthreads();
}

__device__ __forceinline__ void ssd_load_raw(const bf16* proj, size_t row0, int p0, int ch, unsigned (&r)[19]) {
#pragma unroll
    for (int i = 0; i < 19; ++i) { const int p = p0 - 3 + i; const size_t rw = (p >= 0) ? row0 + i - 3 : row0; const unsigned v = (unsigned)proj[rw * NP + C_XBC + ch]; r[i] = (p >= 0) ? v : 0u; }
}
__device__ __forceinline__ void ssd_conv(const unsigned (&r)[19], int ch, const float* cw, const float* cb, float (&x)[16]) {
    const float w0 = cw[ch], w1 = cw[768 + ch], w2 = cw[2 * 768 + ch], w3 = cw[3 * 768 + ch], bb = cb[ch];
#pragma unroll
    for (int tt = 0; tt < 16; ++tt) x[tt] = siluf(bb + w0 * __uint_as_float(r[tt] << 16) + w1 * __uint_as_float(r[tt + 1] << 16) + w2 * __uint_as_float(r[tt + 2] << 16) + w3 * __uint_as_float(r[tt + 3] << 16));
}
__device__ __forceinline__ void ssd_scalars(const Args& a, int layer, int b, int c, int g, int tid, LAS float* aL, LAS float* cumL, LAS float* dtL) {
    const float* dtraw = (const float*)(a.ws + WS_DT);
    const int hl = tid >> 7, t = tid & 127, h = 4 * g + hl;
    const float dt = softplusf(dtraw[((size_t)b * L + c * 128 + t) * 8 + h] + a.in[10][layer * 8 + h]);
    dtL[tid] = dt; aL[tid] = -expf(a.in[11][layer * 8 + h]) * dt;
    __syncthreads();
    float cs = 0.f;
    for (int s = 0; s <= t; ++s) cs += aL[hl * 128 + s];
    cumL[tid] = cs;
    __syncthreads();
}
__device__ __forceinline__ void ssd_m1(const Args& a, int layer, LAS unsigned char* lds, int b, int c, int g, int tid) {
    asm volatile("" : "+v"(tid), "+s"(b), "+s"(c));
    const bf16* proj = (const bf16*)(a.ws + WS_PROJ);
    const float* cw = a.in[8] + (size_t)layer * 4 * 768; const float* cb = a.in[9] + (size_t)layer * 768;
    float* ST = (float*)(a.ws + WS_ST); float* DEC = (float*)(a.ws + WS_DEC);
    const int j = tid >> 6, lane = tid & 63, fr = lane & 15, q = lane >> 4;
    LAS unsigned char* XT = lds; LAS unsigned char* BT = lds + 4 * 64 * TRP;
    LAS float* aL = (LAS float*)(lds + 5 * 64 * TRP); LAS float* cumL = aL + 512; LAS float* dtL = cumL + 512; LAS float* wL = dtL + 512;
    const size_t row0 = (size_t)b * L + c * 128 + 16 * j; const int p0 = c * 128 + 16 * j;
    {
        unsigned raw[5][19];
#pragma unroll
        for (int i = 0; i < 5; ++i) ssd_load_raw(proj, row0, p0, (i < 4 ? (4 * g + i) * 64 : 512 + g * 64) + lane, raw[i]);
        float x[16];
#pragma unroll
        for (int hl = 0; hl < 4; ++hl) {
            ssd_conv(raw[hl], (4 * g + hl) * 64 + lane, cw, cb, x);
            wr_run_T(XT + (hl * 64 + lane) * TRP + 32 * j, x);
        }
        ssd_conv(raw[4], 512 + g * 64 + lane, cw, cb, x);
        wr_run_T(BT + lane * TRP + 32 * j, x);
    }
    ssd_scalars(a, layer, b, c, g, tid, aL, cumL, dtL);
    {
        const int hl = tid >> 7, t = tid & 127;
        const float cl = cumL[hl * 128 + 127];
        wL[tid] = expf(cl - cumL[tid]) * dtL[tid];
        if (t < 64) DEC[(((size_t)b * 64 + c) * 16 + 4 * g + hl) * 64 + t] = expf(cl);
    }
    __syncthreads();
    {
        const int hl = j >> 1;
        float* dst = ST + (((size_t)b * 64 + c) * 16 + 4 * g + hl) * 4096;
#pragma unroll 1
        for (int vi = 0; vi < 2; ++vi) {
            const int vt = (j & 1) * 2 + vi;
            s16x8 Af[4];
#pragma unroll
            for (int ss = 0; ss < 4; ++ss) {
                const u32x4 au = *(const LAS u32x4*)(XT + (hl * 64 + 16 * vt + fr) * TRP + (32 * ss + 8 * q) * 2);
                const f32x4 w0 = *(const LAS f32x4*)(wL + hl * 128 + 32 * ss + 8 * q), w1 = *(const LAS f32x4*)(wL + hl * 128 + 32 * ss + 8 * q + 4);
                u32x4 o;
                o.x = pk2(__uint_as_float(au.x << 16) * w0.x, __uint_as_float(au.x & 0xffff0000u) * w0.y);
                o.y = pk2(__uint_as_float(au.y << 16) * w0.z, __uint_as_float(au.y & 0xffff0000u) * w0.w);
                o.z = pk2(__uint_as_float(au.z << 16) * w1.x, __uint_as_float(au.z & 0xffff0000u) * w1.y);
                o.w = pk2(__uint_as_float(au.w << 16) * w1.z, __uint_as_float(au.w & 0xffff0000u) * w1.w);
                Af[ss] = __builtin_bit_cast(s16x8, o);
            }
#pragma unroll
            for (int kt = 0; kt < 4; ++kt) {
                f32x4 acc = {0.f, 0.f, 0.f, 0.f};
#pragma unroll
                for (int ss = 0; ss < 4; ++ss) acc = mfma32(Af[ss], ld8(BT + (16 * kt + fr) * TRP + (32 * ss + 8 * q) * 2), acc);
#pragma unroll
                for (int r = 0; r < 4; ++r) dst[(16 * vt + 4 * q + r) * 64 + 16 * kt + fr] = acc[r];
            }
        }
    }
    __syncthreads();
}
__device__ __forceinline__ void stage_states2(const float* ST, int b, int c, int head0, LAS unsigned char* SN, int tid) {
    const int idx = tid * 16, hd = idx >> 12, rem = idx & 4095, v = rem >> 6, k0 = rem & 63;
    const float* src = ST + (((size_t)b * 64 + c) * 16 + head0 + hd) * 4096 + v * 64 + k0;
    const f32x4 s0 = *(const f32x4*)src, s1 = *(const f32x4*)(src + 4), s2 = *(const f32x4*)(src + 8), s3 = *(const f32x4*)(src + 12);
    u32x4 w0 = {pk2(s0.x, s0.y), pk2(s0.z, s0.w), pk2(s1.x, s1.y), pk2(s1.z, s1.w)}, w1 = {pk2(s2.x, s2.y), pk2(s2.z, s2.w), pk2(s3.x, s3.y), pk2(s3.z, s3.w)};
    LAS unsigned char* d = SN + (hd * 64 + v) * NATP + k0 * 2;
    *(LAS u32x4*)d = w0; *(LAS u32x4*)(d + 16) = w1;
}
__device__ __forceinline__ void ssd_m3(const Args& a, int layer, LAS unsigned char* lds, int b, int c, int g, int tid) {
    asm volatile("" : "+v"(tid), "+s"(b), "+s"(c));
    const bf16* proj = (const bf16*)(a.ws + WS_PROJ);
    const float* cw = a.in[8] + (size_t)layer * 4 * 768; const float* cb = a.in[9] + (size_t)layer * 768;
    const float* ST = (const float*)(a.ws + WS_ST); bf16* mixed = (bf16*)(a.ws + WS_MIXED);
    const int j = tid >> 6, lane = tid & 63, fr = lane & 15, q = lane >> 4;
    LAS unsigned char* XT = lds; LAS unsigned char* KN = XT + 4 * 64 * TRP; LAS unsigned char* QN = KN + 128 * NATP; LAS unsigned char* SN = QN + 128 * NATP;
    LAS float* aL = (LAS float*)(SN + 2 * 64 * NATP); LAS float* cumL = aL + 512; LAS float* dtL = cumL + 512;
    const size_t row0 = (size_t)b * L + c * 128 + 16 * j; const int p0 = c * 128 + 16 * j;
#pragma unroll 1
    for (int r7_ = 0; r7_ < ((PROBE_SUB == 7) ? 3 : 1); ++r7_) {
        unsigned raw[6][19];
#pragma unroll
        for (int i = 0; i < 6; ++i) ssd_load_raw(proj, row0, p0, (i < 4 ? (4 * g + i) * 64 : (i == 4 ? 512 : 640) + g * 64) + lane, raw[i]);
        float x[16];
#pragma unroll
        for (int hl = 0; hl < 4; ++hl) {
            ssd_conv(raw[hl], (4 * g + hl) * 64 + lane, cw, cb, x);
            wr_run_T(XT + (hl * 64 + lane) * TRP + 32 * j, x);
        }
        ssd_conv(raw[4], 512 + g * 64 + lane, cw, cb, x);
        wr_run_N(KN + (16 * j) * NATP + lane * 2, x);
        ssd_conv(raw[5], 640 + g * 64 + lane, cw, cb, x);
        wr_run_N(QN + (16 * j) * NATP + lane * 2, x);
    }
    stage_states2(ST, b, c, 4 * g, SN, tid);
    ssd_scalars(a, layer, b, c, g, tid, aL, cumL, dtL);
    u32x2 y[2][2][4]; float ssum[2];
    size_t rowp[2];
#pragma unroll
    for (int p = 0; p < 2; ++p) {
        if (p == 1) { __syncthreads(); stage_states2(ST, b, c, 4 * g + 2, SN, tid); __syncthreads(); }
        const int wb = (p == 0) ? j : 7 - j, tl = 16 * wb + fr;
        rowp[p] = (size_t)b * L + c * 128 + tl;
        u32x2 gz[2][4];
#pragma unroll
        for (int hd = 0; hd < 2; ++hd)
#pragma unroll
            for (int vt = 0; vt < 4; ++vt) gz[hd][vt] = *(const u32x2*)(proj + rowp[p] * NP + C_Z + (4 * g + 2 * p + hd) * 64 + 16 * vt + 4 * q);
        s16x8 Qf[2];
#pragma unroll
        for (int ks = 0; ks < 2; ++ks) Qf[ks] = ld8(QN + (16 * wb + fr) * NATP + (32 * ks + 8 * q) * 2);
        f32x4 sc[8];
#pragma unroll
        for (int st = 0; st < 8; ++st) {
            sc[st] = (f32x4){0.f, 0.f, 0.f, 0.f};
            if (st <= wb) {
#pragma unroll
                for (int ks = 0; ks < 2; ++ks) sc[st] = mfma32(ld8(KN + (16 * st + fr) * NATP + (32 * ks + 8 * q) * 2), Qf[ks], sc[st]);
            }
        }
        float ss = 0.f;
#pragma unroll
        for (int hd = 0; hd < 2; ++hd) {
            const int hl = 2 * p + hd, h = 4 * g + hl;
            const float cum_t = cumL[hl * 128 + tl], dsk = a.in[12][layer * 8 + h];
            f32x4 oacc[4];
            const float et = fexp(cum_t);
#pragma unroll
            for (int vt = 0; vt < 4; ++vt) {
                f32x4 t = {0.f, 0.f, 0.f, 0.f};
#pragma unroll
                for (int ks = 0; ks < 2; ++ks) t = mfma32(ld8(SN + (hd * 64 + 16 * vt + fr) * NATP + (32 * ks + 8 * q) * 2), Qf[ks], t);
                oacc[vt] = t * et;
            }
#pragma unroll
            for (int pa = 0; pa < 4; ++pa) {
                if (2 * pa <= wb) {
                    unsigned pb[4];
#pragma unroll
                    for (int u = 0; u < 2; ++u) {
                        const int st = 2 * pa + u;
                        const f32x4 cs4 = *(const LAS f32x4*)(cumL + hl * 128 + 16 * st + 4 * q), dt4 = *(const LAS f32x4*)(dtL + hl * 128 + 16 * st + 4 * q);
                        float pv[4];
#pragma unroll
                        for (int r = 0; r < 4; ++r) {
                            const int d = tl - (16 * st + 4 * q + r);
                            const float v = (d >= 0 && st <= wb) ? sc[st][r] * fexp(cum_t - cs4[r]) * dt4[r] : 0.f;
                            pv[r] = (d == 0) ? v + dsk : v;
                        }
                        pb[2 * u] = pk2(pv[0], pv[1]); pb[2 * u + 1] = pk2(pv[2], pv[3]);
                    }
                    const u32x4 pbv = {pb[0], pb[1], pb[2], pb[3]};
                    const s16x8 Bp = __builtin_bit_cast(s16x8, pbv);
#pragma unroll
                    for (int vt = 0; vt < 4; ++vt) {
                        const LAS unsigned char* vp = XT + (hl * 64 + 16 * vt + fr) * TRP + (32 * pa + 4 * q) * 2;
                        oacc[vt] = mfma32(cat8(ld4(vp), ld4(vp + 32)), Bp, oacc[vt]);
                    }
                }
            }
#pragma unroll
            for (int vt = 0; vt < 4; ++vt) {
                const u32x2 z2 = gz[hd][vt];
                const float y0 = oacc[vt].x * siluf(__uint_as_float(z2.x << 16)), y1 = oacc[vt].y * siluf(__uint_as_float(z2.x & 0xffff0000u));
                const float y2 = oacc[vt].z * siluf(__uint_as_float(z2.y << 16)), y3 = oacc[vt].w * siluf(__uint_as_float(z2.y & 0xffff0000u));
                ss += (y0 * y0 + y1 * y1) + (y2 * y2 + y3 * y3);
                y[p][hd][vt].x = pk2(y0, y1); y[p][hd][vt].y = pk2(y2, y3);
            }
        }
        ss += swz_xor<16>(ss); ss += xor32(ss, lane);
        ssum[p] = ss;
    }
    __syncthreads();
    if (q == 0) { aL[16 * j + fr] = ssum[0]; aL[128 + 16 * (7 - j) + fr] = ssum[1]; }
    __syncthreads();
    const float* gn = a.in[13] + (size_t)layer * 512 + g * 256;
#pragma unroll
    for (int p = 0; p < 2; ++p) {
        const int wb = (p == 0) ? j : 7 - j, tl = 16 * wb + fr;
        const float rinv = rsqrtf((aL[tl] + aL[128 + tl]) * (1.f / 256.f) + EPS);
#pragma unroll
        for (int hd = 0; hd < 2; ++hd)
#pragma unroll
            for (int vt = 0; vt < 4; ++vt) {
                const int col = (2 * p + hd) * 64 + 16 * vt + 4 * q;
                const f32x4 gv = *(const f32x4*)(gn + col);
                const u32x2 yy = y[p][hd][vt];
                u32x2 o; o.x = pk2(__uint_as_float(yy.x << 16) * rinv * gv.x, __uint_as_float(yy.x & 0xffff0000u) * rinv * gv.y); o.y = pk2(__uint_as_float(yy.y << 16) * rinv * gv.z, __uint_as_float(yy.y & 0xffff0000u) * rinv * gv.w);
                *(u32x2*)(mixed + rowp[p] * D + g * 256 + col) = o;
            }
    }
    __syncthreads();
}

constexpr int HG_QN = 0, HG_KN = 2 * 64 * NATP, HG_KH = 4 * 64 * NATP, HG_VT = 6 * 64 * NATP, HG_OB = 8 * 64 * NATP, HG_GL = HG_OB + 2 * 64 * TRP, HG_TOT = HG_GL + 2 * 8 * 64 * 4;
template <bool M3>
__device__ __forceinline__ void hgrn_stage_a(const Args& a, int layer, LAS unsigned char* lds, int b, int c, int half, int hc, int j, int lane) {
    const bf16* proj = (const bf16*)(a.ws + WS_PROJ);
    const int hd = j >> 2, sl = j & 3, h = 2 * half + hd, col = h * 64 + lane, jg = 4 * hc + sl;
    const size_t row0 = (size_t)b * L + c * 128 + 16 * jg;
    const float lbv = ((const float*)(a.ws + WS_LB))[layer * 256 + col];
    float qv[16], kin[16], clv[16], vv[16];
#pragma unroll
    for (int tt = 0; tt < 16; ++tt) {
        const float fr_ = bf2f(proj[(row0 + tt) * NP + C_HF + col]);
        vv[tt] = bf2f(proj[(row0 + tt) * NP + C_HI + col]);
        if (M3) qv[tt] = bf2f(proj[(row0 + tt) * NP + C_HQ + col]);
        const float f = lbv + (1.f - lbv) * sigmf(fr_);
        clv[tt] = flog(fmaxf(f, 1e-30f)); kin[tt] = 1.f - f;
    }
#pragma unroll
    for (int tt = 1; tt < 16; ++tt) clv[tt] += clv[tt - 1];
    const float total = clv[15];
    float x[16];
#pragma unroll
    for (int tt = 0; tt < 16; ++tt) x[tt] = kin[tt] * fexp(total - clv[tt]);
    wr_run_T(lds + HG_KH + (hd * 64 + lane) * NATP + 32 * sl, x);
    wr_run_T(lds + HG_VT + (hd * 64 + lane) * NATP + 32 * sl, vv);
    ((LAS float*)(lds + HG_GL))[(hd * 8 + jg) * 64 + lane] = M3 ? fexp(total) : total;
    if (M3) {
#pragma unroll
        for (int tt = 0; tt < 16; ++tt) x[tt] = qv[tt] * fexp(clv[tt]);
        wr_run_N(lds + HG_QN + (hd * 64 + 16 * sl) * NATP + lane * 2, x);
#pragma unroll
        for (int tt = 0; tt < 16; ++tt) x[tt] = kin[tt] * fexp(fminf(-clv[tt], 80.f));
        wr_run_N(lds + HG_KN + (hd * 64 + 16 * sl) * NATP + lane * 2, x);
    }
}
__device__ __forceinline__ s16x4 pk4(f32x4 v) { u32x2 u = {pk2(v.x, v.y), pk2(v.z, v.w)}; return __builtin_bit_cast(s16x4, u); }
__device__ __forceinline__ s16x4 ld4s(const LAS unsigned char* p) { return *(const LAS s16x4*)p; }
template <bool M3>
__device__ __forceinline__ void hgrn_unit(const Args& a, int layer, LAS unsigned char* lds, int b, int c, int half, int tid) {
    asm volatile("" : "+v"(tid), "+s"(b), "+s"(c));
    const int j = tid >> 6, lane = tid & 63, fr = lane & 15, q = lane >> 4;
    const int hd = j >> 2, vt = j & 3, head = 8 + 2 * half + hd;
    float* STp = (float*)(a.ws + WS_ST) + (((size_t)b * 64 + c) * 16 + head) * 4096;
    f32x4 S[4];
#pragma unroll
    for (int kt = 0; kt < 4; ++kt) {
        S[kt] = (f32x4){0.f, 0.f, 0.f, 0.f};
        if (M3) {
#pragma unroll
            for (int r = 0; r < 4; ++r) S[kt][r] = STp[(16 * kt + 4 * q + r) * 64 + 16 * vt + fr];
        }
    }
    const LAS float* gL = (const LAS float*)(lds + HG_GL);
#pragma unroll 1
    for (int hc = 0; hc < 2; ++hc) {
        for (int r8_ = 0; r8_ < ((PROBE_SUB == 8 && M3) ? 3 : 1); ++r8_) hgrn_stage_a<M3>(a, layer, lds, b, c, half, hc, j, lane);
        __syncthreads();
#pragma unroll 1
        for (int sl = 0; sl < 4; ++sl) {
            const int jg = 4 * hc + sl;
            const s16x4 Bv = ld4s(lds + HG_VT + (hd * 64 + 16 * vt + fr) * NATP + (16 * sl + 4 * q) * 2);
            if (M3) {
                f32x4 pacc = {0.f, 0.f, 0.f, 0.f};
#pragma unroll
                for (int ks = 0; ks < 2; ++ks)
                    pacc = mfma32(ld8(lds + HG_KN + (hd * 64 + 16 * sl + fr) * NATP + (32 * ks + 8 * q) * 2), ld8(lds + HG_QN + (hd * 64 + 16 * sl + fr) * NATP + (32 * ks + 8 * q) * 2), pacc);
#pragma unroll
                for (int r = 0; r < 4; ++r) pacc[r] = (4 * q + r <= fr) ? pacc[r] : 0.f;
                f32x4 oacc = {0.f, 0.f, 0.f, 0.f};
#pragma unroll
                for (int kt = 0; kt < 4; ++kt) oacc = mfma16(ld4s(lds + HG_QN + (hd * 64 + 16 * sl + fr) * NATP + (16 * kt + 4 * q) * 2), pk4(S[kt]), oacc);
                oacc = mfma16(pk4(pacc), Bv, oacc);
                LAS float* ob = (LAS float*)(lds + HG_OB + (hd * 64 + 16 * sl + 4 * q) * TRP) + 16 * vt + fr;
#pragma unroll
                for (int r = 0; r < 4; ++r) ob[r * (TRP / 4)] = oacc[r];
            }
#pragma unroll
            for (int kt = 0; kt < 4; ++kt) {
                const f32x4 g4 = *(const LAS f32x4*)(gL + (hd * 8 + jg) * 64 + 16 * kt + 4 * q);
                f32x4 sc = S[kt];
                if (M3) sc = sc * g4; else { sc.x *= fexp(g4.x); sc.y *= fexp(g4.y); sc.z *= fexp(g4.z); sc.w *= fexp(g4.w); }
                S[kt] = mfma16(ld4s(lds + HG_KH + (hd * 64 + 16 * kt + fr) * NATP + (16 * sl + 4 * q) * 2), Bv, sc);
            }
        }
        __syncthreads();
        if (M3) {
            const int hd2 = tid >> 8, t = (tid >> 2) & 63, qu = tid & 3, h2 = 2 * half + hd2;
            const LAS float* ob = (const LAS float*)(lds + HG_OB + (hd2 * 64 + t) * TRP) + 16 * qu;
            f32x4 o[4]; float ss = 0.f;
#pragma unroll
            for (int i = 0; i < 4; ++i) { o[i] = *(const LAS f32x4*)(ob + 4 * i); ss += (o[i].x * o[i].x + o[i].y * o[i].y) + (o[i].z * o[i].z + o[i].w * o[i].w); }
            ss += swz_xor<1>(ss); ss += swz_xor<2>(ss);
            const float rinv = rsqrtf(ss * (1.f / 64.f) + EPS);
            const size_t row = (size_t)b * L + c * 128 + 64 * hc + t;
            const bf16* gp = (const bf16*)(a.ws + WS_PROJ) + row * NP + C_HG + h2 * 64 + 16 * qu;
            const u32x4 g0 = *(const u32x4*)gp, g1 = *(const u32x4*)(gp + 8);
            const float* ng = a.in[15] + (size_t)layer * 256 + h2 * 64 + 16 * qu;
            const unsigned gg[8] = {g0.x, g0.y, g0.z, g0.w, g1.x, g1.y, g1.z, g1.w};
            unsigned ow[8];
#pragma unroll
            for (int i = 0; i < 4; ++i) {
                const f32x4 nv = *(const f32x4*)(ng + 4 * i);
                ow[2 * i] = pk2(o[i].x * rinv * nv.x * sigmf(__uint_as_float(gg[2 * i] << 16)), o[i].y * rinv * nv.y * sigmf(__uint_as_float(gg[2 * i] & 0xffff0000u)));
                ow[2 * i + 1] = pk2(o[i].z * rinv * nv.z * sigmf(__uint_as_float(gg[2 * i + 1] << 16)), o[i].w * rinv * nv.w * sigmf(__uint_as_float(gg[2 * i + 1] & 0xffff0000u)));
            }
            bf16* mp = (bf16*)(a.ws + WS_MIXED) + row * D + 512 + h2 * 64 + 16 * qu;
            *(u32x4*)mp = (u32x4){ow[0], ow[1], ow[2], ow[3]}; *(u32x4*)(mp + 8) = (u32x4){ow[4], ow[5], ow[6], ow[7]};
            __syncthreads();
        }
    }
    if (!M3) {
#pragma unroll
        for (int kt = 0; kt < 4; ++kt)
#pragma unroll
            for (int r = 0; r < 4; ++r) STp[(16 * kt + 4 * q + r) * 64 + 16 * vt + fr] = S[kt][r];
        if (tid < 128) {
            const int hd2 = tid >> 6, k = tid & 63;
            float s = 0.f;
#pragma unroll
            for (int jg = 0; jg < 8; ++jg) s += gL[(hd2 * 8 + jg) * 64 + k];
            ((float*)(a.ws + WS_DEC))[(((size_t)b * 64 + c) * 16 + 8 + 2 * half + hd2) * 64 + k] = expf(s);
        }
        __syncthreads();
    }
}

__device__ __forceinline__ void phase_m1(const Args& a, int layer, LAS unsigned char* lds, int bid, int G, int tid) {
    for (int u = bid; u < NB * 64 * 2; u += G) {
        const int b = u >> 7, c = (u >> 1) & 63, half = u & 1;
        for (int r_ = 0; r_ < ((PROBE_SUB == 4) ? 3 : 1); ++r_) ssd_m1(a, layer, lds, b, c, half, tid);
        for (int r_ = 0; r_ < ((PROBE_SUB == 5) ? 3 : 1); ++r_) ret_m1(a, lds, b, c, half, tid);
        for (int r_ = 0; r_ < ((PROBE_SUB == 6) ? 3 : 1); ++r_) hgrn_unit<false>(a, layer, lds, b, c, half, tid);
    }
}
__device__ __forceinline__ void phase_m2(const Args& a, LAS unsigned char* lds, int bid, int G, int tid) {
    float* ST = (float*)(a.ws + WS_ST); const float* DEC = (const float*)(a.ws + WS_DEC);
    LAS float* dl = (LAS float*)lds;
    for (int u = bid; u < 256; u += G) {
        const int bh = u >> 3, b = bh >> 4, head = bh & 15, e = (u & 7) * 512 + tid;
        __syncthreads();
#pragma unroll
        for (int i = 0; i < 8; ++i) { const int x = tid + 512 * i, c = x >> 6; dl[x] = DEC[(((size_t)b * 64 + c) * 16 + head) * 64 + (x & 63)]; }
        float s[64];
#pragma unroll
        for (int c = 0; c < 64; ++c) s[c] = ST[(((size_t)b * 64 + c) * 16 + head) * 4096 + e];
        __syncthreads();
        float run = 0.f;
#pragma unroll
        for (int c = 0; c < 64; ++c) { const float prev = run; run = dl[c * 64 + (e >> 6)] * run + s[c]; ST[(((size_t)b * 64 + c) * 16 + head) * 4096 + e] = prev; }
    }
}
__device__ __forceinline__ void phase_m3(const Args& a, int layer, LAS unsigned char* lds, int bid, int G, int tid) {
    for (int u = bid; u < NB * 64 * 2; u += G) {
        const int b = u >> 7, c = (u >> 1) & 63, half = u & 1;
        for (int r_ = 0; r_ < ((PROBE_SUB == 1) ? 3 : 1); ++r_) ssd_m3(a, layer, lds, b, c, half, tid);
        for (int r_ = 0; r_ < ((PROBE_SUB == 2) ? 3 : 1); ++r_) ret_m3(a, lds, b, c, half, tid);
        for (int r_ = 0; r_ < ((PROBE_SUB == 3) ? 3 : 1); ++r_) hgrn_unit<true>(a, layer, lds, b, c, half, tid);
    }
}


__device__ __forceinline__ const void* rd_ptr(LAS const unsigned* p) {
    const unsigned lo = __builtin_amdgcn_readfirstlane(p[0]), hi = __builtin_amdgcn_readfirstlane(p[1]);
    return (const void*)(GAS const void*)(((unsigned long long)hi << 32) | lo);
}
__device__ __forceinline__ Args load_args(LAS unsigned char* lds) {
    LAS const unsigned* la = (LAS const unsigned*)(lds + LDS_ARGS);
    asm volatile("" : "+v"(la));
    Args A;
#pragma unroll
    for (int i = 0; i < 24; ++i) A.in[i] = (const float*)rd_ptr(la + 2 * i);
    A.out = (float*)rd_ptr(la + 48); A.ws = (unsigned char*)rd_ptr(la + 50);
    A.ph_lo = 0; A.ph_hi = 0; A.region = 0; A.pad = 0;
    return A;
}
#define PROBE_PH -1
#define PROBE_REP 2
#define REPS(p) ((PROBE_PH == (p)) ? 1 + PROBE_REP : 1)
__global__ void __launch_bounds__(NTHREADS, 2) fwd(Args a0) {
    extern __shared__ __attribute__((aligned(16))) unsigned char lds_raw[];
    LAS unsigned char* lds = (LAS unsigned char*)lds_raw;
    const int G0 = gridDim.x, bid0 = blockIdx.x;
    const int wave = __builtin_amdgcn_readfirstlane(threadIdx.x >> 6);
#define FRESH() int lane = __builtin_amdgcn_mbcnt_hi(~0u, __builtin_amdgcn_mbcnt_lo(~0u, 0u)); asm volatile("" : "+v"(lane)); int bid = bid0, G = G0; asm volatile("" : "+s"(bid), "+s"(G)); \
    const int tid = wave * 64 + lane, gw = bid * NWAVES + wave, ngw = G * NWAVES; (void)gw; (void)ngw; const Args a = load_args(lds)
    const int lo = a0.ph_lo, hi = a0.ph_hi;
    volatile LAS unsigned* misc = (volatile LAS unsigned*)(lds + LDS_MISC);
    if (threadIdx.x < 4) misc[threadIdx.x] = 0u;
    if (threadIdx.x < 56) ((LAS unsigned*)(lds + LDS_ARGS))[threadIdx.x] = ((const unsigned*)&a0)[threadIdx.x];
    __syncthreads();
    XcdBarrier bar; bar.bar = (unsigned*)(a0.ws + WS_CTL) + CW_BAR + a0.region * XCD_BAR_WORDS; bar.x = 0; bar.st = misc;
    if (hi - lo > 1) bar = xcd_barrier_post(bar.bar, misc);
#define IN(k) (lo <= (k) && (k) < hi)
#define SEAM(k) do { if (IN(k) && IN((k) + 1)) { asm volatile("" : "+s"(bar.bar)); xcd_barrier(bar); } } while (0)
    if (IN(PH_PRO)) { FRESH(); phase_prologue(a, lds, bid, G, tid); phase_convert(a, lds, gw, ngw, wave, lane); }
    SEAM(PH_PRO);
    for (int layer = 0; layer < DEPTH; ++layer) {
        const int pb = 1 + layer * PH_PER_LAYER;
        if (IN(pb + P_N1)) { _Pragma("unroll 1") for (int rep_ = 0; rep_ < REPS(P_N1); ++rep_) { FRESH(); phase_norm1(a, layer, lds, bid, G, wave, lane, rep_ > 0); } }
        SEAM(pb + P_N1);
        if (IN(pb + P_GIN)) { _Pragma("unroll 1") for (int rep_ = 0; rep_ < REPS(P_GIN); ++rep_) { FRESH(); phase_gemm_in(a, layer, lds, G, bid, wave); } }
        SEAM(pb + P_GIN);
        if (IN(pb + P_M1)) { _Pragma("unroll 1") for (int rep_ = 0; rep_ < REPS(P_M1); ++rep_) { FRESH(); phase_m1(a, layer, lds, bid, G, tid); } }
        SEAM(pb + P_M1);
        if (IN(pb + P_M2)) { _Pragma("unroll 1") for (int rep_ = 0; rep_ < REPS(P_M2); ++rep_) { FRESH(); phase_m2(a, lds, bid, G, tid); } }
        SEAM(pb + P_M2);
        if (IN(pb + P_M3)) { _Pragma("unroll 1") for (int rep_ = 0; rep_ < REPS(P_M3); ++rep_) { FRESH(); phase_m3(a, layer, lds, bid, G, tid); } }
        SEAM(pb + P_M3);
        if (IN(pb + P_GOUT)) { _Pragma("unroll 1") for (int rep_ = 0; rep_ < REPS(P_GOUT); ++rep_) { FRESH(); phase_gemm_out(a, layer, lds, G, bid, wave); } }
        SEAM(pb + P_GOUT);
        if (IN(pb + P_N2)) { _Pragma("unroll 1") for (int rep_ = 0; rep_ < REPS(P_N2); ++rep_) { FRESH(); phase_norm2(a, layer, lds, bid, G, wave, lane, rep_ > 0); } }
        SEAM(pb + P_N2);
        if (IN(pb + P_GGU)) { _Pragma("unroll 1") for (int rep_ = 0; rep_ < REPS(P_GGU); ++rep_) { FRESH(); phase_gemm_gu(a, layer, lds, G, bid, tid, wave); } }
        SEAM(pb + P_GGU);
        if (IN(pb + P_GDN)) { _Pragma("unroll 1") for (int rep_ = 0; rep_ < REPS(P_GDN); ++rep_) { FRESH(); phase_gemm_dn(a, layer, lds, G, bid, tid, wave); } }
        SEAM(pb + P_GDN);
    }
    if (IN(PH_FINAL)) { FRESH(); phase_norm1(a, DEPTH, lds, bid, G, wave, lane); }
#undef IN
#undef SEAM
}

#ifndef N_LAUNCH_MODE
#define N_LAUNCH_MODE 1
#endif
extern "C" void kernel_launch(void* const* d_in, const int* in_sizes, int n_in, void* d_out, int out_size, void* d_ws, size_t ws_size, hipStream_t stream) {
    static int grid = 0;
    if (grid == 0) {
        if (n_in != 24 || ws_size < WS_END) { fprintf(stderr, "kernel_launch: unexpected n_in %d / ws %zu\n", n_in, ws_size); grid = -1; return; }
        int dev = 0, cus = 0, per_cu = 0;
        if (hipGetDevice(&dev) != hipSuccess || hipDeviceGetAttribute(&cus, hipDeviceAttributeMultiprocessorCount, dev) != hipSuccess) { grid = -1; return; }
        if (hipFuncSetAttribute((const void*)fwd, hipFuncAttributeMaxDynamicSharedMemorySize, LDS_BYTES) != hipSuccess) { fprintf(stderr, "kernel_launch: hipFuncSetAttribute failed\n"); grid = -1; return; }
        if (hipOccupancyMaxActiveBlocksPerMultiprocessor(&per_cu, (const void*)fwd, NTHREADS, LDS_BYTES) != hipSuccess || per_cu < 1) { fprintf(stderr, "kernel_launch: occupancy query says %d\n", per_cu); }
        (void)hipGetLastError();
        grid = cus;
    }
    if (grid < 0) return;
    unsigned char* ws = (unsigned char*)d_ws;
    (void)hipMemsetAsync(ws + WS_CTL, 0, CTL_BYTES, stream);
    Args a{};
    for (int i = 0; i < 24; ++i) a.in[i] = (const float*)d_in[i];
    a.out = (float*)d_out; a.ws = ws; a.region = 0; a.pad = 0;
#if N_LAUNCH_MODE == 1
    a.ph_lo = 0; a.ph_hi = NPH;
    hipLaunchKernelGGL(fwd, dim3(grid), dim3(NTHREADS), LDS_BYTES, stream, a);
#else
    for (int ph = 0; ph < NPH; ++ph) { a.ph_lo = ph; a.ph_hi = ph + 1; hipLaunchKernelGGL(fwd, dim3(grid), dim3(NTHREADS), LDS_BYTES, stream, a); }
#endif
}
```

```cpp
#include <hip/hip_runtime.h>
#include <stdint.h>
#include <stdio.h>

#define GAS __attribute__((address_space(1)))
#define LAS __attribute__((address_space(3)))
typedef unsigned short bf16;
typedef float f32x4 __attribute__((ext_vector_type(4)));
typedef unsigned u32x2 __attribute__((ext_vector_type(2)));
typedef unsigned u32x4 __attribute__((ext_vector_type(4)));

constexpr int D = 1024, NB = 2, L = 8192, T = NB * L, DEPTH = 4;
constexpr int DIN = 3336;
constexpr int NP = 3328;
constexpr int NE = 32, DE = 256;
constexpr float EPS = 1e-6f;
constexpr int R_DT = 1280;
constexpr int C_Z = 0, C_XBC = 512, C_HQ = 1280, C_HF = 1536, C_HI = 1792, C_HG = 2048, C_RQ = 2304, C_RK = 2560, C_RV = 2816, C_RG = 3072;
constexpr int PAIR_ROWS = 2 * T + NE * 256;

constexpr size_t MiB = 1u << 20;
constexpr size_t WS_CTL = 0, CTL_BYTES = 1 * MiB;
constexpr size_t WS_MOD = 1 * MiB;
constexpr size_t WS_LB = 1 * MiB + 512 * 1024;
constexpr size_t WS_ROPE = 2 * MiB;
constexpr size_t WS_DT = 4 * MiB;
constexpr size_t WS_EID = 5 * MiB;
constexpr size_t WS_EW = 5 * MiB + 128 * 1024;
constexpr size_t WS_SLOT = 5 * MiB + 256 * 1024;
constexpr size_t WS_LIST = 6 * MiB;
constexpr size_t WS_WL = 8 * MiB;
constexpr size_t WS_XW = 10 * MiB;
constexpr size_t WS_H = 74 * MiB;
constexpr size_t WS_PROJ = 106 * MiB;
constexpr size_t WS_HID = 106 * MiB;
constexpr size_t WS_Y = 126 * MiB;
constexpr size_t WS_MIXED = 210 * MiB;
constexpr size_t WS_O = 242 * MiB;
constexpr size_t WS_WIN = 306 * MiB;
constexpr size_t WS_WOUT = 332 * MiB;
constexpr size_t WS_WGU = 340 * MiB;
constexpr size_t WS_WD = 468 * MiB;
constexpr size_t WS_ST = 532 * MiB;
constexpr size_t WS_DEC = 4 * MiB + 512 * 1024;
constexpr size_t WS_WR = 564 * MiB;
constexpr size_t WS_WDT = 565 * MiB;
constexpr size_t WS_END = 566 * MiB;
constexpr int CW_CNT = 8192, CNT_STRIDE = 64;
constexpr int CW_BAR = 16384;
constexpr int LDS_STAGE = 0, LDS_TAB = 131072, LDS_TSTART = 139264, LDS_MISC = 143360, LDS_ARGS = 143424, LDS_BYTES = 147456;

struct Args { const float* in[24]; float* out; unsigned char* ws; int ph_lo, ph_hi, region, pad; };

__device__ __forceinline__ float bf2f(unsigned short u) { return __uint_as_float(((unsigned)u) << 16); }
typedef float f32x2_t __attribute__((ext_vector_type(2)));
typedef __bf16 bf16x2_t __attribute__((ext_vector_type(2)));
__device__ __forceinline__ unsigned pk2(float lo, float hi) { const f32x2_t v = {lo, hi}; const bf16x2_t b = __builtin_convertvector(v, bf16x2_t); return __builtin_bit_cast(unsigned, b); }
__device__ __forceinline__ unsigned f2bf(float f) { return pk2(f, f) & 0xffffu; }
__device__ __forceinline__ float fexp(float x) { return __builtin_amdgcn_exp2f(x * 1.4426950408889634f); }
__device__ __forceinline__ float fexp2(float x) { return __builtin_amdgcn_exp2f(x); }
__device__ __forceinline__ float flog(float x) { return __builtin_amdgcn_logf(x) * 0.6931471805599453f; }
__device__ __forceinline__ float frcp(float x) { return __builtin_amdgcn_rcpf(x); }
__device__ __forceinline__ float siluf(float x) { return x * frcp(1.f + fexp(-x)); }
__device__ __forceinline__ float sigmf(float x) { return frcp(1.f + fexp(-x)); }
__device__ __forceinline__ float softplusf(float x) { return fmaxf(x, 0.f) + log1pf(__expf(-fabsf(x))); }
template <int X> __device__ __forceinline__ float swz_xor(float v) { return __int_as_float(__builtin_amdgcn_ds_swizzle(__float_as_int(v), (X << 10) | 0x1f)); }
__device__ __forceinline__ float rdlane(float v, int l) { return __int_as_float(__builtin_amdgcn_readlane(__float_as_int(v), l)); }
__device__ __forceinline__ float wave_sum(float v) {
    v += swz_xor<1>(v); v += swz_xor<2>(v); v += swz_xor<4>(v); v += swz_xor<8>(v); v += swz_xor<16>(v);
    return rdlane(v, 0) + rdlane(v, 32);
}
__device__ __forceinline__ float xor32(float v, int lane) { return __int_as_float(__builtin_amdgcn_ds_bpermute((lane ^ 32) << 2, __float_as_int(v))); }
__constant__ double c_invf[32] = {1.0, 0.7498942093324559, 0.5623413251903491, 0.4216965034285822, 0.31622776601683794, 0.23713737056616552, 0.1778279410038923, 0.1333521432163324, 0.1, 0.07498942093324558, 0.05623413251903491, 0.042169650342858224, 0.03162277660168379, 0.023713737056616554, 0.01778279410038923, 0.01333521432163324, 0.01, 0.007498942093324558, 0.005623413251903491, 0.004216965034285823, 0.0031622776601683794, 0.0023713737056616554, 0.0017782794100389228, 0.001333521432163324, 0.001, 0.0007498942093324559, 0.0005623413251903491, 0.00042169650342858224, 0.00031622776601683794, 0.00023713737056616554, 0.00017782794100389227, 0.0001333521432163324};
constexpr int NWAVES = 8, NTHREADS = 512;
constexpr int PH_PRO = 0, PH_PER_LAYER = 9, PH_FINAL = 1 + DEPTH * PH_PER_LAYER, NPH = PH_FINAL + 1;
enum { P_N1 = 0, P_GIN, P_M1, P_M2, P_M3, P_GOUT, P_N2, P_GGU, P_GDN };

__device__ __forceinline__ void phase_prologue(const Args& a, LAS unsigned char* lds, int bid, int G, int tid) {
    const float* c = a.in[1]; const float* w_ada = a.in[5]; const float* b_ada = a.in[6];
    float* mod = (float*)(a.ws + WS_MOD);
    const int wave = tid >> 6, lane = tid & 63;
    LAS float* cact = (LAS float*)lds;
    LAS float* red = (LAS float*)(lds + 8192);
    for (int i = tid; i < NB * D; i += NTHREADS) { const float v = c[i]; cact[i] = siluf(v); }
    __syncthreads();
    for (int it = bid; it < DEPTH * 24; it += G) {
        const int l = it / 24, j0 = (it % 24) * 256;
        const float* W = w_ada + (size_t)l * D * 6144 + j0 + lane * 4;
        f32x4 a0 = {0.f, 0.f, 0.f, 0.f}, a1 = {0.f, 0.f, 0.f, 0.f};
        const int k0 = wave * 128;
#pragma unroll 8
        for (int k = 0; k < 128; ++k) {
            const f32x4 w = *(const f32x4*)(W + (size_t)(k0 + k) * 6144);
            const float c0 = cact[k0 + k], c1 = cact[D + k0 + k];
            a0 += w * c0; a1 += w * c1;
        }
        __syncthreads();
        *(LAS f32x4*)(red + (wave * 2 + 0) * 256 + lane * 4) = a0;
        *(LAS f32x4*)(red + (wave * 2 + 1) * 256 + lane * 4) = a1;
        __syncthreads();
        {
            const int b = tid >> 8, col = tid & 255;
            float s = 0.f;
#pragma unroll
            for (int w = 0; w < 8; ++w) s += red[(w * 2 + b) * 256 + col];
            mod[((size_t)l * NB + b) * 6144 + j0 + col] = s + b_ada[(size_t)l * 6144 + j0 + col];
        }
    }
    if (bid == G - 1 && tid < 256) {
        const float* hl = a.in[14]; float* lb = (float*)(a.ws + WS_LB);
        const float v0 = hl[tid], v1 = hl[256 + tid], v2 = hl[512 + tid], v3 = hl[768 + tid];
        const float m = fmaxf(fmaxf(v0, v1), fmaxf(v2, v3));
        const float e0 = expf(v0 - m), e1 = expf(v1 - m), e2 = expf(v2 - m), e3 = expf(v3 - m);
        const float inv = 1.f / (e0 + e1 + e2 + e3);
        lb[tid] = 0.f; lb[256 + tid] = e1 * inv; lb[512 + tid] = (e1 + e2) * inv; lb[768 + tid] = (e1 + e2 + e3) * inv;
    }
    {
        float* rope = (float*)(a.ws + WS_ROPE);
        for (int i = bid * NTHREADS + tid; i < L * 32; i += G * NTHREADS) {
            const int p = i >> 5, j = i & 31;
            const double f = c_invf[j];
            double r = (double)p * f * 0.15915494309189535;
            r -= floor(r);
            const float rf = (float)r;
            rope[2 * i] = __builtin_amdgcn_cosf(rf); rope[2 * i + 1] = __builtin_amdgcn_sinf(rf);
        }
    }
}

typedef short n2s8 __attribute__((ext_vector_type(8)));
__device__ __forceinline__ void phase_norm1(const Args& a, int layer, LAS unsigned char* lds, int bid, int G, int wave, int lane, bool rerun = false) {
    const float* xin = a.in[0];
    float* xw = (float*)(a.ws + WS_XW);
    const float* mod = (const float*)(a.ws + WS_MOD);
    bf16* h = (bf16*)(a.ws + WS_H);
    float* dtraw = (float*)(a.ws + WS_DT);
    const bf16* Y = (const bf16*)(a.ws + WS_Y);
    const int* eid = (const int*)(a.ws + WS_EID);
    const int* slot = (const int*)(a.ws + WS_SLOT);
    LAS float* part = (LAS float*)lds;
    LAS float* pdt = (LAS float*)(lds + 512);
    int mybase = 0;
    const bool gather = (layer > 0 && !rerun);
    if (gather) {
        const int* cnt = (const int*)(a.ws + WS_CTL) + CW_CNT + (layer - 1) * NE * CNT_STRIDE;
        int pc = (lane < NE) ? ((cnt[lane * CNT_STRIDE] + 255) & ~255) : 0;
        int run = 0;
#pragma unroll
        for (int i = 0; i < NE; ++i) { mybase = (lane == i) ? run : mybase; run += __builtin_amdgcn_readlane(pc, i); }
    }
    const float* gvec = (layer < DEPTH) ? a.in[2] + (size_t)layer * D : a.in[4];
    const bf16* wdt = (const bf16*)(a.ws + WS_WDT) + (size_t)(layer < DEPTH ? layer : 0) * 2 * 16 * D;
    LAS float* vec = (LAS float*)(lds + 32768);
    const int tile = wave >> 1, kh = wave & 1, t = lane & 15, q = lane >> 4;
    for (int blk = bid; blk < T / 64; blk += G) {
        const int row = blk * 64 + tile * 16 + t, b = row >> 13;
        const int cb = 512 * kh + 8 * q;
        if (layer < DEPTH) {
            const float* mbv = mod + ((size_t)layer * NB + b) * 6144;
            for (int i = wave * 64 + lane; i < D; i += NTHREADS) { vec[i] = gvec[i]; vec[D + i] = mbv[i]; vec[2 * D + i] = mbv[D + i] + 1.f; }
        }
        const float* src = ((layer == 0 && !rerun) ? xin : xw) + (size_t)row * D + cb;
        float* xo = xw + (size_t)row * D + cb;
        const bf16* y0p = Y; const bf16* y1p = Y;
        if (gather) {
            const int e0 = eid[2 * row], e1 = eid[2 * row + 1];
            const int b0 = __builtin_amdgcn_ds_bpermute(e0 << 2, mybase), b1 = __builtin_amdgcn_ds_bpermute(e1 << 2, mybase);
            y0p = Y + (size_t)(b0 + slot[2 * row]) * D + cb; y1p = Y + (size_t)(b1 + slot[2 * row + 1]) * D + cb;
        }
        const float* gf = mod + ((size_t)(layer > 0 ? layer - 1 : 0) * NB + b) * 6144 + 5 * D + cb;
        float ss = 0.f;
#pragma unroll 4
        for (int ks = 0; ks < 16; ++ks) {
            f32x4 x0 = *(const f32x4*)(src + 32 * ks), x1 = *(const f32x4*)(src + 32 * ks + 4);
            if (gather) {
                const u32x4 ya = *(const u32x4*)(y0p + 32 * ks), yb = *(const u32x4*)(y1p + 32 * ks);
                const f32x4 g0 = *(const f32x4*)(gf + 32 * ks), g1 = *(const f32x4*)(gf + 32 * ks + 4);
                x0.x += g0.x * (__uint_as_float(ya.x << 16) + __uint_as_float(yb.x << 16)); x0.y += g0.y * (__uint_as_float(ya.x & 0xffff0000u) + __uint_as_float(yb.x & 0xffff0000u));
                x0.z += g0.z * (__uint_as_float(ya.y << 16) + __uint_as_float(yb.y << 16)); x0.w += g0.w * (__uint_as_float(ya.y & 0xffff0000u) + __uint_as_float(yb.y & 0xffff0000u));
                x1.x += g1.x * (__uint_as_float(ya.z << 16) + __uint_as_float(yb.z << 16)); x1.y += g1.y * (__uint_as_float(ya.z & 0xffff0000u) + __uint_as_float(yb.z & 0xffff0000u));
                x1.z += g1.z * (__uint_as_float(ya.w << 16) + __uint_as_float(yb.w << 16)); x1.w += g1.w * (__uint_as_float(ya.w & 0xffff0000u) + __uint_as_float(yb.w & 0xffff0000u));
            }
            if (layer < DEPTH) { *(f32x4*)(xo + 32 * ks) = x0; *(f32x4*)(xo + 32 * ks + 4) = x1; }
            ss += ((x0.x * x0.x + x0.y * x0.y) + (x0.z * x0.z + x0.w * x0.w)) + ((x1.x * x1.x + x1.y * x1.y) + (x1.z * x1.z + x1.w * x1.w));
        }
        ss += swz_xor<16>(ss); ss += xor32(ss, lane);
        if (q == 0) part[(tile * 2 + kh) * 16 + t] = ss;
        __syncthreads();
        const float rstd = rsqrtf((part[(tile * 2) * 16 + t] + part[(tile * 2 + 1) * 16 + t]) * (1.f / D) + EPS);
        if (layer == DEPTH) {
            float* op = a.out + (size_t)row * D + cb;
#pragma unroll 4
            for (int ks = 0; ks < 16; ++ks) {
                f32x4 x0 = *(const f32x4*)(src + 32 * ks), x1 = *(const f32x4*)(src + 32 * ks + 4);
                {
                    const u32x4 ya = *(const u32x4*)(y0p + 32 * ks), yb = *(const u32x4*)(y1p + 32 * ks);
                    const f32x4 g0 = *(const f32x4*)(gf + 32 * ks), g1 = *(const f32x4*)(gf + 32 * ks + 4);
                    x0.x += g0.x * (__uint_as_float(ya.x << 16) + __uint_as_float(yb.x << 16)); x0.y += g0.y * (__uint_as_float(ya.x & 0xffff0000u) + __uint_as_float(yb.x & 0xffff0000u));
                    x0.z += g0.z * (__uint_as_float(ya.y << 16) + __uint_as_float(yb.y << 16)); x0.w += g0.w * (__uint_as_float(ya.y & 0xffff0000u) + __uint_as_float(yb.y & 0xffff0000u));
                    x1.x += g1.x * (__uint_as_float(ya.z << 16) + __uint_as_float(yb.z << 16)); x1.y += g1.y * (__uint_as_float(ya.z & 0xffff0000u) + __uint_as_float(yb.z & 0xffff0000u));
                    x1.z += g1.z * (__uint_as_float(ya.w << 16) + __uint_as_float(yb.w << 16)); x1.w += g1.w * (__uint_as_float(ya.w & 0xffff0000u) + __uint_as_float(yb.w & 0xffff0000u));
                }
                const f32x4 g0 = *(const f32x4*)(gvec + cb + 32 * ks), g1 = *(const f32x4*)(gvec + cb + 32 * ks + 4);
                *(f32x4*)(op + 32 * ks) = x0 * rstd * g0; *(f32x4*)(op + 32 * ks + 4) = x1 * rstd * g1;
            }
            __syncthreads();
            continue;
        }
        const LAS float* vp = vec + cb;
        bf16* hr = h + (size_t)row * D + cb;
        const bf16* wp = wdt + (size_t)t * D + cb;
        f32x4 acc = {0.f, 0.f, 0.f, 0.f};
#pragma unroll 4
        for (int ks = 0; ks < 16; ++ks) {
            unsigned hi[4], lo[4];
#pragma unroll
            for (int e = 0; e < 2; ++e) {
                const f32x4 g = *(const LAS f32x4*)(vp + 32 * ks + 4 * e), sh = *(const LAS f32x4*)(vp + D + 32 * ks + 4 * e), sc1 = *(const LAS f32x4*)(vp + 2 * D + 32 * ks + 4 * e);
                const f32x4 hv = *(const f32x4*)(xo + 32 * ks + 4 * e) * rstd * g * sc1 + sh;
                const unsigned p01 = pk2(hv.x, hv.y), p23 = pk2(hv.z, hv.w);
                hi[2 * e] = p01; hi[2 * e + 1] = p23;
                lo[2 * e] = pk2(hv.x - __uint_as_float(p01 << 16), hv.y - __uint_as_float(p01 & 0xffff0000u)); lo[2 * e + 1] = pk2(hv.z - __uint_as_float(p23 << 16), hv.w - __uint_as_float(p23 & 0xffff0000u));
            }
            const u32x4 hiv = {hi[0], hi[1], hi[2], hi[3]}, lov = {lo[0], lo[1], lo[2], lo[3]};
            *(u32x4*)(hr + 32 * ks) = hiv;
            const n2s8 Ah = __builtin_bit_cast(n2s8, hiv), Al = __builtin_bit_cast(n2s8, lov);
            const n2s8 Bh = *(const n2s8*)(wp + 32 * ks), Bl = *(const n2s8*)(wp + (size_t)16 * D + 32 * ks);
            acc = __builtin_amdgcn_mfma_f32_16x16x32_bf16(Ah, Bh, acc, 0, 0, 0);
            acc = __builtin_amdgcn_mfma_f32_16x16x32_bf16(Ah, Bl, acc, 0, 0, 0);
            acc = __builtin_amdgcn_mfma_f32_16x16x32_bf16(Al, Bh, acc, 0, 0, 0);
        }
#pragma unroll
        for (int r = 0; r < 4; ++r) pdt[((tile * 2 + kh) * 16 + 4 * q + r) * 16 + t] = acc[r];
        __syncthreads();
        {
            const int tid = wave * 64 + lane, tk = tid >> 3, d = tid & 7, tl = tk >> 4, tt = tk & 15;
            dtraw[(size_t)(blk * 64 + tk) * 8 + d] = pdt[((tl * 2) * 16 + tt) * 16 + d] + pdt[((tl * 2 + 1) * 16 + tt) * 16 + d];
        }
        __syncthreads();
    }
}

__device__ __forceinline__ void phase_norm2(const Args& a, int layer, LAS unsigned char* lds, int bid, int G, int wave, int lane, bool rerun = false) {
    const float* xw = (const float*)(a.ws + WS_XW);
    const float* mod = (const float*)(a.ws + WS_MOD);
    bf16* h = (bf16*)(a.ws + WS_H);
    int* eid = (int*)(a.ws + WS_EID); float* ew = (float*)(a.ws + WS_EW);
    int* slot = (int*)(a.ws + WS_SLOT); int* list = (int*)(a.ws + WS_LIST); float* wl = (float*)(a.ws + WS_WL);
    int* cnt = (int*)(a.ws + WS_CTL) + CW_CNT + layer * NE * CNT_STRIDE;
    const float* gvec = a.in[3] + (size_t)layer * D;
    const float* bg = a.in[18] + layer * 4; const float* be = a.in[20] + layer * NE;
    const bf16* wr = (const bf16*)(a.ws + WS_WR) + (size_t)layer * 2 * 48 * D;
    LAS float* part = (LAS float*)lds;
    LAS float* plog = (LAS float*)(lds + 512);
    LAS int* hist = (LAS int*)(lds + 512 + 4 * 2 * 16 * 48 * 4);
    LAS float* vec = (LAS float*)(lds + 32768);
    const int tile = wave >> 1, kh = wave & 1, t = lane & 15, q = lane >> 4, tid = wave * 64 + lane;
    for (int blk = bid; blk < T / 64; blk += G) {
        const int row = blk * 64 + tile * 16 + t, b = row >> 13;
        {
            const float* mbv = mod + ((size_t)layer * NB + b) * 6144 + 3 * D;
            for (int i = tid; i < D; i += NTHREADS) { vec[i] = gvec[i]; vec[D + i] = mbv[i]; vec[2 * D + i] = mbv[D + i] + 1.f; }
        }
        const float* xr = xw + (size_t)row * D + 512 * kh + 8 * q;
        float ss = 0.f;
#pragma unroll 8
        for (int ks = 0; ks < 16; ++ks) {
            const f32x4 x0 = *(const f32x4*)(xr + 32 * ks), x1 = *(const f32x4*)(xr + 32 * ks + 4);
            ss += ((x0.x * x0.x + x0.y * x0.y) + (x0.z * x0.z + x0.w * x0.w)) + ((x1.x * x1.x + x1.y * x1.y) + (x1.z * x1.z + x1.w * x1.w));
        }
        ss += swz_xor<16>(ss); ss += xor32(ss, lane);
        if (tid < 32) hist[tid] = 0;
        if (q == 0) part[(tile * 2 + kh) * 16 + t] = ss;
        __syncthreads();
        const float rstd = rsqrtf((part[(tile * 2) * 16 + t] + part[(tile * 2 + 1) * 16 + t]) * (1.f / D) + EPS);
        const LAS float* vp = vec + 512 * kh + 8 * q;
        bf16* hr = h + (size_t)row * D + 512 * kh + 8 * q;
        const bf16* wp = wr + (size_t)t * D + 512 * kh + 8 * q;
        f32x4 acc[3] = {{0.f, 0.f, 0.f, 0.f}, {0.f, 0.f, 0.f, 0.f}, {0.f, 0.f, 0.f, 0.f}};
#pragma unroll 4
        for (int ks = 0; ks < 16; ++ks) {
            unsigned hi[4], lo[4];
#pragma unroll
            for (int e = 0; e < 2; ++e) {
                const f32x4 g = *(const LAS f32x4*)(vp + 32 * ks + 4 * e), sh = *(const LAS f32x4*)(vp + D + 32 * ks + 4 * e), sc1 = *(const LAS f32x4*)(vp + 2 * D + 32 * ks + 4 * e);
                const f32x4 hv = *(const f32x4*)(xr + 32 * ks + 4 * e) * rstd * g * sc1 + sh;
                const unsigned p01 = pk2(hv.x, hv.y), p23 = pk2(hv.z, hv.w);
                hi[2 * e] = p01; hi[2 * e + 1] = p23;
                lo[2 * e] = pk2(hv.x - __uint_as_float(p01 << 16), hv.y - __uint_as_float(p01 & 0xffff0000u)); lo[2 * e + 1] = pk2(hv.z - __uint_as_float(p23 << 16), hv.w - __uint_as_float(p23 & 0xffff0000u));
            }
            const u32x4 hiv = {hi[0], hi[1], hi[2], hi[3]}, lov = {lo[0], lo[1], lo[2], lo[3]};
            *(u32x4*)(hr + 32 * ks) = hiv;
            const n2s8 Ah = __builtin_bit_cast(n2s8, hiv), Al = __builtin_bit_cast(n2s8, lov);
#pragma unroll
            for (int nt = 0; nt < 3; ++nt) {
                const n2s8 Bh = *(const n2s8*)(wp + (size_t)(16 * nt) * D + 32 * ks), Bl = *(const n2s8*)(wp + (size_t)(48 + 16 * nt) * D + 32 * ks);
                acc[nt] = __builtin_amdgcn_mfma_f32_16x16x32_bf16(Ah, Bh, acc[nt], 0, 0, 0);
                acc[nt] = __builtin_amdgcn_mfma_f32_16x16x32_bf16(Ah, Bl, acc[nt], 0, 0, 0);
                acc[nt] = __builtin_amdgcn_mfma_f32_16x16x32_bf16(Al, Bh, acc[nt], 0, 0, 0);
            }
        }
#pragma unroll
        for (int nt = 0; nt < 3; ++nt)
#pragma unroll
            for (int r = 0; r < 4; ++r) plog[((tile * 2 + kh) * 16 + 4 * q + r) * 48 + 16 * nt + t] = acc[nt][r];
        __syncthreads();
        int e0 = 0, e1 = 0, r0 = 0, r1 = 0; float w0 = 0.f, w1 = 0.f;
        const bool router = (kh == 0 && lane < 16 && !rerun);
        const int rrow = blk * 64 + tile * 16 + lane;
        if (router) {
            const LAS float* p0 = plog + ((tile * 2) * 16 + lane) * 48; const LAS float* p1 = p0 + 16 * 48;
            float lg[4];
#pragma unroll
            for (int i = 0; i < 4; ++i) lg[i] = p0[32 + i] + p1[32 + i] + bg[i];
            int gi = 0; float gm = lg[0];
#pragma unroll
            for (int i = 1; i < 4; ++i) if (lg[i] > gm) { gm = lg[i]; gi = i; }
            float se = 0.f;
#pragma unroll
            for (int i = 0; i < 4; ++i) se += expf(lg[i] - gm);
            const float pg = 1.f / se;
            float ig[8];
#pragma unroll
            for (int i = 0; i < 8; ++i) ig[i] = p0[gi * 8 + i] + p1[gi * 8 + i] + be[gi * 8 + i];
            int i0 = 0; float v0 = ig[0];
#pragma unroll
            for (int i = 1; i < 8; ++i) if (ig[i] > v0) { v0 = ig[i]; i0 = i; }
            int i1 = -1; float v1 = -3.0e38f;
#pragma unroll
            for (int i = 0; i < 8; ++i) if (i != i0 && ig[i] > v1) { v1 = ig[i]; i1 = i; }
            const float ex = expf(v1 - v0);
            w0 = pg / (1.f + ex); w1 = pg * ex / (1.f + ex);
            e0 = gi * 8 + i0; e1 = gi * 8 + i1;
            r0 = __hip_atomic_fetch_add(&hist[e0], 1, __ATOMIC_RELAXED, __HIP_MEMORY_SCOPE_WORKGROUP); r1 = __hip_atomic_fetch_add(&hist[e1], 1, __ATOMIC_RELAXED, __HIP_MEMORY_SCOPE_WORKGROUP);
        }
        __syncthreads();
        if (tid < 32) { const int c = hist[tid]; hist[32 + tid] = c ? atomicAdd(&cnt[tid * CNT_STRIDE], c) : 0; }
        __syncthreads();
        if (router) {
            const int s0 = hist[32 + e0] + r0, s1 = hist[32 + e1] + r1;
            eid[2 * rrow] = e0; eid[2 * rrow + 1] = e1; ew[2 * rrow] = w0; ew[2 * rrow + 1] = w1; slot[2 * rrow] = s0; slot[2 * rrow + 1] = s1;
            list[(size_t)e0 * T + s0] = rrow; wl[(size_t)e0 * T + s0] = w0; list[(size_t)e1 * T + s1] = rrow; wl[(size_t)e1 * T + s1] = w1;
        }
        __syncthreads();
    }
}

#define XB_TMO      128
#define XB_XCNT(j)  (256  + 64 * (j))
#define XB_XSUB(j)  (1280 + 64 * (j))
#define XB_XGEN(j)  (2304 + 64 * (j))
#define XB_TOP      3328
#define XB_TOPGEN   3392
#define XCD_BAR_WORDS 3456
#define XB_SPIN_CAP (1u << 18)

__device__ __forceinline__ unsigned xb_ld(unsigned* p)              { return __hip_atomic_load(p, __ATOMIC_RELAXED, __HIP_MEMORY_SCOPE_AGENT); }
__device__ __forceinline__ unsigned xb_add(unsigned* p, unsigned v) { return __hip_atomic_fetch_add(p, v, __ATOMIC_RELAXED, __HIP_MEMORY_SCOPE_AGENT); }
__device__ __forceinline__ unsigned xb_xcc_id() { return (unsigned)__builtin_amdgcn_s_getreg((3 << 11) | 20) & 0xFu; }
#define XB_SPIN(cond, bar) do { unsigned _sp = 0; while (cond) { __builtin_amdgcn_s_sleep(1); \
    if ((++_sp & 255u) == 0u) { if (xb_ld(&(bar)[XB_TMO])) break; if (_sp > XB_SPIN_CAP) { atomicAdd(&(bar)[XB_TMO], 1u); break; } } } } while (0)

struct XcdBarrier {
    unsigned* bar; unsigned x;
    volatile LAS unsigned* st;
};

__device__ __forceinline__ XcdBarrier xcd_barrier_post(unsigned* bar, volatile LAS unsigned* st) {
    XcdBarrier b; b.bar = bar; b.x = xb_xcc_id(); b.st = st;
    if (threadIdx.x == 0) (void)xb_add(&bar[XB_XCNT(b.x)], 1u);
    return b;
}
__device__ __forceinline__ void xcd_barrier_complete(unsigned* bar, unsigned x, unsigned& nloc, unsigned& nx) {
    const unsigned G = gridDim.x * gridDim.y * gridDim.z;
    unsigned sum, cnt, mine, sp = 0u;
    for (;;) {
        sum = 0u; cnt = 0u; mine = 0u;
#pragma unroll
        for (unsigned j = 0; j < 16; ++j) { const unsigned c = xb_ld(&bar[XB_XCNT(j)]); sum += c; cnt += (c > 0u) ? 1u : 0u; mine = (j == x) ? c : mine; }
        if (sum == G) break;
        __builtin_amdgcn_s_sleep(1);
        if ((++sp & 255u) == 0u) { if (xb_ld(&bar[XB_TMO])) break; if (sp > XB_SPIN_CAP) { atomicAdd(&bar[XB_TMO], 1u); break; } }
    }
    nloc = mine > 0u ? mine : 1u; nx = cnt > 0u ? cnt : 1u;
}

__device__ __forceinline__ void xcd_barrier(const XcdBarrier& b) {
    asm volatile("s_waitcnt vmcnt(0)" ::: "memory");
    __syncthreads();
    if (threadIdx.x == 0) {
        unsigned* bar = b.bar;
        __builtin_amdgcn_s_waitcnt(0);
        unsigned nloc = b.st[0], nx = b.st[1];
        if (nloc == 0u) { xcd_barrier_complete(bar, b.x, nloc, nx); b.st[0] = nloc; b.st[1] = nx; }
        const unsigned old = xb_add(&bar[XB_XSUB(b.x)], 1u);
        const unsigned gen = old / nloc;
        if (old + 1u == (gen + 1u) * nloc) {
            __builtin_amdgcn_fence(__ATOMIC_RELEASE, "agent");
            asm volatile("s_waitcnt vmcnt(0)" ::: "memory");
            const unsigned og = xb_add(&bar[XB_TOP], 1u);
            const unsigned tg = og / nx;
            if (og + 1u == (tg + 1u) * nx) xb_add(&bar[XB_TOPGEN], 1u);
            else XB_SPIN(xb_ld(&bar[XB_TOPGEN]) == tg, bar);
            __builtin_amdgcn_fence(__ATOMIC_ACQUIRE, "agent");
            xb_add(&bar[XB_XGEN(b.x)], 1u);
            asm volatile("s_waitcnt vmcnt(0)" ::: "memory");
        } else {
            XB_SPIN(xb_ld(&bar[XB_XGEN(b.x)]) == gen, bar);
            __builtin_amdgcn_fence(__ATOMIC_ACQUIRE, "agent");
            asm volatile("s_waitcnt vmcnt(0)" ::: "memory");
        }
    }
    __syncthreads();
}

namespace pg8 {
typedef unsigned short bf16_t;
typedef short bf16x8 __attribute__((ext_vector_type(8)));
constexpr int BM = 256, BK = 64, HALF = 128, HTB = HALF * BK * 2  , STAGE_BYTES = 8 * HTB, NXCD = 8, WGM = 8;

__host__ __device__ __forceinline__ int lds_byte(int r, int c) { const int st = (r >> 4) * 2 + (c >> 5), rr = r & 15, cc = c & 31, ob = rr * 64 + cc * 2; return st * 1024 + (ob ^ (((ob >> 9) & 1) << 5)); }
__host__ __device__ __forceinline__ void stage_rc(int b, int& R, int& C) { const int st = b / 1024, sb = b % 1024, swz = sb ^ (((sb >> 9) & 1) << 5); R = (st >> 1) * 16 + swz / 64; C = (st & 1) * 32 + (swz % 64) / 2; }
__host__ __device__ __forceinline__ int perm32(int rho) { const int n = rho >> 4, i = rho & 15; return 8 * (i >> 2) + 4 * n + (i & 3); }

struct Unit { int pm, pn, e, lu; };
struct Gemm { const bf16_t* A; const bf16_t* Bt; int K; size_t strideB; };

struct StaticOrder {
    int nM, nN, nwg, G, c;
    __host__ __device__ void init(int M, int N, int G_, int c_) { nM = M / BM; nN = N / BM; nwg = nM * nN; G = G_; c = c_; }
    __host__ __device__ bool next(int i, Unit& u) const {
        const long L = (long)i * G + c; if (L >= nwg) return false;
        int wgid = (int)L; { const int q = nwg / NXCD, r = nwg % NXCD, xcd = wgid % NXCD, off = wgid / NXCD; wgid = (xcd < r ? xcd * (q + 1) : r * (q + 1) + (xcd - r) * q) + off; }
        const int nig = WGM * nN, gid = wgid / nig, fm = gid * WGM, gsz = (nM - fm) < WGM ? (nM - fm) : WGM;
        u.pm = fm + ((wgid % nig) % gsz); u.pn = (wgid % nig) / gsz; u.e = 0; u.lu = 0; return true;
    }
};
struct GroupOrder {
    const LAS int* tstart; int NT, total, G, c;
    __device__ __forceinline__ bool next(int i, Unit& u) const {
        const int Lx = i * G + c; if (Lx >= total) return false;
        const int PM = Lx / NT; u.pn = Lx - PM * NT; u.pm = PM;
        int e = 0; while (__builtin_amdgcn_readfirstlane(tstart[e + 1]) <= PM) ++e;
        u.e = e; u.lu = i; return true;
    }
};

__device__ __forceinline__ unsigned cvt_pk_bf16(float lo, float hi) { unsigned r; asm volatile("v_cvt_pk_bf16_f32 %0, %1, %2" : "=v"(r) : "v"(lo), "v"(hi)); return r; }

struct EpiStoreBf16 {
    static constexpr bool PERM = true;
    bf16_t* O; int ldc;
    __device__ __forceinline__ void operator()(const f32x4 (&acc)[2][2][4][2], const Unit& u, int wr, int wc, int fr, int fq) const {
        const int row0 = u.pm * BM + wr * 64 + fr, col0 = u.pn * BM + wc * 32 + 8 * fq;
#pragma unroll
        for (int ai = 0; ai < 2; ++ai)
#pragma unroll
            for (int m = 0; m < 4; ++m) { bf16_t* rowp = O + (size_t)(row0 + ai * HALF + m * 16) * ldc + col0;
#pragma unroll
                for (int bj = 0; bj < 2; ++bj) { const f32x4 v0 = acc[ai][bj][m][0], v1 = acc[ai][bj][m][1];
                    u32x4 w; w.x = cvt_pk_bf16(v0[0], v0[1]); w.y = cvt_pk_bf16(v0[2], v0[3]); w.z = cvt_pk_bf16(v1[0], v1[1]); w.w = cvt_pk_bf16(v1[2], v1[3]);
                    *(u32x4*)(rowp + bj * HALF) = w; } }
    }
};
struct EpiResid {
    static constexpr bool PERM = false;
    float* X; const float* gate;
    __device__ __forceinline__ void operator()(const f32x4 (&acc)[2][2][4][2], const Unit& u, int wr, int wc, int fr, int fq) const {
        const int row0 = u.pm * BM + wr * 64 + fr, col0 = u.pn * BM + wc * 32 + 4 * fq;
        const int b = (u.pm * BM) >> 13;
        f32x4 gv[2][2];
#pragma unroll
        for (int bj = 0; bj < 2; ++bj)
#pragma unroll
            for (int n = 0; n < 2; ++n) gv[bj][n] = *(const f32x4*)(gate + (size_t)b * 6144 + col0 + bj * HALF + n * 16);
#pragma unroll
        for (int ai = 0; ai < 2; ++ai)
#pragma unroll
            for (int m = 0; m < 4; ++m) { float* rowp = X + (size_t)(row0 + ai * HALF + m * 16) * D + col0; f32x4 xv[2][2];
#pragma unroll
                for (int bj = 0; bj < 2; ++bj)
#pragma unroll
                    for (int n = 0; n < 2; ++n) xv[bj][n] = *(const f32x4*)(rowp + bj * HALF + n * 16);
#pragma unroll
                for (int bj = 0; bj < 2; ++bj)
#pragma unroll
                    for (int n = 0; n < 2; ++n) *(f32x4*)(rowp + bj * HALF + n * 16) = xv[bj][n] + gv[bj][n] * acc[ai][bj][m][n]; }
    }
};
struct EpiGU {
    static constexpr bool PERM = true;
    bf16_t* H; const LAS float* tabw;
    __device__ __forceinline__ void operator()(const f32x4 (&acc)[2][2][4][2], const Unit& u, int wr, int wc, int fr, int fq) const {
#pragma unroll
        for (int ai = 0; ai < 2; ++ai)
#pragma unroll
            for (int m = 0; m < 4; ++m) {
                const int rl = ai * HALF + wr * 64 + m * 16 + fr;
                const float w = tabw[u.lu * 256 + rl];
                bf16_t* rowp = H + (size_t)(u.pm * BM + rl) * DE + u.pn * HALF + wc * 32 + 8 * fq;
                float o[8];
#pragma unroll
                for (int n = 0; n < 2; ++n)
#pragma unroll
                    for (int j = 0; j < 4; ++j) { const float g = acc[ai][0][m][n][j], up = acc[ai][1][m][n][j]; o[n * 4 + j] = g * __builtin_amdgcn_rcpf(1.f + __builtin_amdgcn_exp2f(-1.4426950408889634f * g)) * up * w; }
                u32x4 wv; wv.x = cvt_pk_bf16(o[0], o[1]); wv.y = cvt_pk_bf16(o[2], o[3]); wv.z = cvt_pk_bf16(o[4], o[5]); wv.w = cvt_pk_bf16(o[6], o[7]);
                *(u32x4*)rowp = wv;
            }
    }
};

template <class Epi, class Sched, bool GATHER, bool ALIGN_EPI>
__device__ __forceinline__ void gemm_phase(LAS unsigned char* lds, const Gemm g, const Sched& S, const Epi& E, const LAS unsigned* taboff, int wave_id) {
    int lane = __builtin_amdgcn_mbcnt_hi(~0u, __builtin_amdgcn_mbcnt_lo(~0u, 0u)); asm volatile("" : "+v"(lane));
    const int wid = wave_id, tid = wid * 64 + lane, wr = wid >> 2, wc = wid & 3, fr = lane & 15, fq = lane >> 4;
    const int K = g.K, nt = K / BK;
    unsigned voffA[2], voffB[2]; int RA[2]; unsigned cA2[2];
#pragma unroll
    for (int i = 0; i < 2; ++i) { int R, C; stage_rc(tid * 16 + i * 8192, R, C); const int Rb = Epi::PERM ? ((R & ~31) + perm32(R & 31)) : R;
        voffA[i] = (unsigned)(R * K + C) * 2u; voffB[i] = (unsigned)(Rb * K + C) * 2u; RA[i] = R; cA2[i] = (unsigned)C * 2u; }
    const size_t kstep = (size_t)(BK * 2);
    const size_t hstep = (size_t)HALF * K * 2;
    const size_t tstep = 2 * hstep;
    const unsigned ldsw = (unsigned)wid * 1024u;
    const int aoff = lds_byte(wr * 64 + fr, fq * 8), boff = lds_byte(wc * 32 + fr, fq * 8);
#define PG8_SA(b, h) (((b) * 2 + (h)) * HTB)
#define PG8_SB(b, h) ((4 + (b) * 2 + (h)) * HTB)
#define PG8_STAGE(bufoff, gbase, voff) do { _Pragma("unroll") for (int _i = 0; _i < 2; ++_i) \
        __builtin_amdgcn_global_load_lds((const unsigned*)((const char*)(gbase) + (voff)[_i]), (LAS unsigned*)(lds + (bufoff) + ldsw + _i * 8192), 16, 0, 0); } while (0)
#define PG8_STAGE_A(bufoff, ap, h, GO) do { if constexpr (GATHER) { PG8_STAGE(bufoff, ap, (GO)[h]); } else { PG8_STAGE(bufoff, (ap) + (h) * hstep, voffA); } } while (0)
#define PG8_LDA(dst, b, h) do { _Pragma("unroll") for (int m = 0; m < 4; ++m) _Pragma("unroll") for (int k = 0; k < 2; ++k) dst[m][k] = *(const LAS bf16x8*)(lds + PG8_SA(b, h) + aoff + m * 2048 + k * 1024); } while (0)
#define PG8_LDB(dst, b, h) do { _Pragma("unroll") for (int n = 0; n < 2; ++n) _Pragma("unroll") for (int k = 0; k < 2; ++k) dst[n][k] = *(const LAS bf16x8*)(lds + PG8_SB(b, h) + boff + n * 2048 + k * 1024); } while (0)
#define PG8_MMA(ai, bj, At, Bt) do { __builtin_amdgcn_s_setprio(1); _Pragma("unroll") for (int m = 0; m < 4; ++m) _Pragma("unroll") for (int n = 0; n < 2; ++n) _Pragma("unroll") for (int k = 0; k < 2; ++k) \
        acc[ai][bj][m][n] = __builtin_amdgcn_mfma_f32_16x16x32_bf16(Bt[n][k], At[m][k], acc[ai][bj][m][n], 0, 0, 0); __builtin_amdgcn_s_setprio(0); } while (0)
#define PG8_WAIT_V(n) asm volatile("s_waitcnt vmcnt(" #n ")" ::: "memory")
#define PG8_WAIT_L(n) asm volatile("s_waitcnt lgkmcnt(" #n ")" ::: "memory")
#define PG8_BAR __builtin_amdgcn_s_barrier()
#define PG8_SCHED __builtin_amdgcn_sched_barrier(0)
#define PG8_GOLOAD(dst, un) do { _Pragma("unroll") for (int _h = 0; _h < 2; ++_h) _Pragma("unroll") for (int _i = 0; _i < 2; ++_i) dst[_h][_i] = taboff[(un).lu * 256 + _h * HALF + RA[_i]] + cA2[_i]; } while (0)
    Unit cur, nxt; int ui = 0;
    if (!S.next(0, cur)) return;
    f32x4 acc[2][2][4][2];
#pragma unroll
    for (int a = 0; a < 2; ++a)
#pragma unroll
        for (int b = 0; b < 2; ++b)
#pragma unroll
            for (int m = 0; m < 4; ++m)
#pragma unroll
                for (int n = 0; n < 2; ++n) acc[a][b][m][n] = (f32x4){0.f, 0.f, 0.f, 0.f};
    bf16x8 At[4][2], B0[2][2], B1[2][2];
    unsigned goC[2][2] = {{0u, 0u}, {0u, 0u}}, goN[2][2] = {{0u, 0u}, {0u, 0u}};
    const char* cA = GATHER ? (const char*)g.A : (const char*)g.A + (size_t)cur.pm * tstep;
    const char* cB = (const char*)g.Bt + (size_t)cur.e * g.strideB + (size_t)cur.pn * tstep;
    if constexpr (GATHER) { PG8_GOLOAD(goC, cur); PG8_WAIT_L(0); }
    PG8_STAGE(PG8_SB(0, 0), cB, voffB); PG8_STAGE(PG8_SB(0, 1), cB + hstep, voffB); PG8_STAGE_A(PG8_SA(0, 0), cA, 0, goC); PG8_STAGE_A(PG8_SA(0, 1), cA, 1, goC);
    if (wr == 1) PG8_BAR;
    PG8_WAIT_V(2); PG8_BAR;
    PG8_STAGE(PG8_SB(1, 0), cB + kstep, voffB); PG8_STAGE_A(PG8_SA(1, 0), cA + kstep, 0, goC); PG8_STAGE(PG8_SB(1, 1), cB + hstep + kstep, voffB);
    PG8_WAIT_V(6); PG8_BAR;
    for (;;) {
        const bool has_next = S.next(ui + 1, nxt);
        const char* nA = GATHER ? (const char*)g.A : (has_next ? (const char*)g.A + (size_t)nxt.pm * tstep : cA);
        const char* nB = has_next ? (const char*)g.Bt + (size_t)nxt.e * g.strideB + (size_t)nxt.pn * tstep : cB;
        if constexpr (GATHER) {
            if (has_next) { PG8_GOLOAD(goN, nxt); }
            else {
#pragma unroll
                for (int _h = 0; _h < 2; ++_h)
#pragma unroll
                    for (int _i = 0; _i < 2; ++_i) goN[_h][_i] = goC[_h][_i];
            }
        }
#pragma unroll 1
        for (int t = 0; t < nt; t += 2) {
            const bool last = (t == nt - 2);
            const char* a1 = cA + (size_t)(t + 1) * kstep;
            const char* a2 = last ? nA : cA + (size_t)(t + 2) * kstep; const char* b2 = last ? nB : cB + (size_t)(t + 2) * kstep;
            const char* a3 = a2 + kstep; const char* b3 = b2 + kstep;
            unsigned go2[2][2];
#pragma unroll
            for (int _h = 0; _h < 2; ++_h)
#pragma unroll
                for (int _i = 0; _i < 2; ++_i) go2[_h][_i] = last ? goN[_h][_i] : goC[_h][_i];
            PG8_LDB(B0, 0, 0); PG8_LDB(B1, 0, 1); PG8_SCHED; PG8_LDA(At, 0, 0); PG8_STAGE_A(PG8_SA(1, 1), a1, 1, goC);
            PG8_WAIT_V(8); PG8_WAIT_L(0); PG8_BAR; PG8_MMA(0, 0, At, B0); PG8_MMA(0, 1, At, B1); PG8_BAR; PG8_SCHED;
            PG8_LDA(At, 0, 1); PG8_STAGE(PG8_SB(0, 0), b2, voffB); PG8_STAGE(PG8_SB(0, 1), b2 + hstep, voffB); PG8_STAGE_A(PG8_SA(0, 0), a2, 0, go2);
            PG8_WAIT_V(8); PG8_WAIT_L(0); PG8_BAR; PG8_MMA(1, 0, At, B0); PG8_MMA(1, 1, At, B1); PG8_BAR; PG8_SCHED;
            PG8_LDB(B0, 1, 0); PG8_LDB(B1, 1, 1); PG8_SCHED; PG8_LDA(At, 1, 0); PG8_STAGE_A(PG8_SA(0, 1), a2, 1, go2);
            PG8_WAIT_V(8); PG8_WAIT_L(0); PG8_BAR; PG8_MMA(0, 0, At, B0); PG8_MMA(0, 1, At, B1); PG8_BAR; PG8_SCHED;
            PG8_LDA(At, 1, 1); PG8_STAGE(PG8_SB(1, 0), b3, voffB); PG8_STAGE(PG8_SB(1, 1), b3 + hstep, voffB); PG8_STAGE_A(PG8_SA(1, 0), a3, 0, go2);
            PG8_WAIT_V(8); PG8_WAIT_L(0); PG8_BAR; PG8_MMA(1, 0, At, B0); PG8_MMA(1, 1, At, B1); PG8_BAR; PG8_SCHED;
        }
        if constexpr (ALIGN_EPI) { if (wr == 0) PG8_BAR; }
        E(acc, cur, wr, wc, fr, fq);
        if (!has_next) break;
#pragma unroll
        for (int a = 0; a < 2; ++a)
#pragma unroll
            for (int b = 0; b < 2; ++b)
#pragma unroll
                for (int m = 0; m < 4; ++m)
#pragma unroll
                    for (int n = 0; n < 2; ++n) acc[a][b][m][n] = (f32x4){0.f, 0.f, 0.f, 0.f};
        cur = nxt; cA = nA; cB = nB; ++ui;
#pragma unroll
        for (int _h = 0; _h < 2; ++_h)
#pragma unroll
            for (int _i = 0; _i < 2; ++_i) goC[_h][_i] = goN[_h][_i];
        if constexpr (ALIGN_EPI) { if (wr == 1) PG8_BAR; }
    }
    PG8_WAIT_V(0);
    if constexpr (!ALIGN_EPI) { if (wr == 0) PG8_BAR; }
    PG8_BAR;
#undef PG8_SA
#undef PG8_SB
#undef PG8_STAGE
#undef PG8_STAGE_A
#undef PG8_LDA
#undef PG8_LDB
#undef PG8_MMA
#undef PG8_WAIT_V
#undef PG8_WAIT_L
#undef PG8_BAR
#undef PG8_SCHED
#undef PG8_GOLOAD
}
}

__device__ __forceinline__ void cvt_tile(const float* Wsrc, int ldn, bf16* dst, int Kd, LAS float* scr, int lane) {
#pragma unroll 8
    for (int i = 0; i < 32; ++i) { const int kk = 2 * i + (lane >> 5); scr[kk * 33 + (lane & 31)] = Wsrc[(size_t)kk * ldn + (lane & 31)]; }
    asm volatile("s_waitcnt lgkmcnt(0)" ::: "memory");
    const int c = lane & 7;
#pragma unroll
    for (int j = 0; j < 4; ++j) { const int n = (lane >> 3) + 8 * j; const LAS float* s = scr + (8 * c) * 33 + n;
        u32x4 o; o.x = pk2(s[0 * 33], s[1 * 33]); o.y = pk2(s[2 * 33], s[3 * 33]); o.z = pk2(s[4 * 33], s[5 * 33]); o.w = pk2(s[6 * 33], s[7 * 33]);
        *(u32x4*)(dst + (size_t)n * Kd + 8 * c) = o; }
    asm volatile("s_waitcnt lgkmcnt(0)" ::: "memory");
}
constexpr int CV_IN = 16 * 104, CV_OUT = 16 * 32, CV_GU = NE * 256, CV_DN = NE * 128, CV_LAYER = CV_IN + CV_OUT + CV_GU + CV_DN;
__device__ __forceinline__ void cvt_item(const Args& a, int l, int r, LAS float* scr, int lane) {
    if (r < CV_IN) {
        const int kb = r / 104, nb = r % 104, nd = nb * 32, ns = nd + (nd >= R_DT ? 8 : 0);
        cvt_tile(a.in[7] + (size_t)l * D * DIN + (size_t)kb * 64 * DIN + ns, DIN, (bf16*)(a.ws + WS_WIN) + (size_t)l * NP * D + (size_t)nd * D + kb * 64, D, scr, lane); return; }
    r -= CV_IN;
    if (r < CV_OUT) {
        const int kb = r / 32, nb = r % 32;
        cvt_tile(a.in[16] + (size_t)l * D * D + (size_t)kb * 64 * D + nb * 32, D, (bf16*)(a.ws + WS_WOUT) + (size_t)l * D * D + (size_t)nb * 32 * D + kb * 64, D, scr, lane); return; }
    r -= CV_OUT;
    if (r < CV_GU) {
        const int e = r / 256, q = r % 256, kb = q / 16, nb = q % 16, pn = nb / 8, half = (nb % 8) / 4, i0 = (nb % 4) * 32;
        const float* W = (half ? a.in[22] : a.in[21]) + ((size_t)l * NE + e) * D * DE;
        cvt_tile(W + (size_t)kb * 64 * DE + pn * 128 + i0, DE, (bf16*)(a.ws + WS_WGU) + ((size_t)l * NE + e) * 512 * D + (size_t)nb * 32 * D + kb * 64, D, scr, lane); return; }
    r -= CV_GU;
    {
        const int e = r / 128, q = r % 128, kb = q / 32, nb = q % 32;
        const float* W = a.in[23] + ((size_t)l * NE + e) * DE * D;
        cvt_tile(W + (size_t)kb * 64 * D + nb * 32, D, (bf16*)(a.ws + WS_WD) + ((size_t)l * NE + e) * D * DE + (size_t)nb * 32 * DE + kb * 64, DE, scr, lane);
    }
}
__device__ __forceinline__ void convert_router(const Args& a, int gtid, int gthreads) {
    bf16* wr = (bf16*)(a.ws + WS_WR);
    for (int i = gtid; i < DEPTH * 48 * D; i += gthreads) {
        const int l = i / (48 * D), n = (i / D) % 48, k = i % D;
        float w = 0.f;
        if (n < 32) w = a.in[19][((size_t)l * D + k) * NE + n]; else if (n < 36) w = a.in[17][((size_t)l * D + k) * 4 + (n - 32)];
        const unsigned hi = f2bf(w);
        wr[((size_t)l * 2 * 48 + n) * D + k] = (bf16)hi;
        wr[((size_t)l * 2 * 48 + 48 + n) * D + k] = (bf16)f2bf(w - __uint_as_float(hi << 16));
    }
}
__device__ __forceinline__ void convert_dt(const Args& a, int gtid, int gthreads) {
    bf16* wd = (bf16*)(a.ws + WS_WDT);
    for (int i = gtid; i < DEPTH * 16 * D; i += gthreads) {
        const int l = i / (16 * D), n = (i / D) % 16, k = i % D;
        const float w = (n < 8) ? a.in[7][((size_t)l * D + k) * DIN + R_DT + n] : 0.f;
        const unsigned hi = f2bf(w);
        wd[((size_t)l * 2 * 16 + n) * D + k] = (bf16)hi;
        wd[((size_t)l * 2 * 16 + 16 + n) * D + k] = (bf16)f2bf(w - __uint_as_float(hi << 16));
    }
}
__device__ __forceinline__ void phase_convert(const Args& a, LAS unsigned char* lds, int gw, int ngw, int wave, int lane) {
    convert_router(a, gw * 64 + lane, ngw * 64);
    convert_dt(a, gw * 64 + lane, ngw * 64);
    LAS float* scr = (LAS float*)(lds + LDS_STAGE + 32768 + wave * 8704);
    for (int it = gw; it < DEPTH * CV_LAYER; it += ngw) cvt_item(a, it / CV_LAYER, it % CV_LAYER, scr, lane);
}

__device__ __forceinline__ void phase_gemm_in(const Args& a, int layer, LAS unsigned char* lds, int G, int bid, int wave) {
    pg8::Gemm g{(const bf16*)(a.ws + WS_H), (const bf16*)(a.ws + WS_WIN) + (size_t)layer * NP * D, D, 0};
    pg8::StaticOrder S; S.init(T, NP, G, bid);
    pg8::EpiStoreBf16 E{(bf16*)(a.ws + WS_PROJ), NP};
    pg8::gemm_phase<pg8::EpiStoreBf16, pg8::StaticOrder, false, true>(lds + LDS_STAGE, g, S, E, nullptr, wave);
}
__device__ __forceinline__ void phase_gemm_out(const Args& a, int layer, LAS unsigned char* lds, int G, int bid, int wave) {
    pg8::Gemm g{(const bf16*)(a.ws + WS_MIXED), (const bf16*)(a.ws + WS_WOUT) + (size_t)layer * D * D, D, 0};
    pg8::StaticOrder S; S.init(T, D, G, bid);
    pg8::EpiResid E{(float*)(a.ws + WS_XW), (const float*)(a.ws + WS_MOD) + (size_t)layer * NB * 6144 + 2 * D};
    pg8::gemm_phase<pg8::EpiResid, pg8::StaticOrder, false, false>(lds + LDS_STAGE, g, S, E, nullptr, wave);
}
__device__ __forceinline__ void build_tstart(const int* cnt, LAS int* tstart, int tid) {
    if (tid == 0) { int s = 0; for (int e = 0; e < NE; ++e) { tstart[e] = s; s += (cnt[e * CNT_STRIDE] + 255) >> 8; } tstart[NE] = s; }
    __syncthreads();
}
constexpr int MAXU = 4;
__device__ __forceinline__ void phase_gemm_gu(const Args& a, int layer, LAS unsigned char* lds, int G, int bid, int tid, int wave) {
    const int* cnt = (const int*)(a.ws + WS_CTL) + CW_CNT + layer * NE * CNT_STRIDE;
    LAS int* tstart = (LAS int*)(lds + LDS_TSTART);
    LAS unsigned* taboff = (LAS unsigned*)(lds + LDS_TAB);
    LAS float* tabw = (LAS float*)(lds + LDS_TAB + MAXU * 1024);
    build_tstart(cnt, tstart, tid);
    pg8::GroupOrder S{tstart, 2, __builtin_amdgcn_readfirstlane(tstart[NE]) * 2, G, bid};
    const int* list = (const int*)(a.ws + WS_LIST); const float* wl = (const float*)(a.ws + WS_WL);
    for (int i = 0; i < MAXU; ++i) {
        pg8::Unit u;
        if (!S.next(i, u)) break;
        if (tid < 256) {
            const int slot = (u.pm - tstart[u.e]) * 256 + tid;
            const bool v = slot < cnt[u.e * CNT_STRIDE];
            const int tok = v ? list[(size_t)u.e * T + slot] : 0;
            taboff[i * 256 + tid] = (unsigned)tok * (unsigned)(D * 2);
            tabw[i * 256 + tid] = v ? wl[(size_t)u.e * T + slot] : 0.f;
        }
    }
    __syncthreads();
    pg8::Gemm g{(const bf16*)(a.ws + WS_H), (const bf16*)(a.ws + WS_WGU) + (size_t)layer * NE * 512 * D, D, (size_t)512 * D * 2};
    pg8::EpiGU E{(bf16*)(a.ws + WS_HID), tabw};
    pg8::gemm_phase<pg8::EpiGU, pg8::GroupOrder, true, true>(lds + LDS_STAGE, g, S, E, taboff, wave);
}
__device__ __forceinline__ void phase_gemm_dn(const Args& a, int layer, LAS unsigned char* lds, int G, int bid, int tid, int wave) {
    const int* cnt = (const int*)(a.ws + WS_CTL) + CW_CNT + layer * NE * CNT_STRIDE;
    LAS int* tstart = (LAS int*)(lds + LDS_TSTART);
    build_tstart(cnt, tstart, tid);
    pg8::GroupOrder S{tstart, 4, __builtin_amdgcn_readfirstlane(tstart[NE]) * 4, G, bid};
    pg8::Gemm g{(const bf16*)(a.ws + WS_HID), (const bf16*)(a.ws + WS_WD) + (size_t)layer * NE * D * DE, DE, (size_t)D * DE * 2};
    pg8::EpiStoreBf16 E{(bf16*)(a.ws + WS_Y), D};
    pg8::gemm_phase<pg8::EpiStoreBf16, pg8::GroupOrder, false, true>(lds + LDS_STAGE, g, S, E, nullptr, wave);
}

#define PROBE_SUB 0
constexpr int NATP = 144, TRP = 272;
typedef short s16x8 __attribute__((ext_vector_type(8)));
typedef short s16x4 __attribute__((ext_vector_type(4)));
__device__ __forceinline__ f32x4 mfma32(s16x8 a, s16x8 b, f32x4 c) { return __builtin_amdgcn_mfma_f32_16x16x32_bf16(a, b, c, 0, 0, 0); }
__device__ __forceinline__ f32x4 mfma16(s16x4 a, s16x4 b, f32x4 c) { return __builtin_amdgcn_mfma_f32_16x16x16bf16_1k(a, b, c, 0, 0, 0); }
__device__ __forceinline__ s16x8 cat8(u32x2 lo, u32x2 hi) { u32x4 v = {lo.x, lo.y, hi.x, hi.y}; return __builtin_bit_cast(s16x8, v); }
__device__ __forceinline__ s16x8 ld8(const LAS unsigned char* p) { return *(const LAS s16x8*)p; }
__device__ __forceinline__ u32x2 ld4(const LAS unsigned char* p) { return *(const LAS u32x2*)p; }
__device__ __forceinline__ void wr_run_T(LAS unsigned char* rowp, const float (&x)[16]) {
    u32x4 w0 = {pk2(x[0], x[1]), pk2(x[2], x[3]), pk2(x[4], x[5]), pk2(x[6], x[7])}, w1 = {pk2(x[8], x[9]), pk2(x[10], x[11]), pk2(x[12], x[13]), pk2(x[14], x[15])};
    *(LAS u32x4*)rowp = w0; *(LAS u32x4*)(rowp + 16) = w1;
}
__device__ __forceinline__ void wr_run_N(LAS unsigned char* colp, const float (&x)[16]) {
#pragma unroll
    for (int tt = 0; tt < 16; tt += 2) { const unsigned p = pk2(x[tt], x[tt + 1]); *(LAS unsigned short*)(colp + tt * NATP) = (unsigned short)p; *(LAS unsigned short*)(colp + (tt + 1) * NATP) = (unsigned short)(p >> 16); }
}
__device__ __forceinline__ float ret_log2_gamma(int h) { return log2f(1.f - exp2f(-5.f - (float)h)); }

__device__ __forceinline__ void ld_run16(const bf16* proj, size_t row0, int col, unsigned (&r)[16]) {
#pragma unroll
    for (int tt = 0; tt < 16; ++tt) r[tt] = (unsigned)proj[(row0 + tt) * NP + col];
}
__device__ __forceinline__ void ret_rot(const unsigned (&r)[16], const float* rope, int p0, int lane, float scale, float (&x)[16]) {
#pragma unroll
    for (int tt = 0; tt < 16; ++tt) {
        const float own = __uint_as_float(r[tt] << 16), oth = xor32(own, lane);
        const float2 cs = *(const float2*)(rope + ((size_t)(p0 + tt) * 32 + (lane & 31)) * 2);
        x[tt] = ((lane < 32) ? (own * cs.x - oth * cs.y) : (oth * cs.y + own * cs.x)) * scale;
    }
}
__device__ __forceinline__ void ret_m1(const Args& a, LAS unsigned char* lds, int b, int c, int half, int tid) {
    asm volatile("" : "+v"(tid), "+s"(b), "+s"(c));
    const bf16* proj = (const bf16*)(a.ws + WS_PROJ); const float* rope = (const float*)(a.ws + WS_ROPE);
    float* ST = (float*)(a.ws + WS_ST); float* DEC = (float*)(a.ws + WS_DEC);
    const int j = tid >> 6, lane = tid & 63, fr = lane & 15, q = lane >> 4;
    LAS unsigned char* KT = lds; LAS unsigned char* VT = lds + 2 * 64 * TRP;
    const size_t row0 = (size_t)b * L + c * 128 + 16 * j; const int p0 = c * 128 + 16 * j;
    {
        unsigned rk[2][16], rv[2][16];
#pragma unroll
        for (int hd = 0; hd < 2; ++hd) { ld_run16(proj, row0, C_RK + (2 * half + hd) * 64 + lane, rk[hd]); ld_run16(proj, row0, C_RV + (2 * half + hd) * 64 + lane, rv[hd]); }
#pragma unroll
        for (int hd = 0; hd < 2; ++hd) {
            const float lg = ret_log2_gamma(2 * half + hd);
            float kr[16], vv[16];
            ret_rot(rk[hd], rope, p0, lane, 0.125f, kr);
#pragma unroll
            for (int tt = 0; tt < 16; ++tt) { kr[tt] *= fexp2((float)(127 - (16 * j + tt)) * lg); vv[tt] = __uint_as_float(rv[hd][tt] << 16); }
            wr_run_T(KT + (hd * 64 + lane) * TRP + 32 * j, kr);
            wr_run_T(VT + (hd * 64 + lane) * TRP + 32 * j, vv);
        }
    }
    __syncthreads();
    {
        const int hd = j >> 2, vt = j & 3, head = 12 + 2 * half + hd;
        s16x8 Af[4];
#pragma unroll
        for (int ss = 0; ss < 4; ++ss) Af[ss] = ld8(VT + (hd * 64 + 16 * vt + fr) * TRP + (32 * ss + 8 * q) * 2);
        float* dst = ST + (((size_t)b * 64 + c) * 16 + head) * 4096;
#pragma unroll
        for (int kt = 0; kt < 4; ++kt) {
            f32x4 acc = {0.f, 0.f, 0.f, 0.f};
#pragma unroll
            for (int ss = 0; ss < 4; ++ss) acc = mfma32(Af[ss], ld8(KT + (hd * 64 + 16 * kt + fr) * TRP + (32 * ss + 8 * q) * 2), acc);
#pragma unroll
            for (int r = 0; r < 4; ++r) dst[(16 * vt + 4 * q + r) * 64 + 16 * kt + fr] = acc[r];
        }
        if (tid < 128) { const int hd2 = tid >> 6, h2 = 2 * half + hd2; DEC[(((size_t)b * 64 + c) * 16 + 12 + h2) * 64 + (tid & 63)] = exp2f(128.f * ret_log2_gamma(h2)); }
    }
    __syncthreads();
}
__device__ __forceinline__ void ret_m3(const Args& a, LAS unsigned char* lds, int b, int c, int half, int tid) {
    asm volatile("" : "+v"(tid), "+s"(b), "+s"(c));
    const bf16* proj = (const bf16*)(a.ws + WS_PROJ); const float* rope = (const float*)(a.ws + WS_ROPE);
    const float* ST = (const float*)(a.ws + WS_ST); bf16* mixed = (bf16*)(a.ws + WS_MIXED);
    const int j = tid >> 6, lane = tid & 63, fr = lane & 15, q = lane >> 4;
    LAS unsigned char* QN = lds; LAS unsigned char* KN = QN + 2 * 128 * NATP; LAS unsigned char* VT = KN + 2 * 128 * NATP; LAS unsigned char* SN = VT + 2 * 64 * TRP;
    const size_t row0 = (size_t)b * L + c * 128 + 16 * j; const int p0 = c * 128 + 16 * j;
    {
        unsigned rq[2][16], rk[2][16], rv[2][16];
#pragma unroll
        for (int hd = 0; hd < 2; ++hd) { const int h = 2 * half + hd; ld_run16(proj, row0, C_RQ + h * 64 + lane, rq[hd]); ld_run16(proj, row0, C_RK + h * 64 + lane, rk[hd]); ld_run16(proj, row0, C_RV + h * 64 + lane, rv[hd]); }
#pragma unroll
        for (int hd = 0; hd < 2; ++hd) {
            float x[16];
            ret_rot(rq[hd], rope, p0, lane, 1.f, x);
            wr_run_N(QN + (hd * 128 + 16 * j) * NATP + lane * 2, x);
            ret_rot(rk[hd], rope, p0, lane, 0.125f, x);
            wr_run_N(KN + (hd * 128 + 16 * j) * NATP + lane * 2, x);
#pragma unroll
            for (int tt = 0; tt < 16; ++tt) x[tt] = __uint_as_float(rv[hd][tt] << 16);
            wr_run_T(VT + (hd * 64 + lane) * TRP + 32 * j, x);
        }
    }
    {
        const int idx = tid * 16, hd = idx >> 12, rem = idx & 4095, v = rem >> 6, k0 = rem & 63;
        const float* src = ST + (((size_t)b * 64 + c) * 16 + 12 + 2 * half + hd) * 4096 + v * 64 + k0;
        const f32x4 s0 = *(const f32x4*)src, s1 = *(const f32x4*)(src + 4), s2 = *(const f32x4*)(src + 8), s3 = *(const f32x4*)(src + 12);
        u32x4 w0 = {pk2(s0.x, s0.y), pk2(s0.z, s0.w), pk2(s1.x, s1.y), pk2(s1.z, s1.w)}, w1 = {pk2(s2.x, s2.y), pk2(s2.z, s2.w), pk2(s3.x, s3.y), pk2(s3.z, s3.w)};
        LAS unsigned char* d = SN + (hd * 64 + v) * NATP + k0 * 2;
        *(LAS u32x4*)d = w0; *(LAS u32x4*)(d + 16) = w1;
    }
    __syncthreads();
#pragma unroll 1
    for (int hd = 0; hd < 2; ++hd) {
        const int w = (hd == 0) ? j : 7 - j, tl = 16 * w + fr;
        const int h = 2 * half + hd; const float lg = ret_log2_gamma(h);
        const size_t row = (size_t)b * L + c * 128 + tl;
        u32x2 gzr[4];
#pragma unroll
        for (int vt = 0; vt < 4; ++vt) gzr[vt] = *(const u32x2*)(proj + row * NP + C_RG + h * 64 + 16 * vt + 4 * q);
        s16x8 Qf[2];
#pragma unroll
        for (int ks = 0; ks < 2; ++ks) Qf[ks] = ld8(QN + (hd * 128 + 16 * w + fr) * NATP + (32 * ks + 8 * q) * 2);
        f32x4 oacc[4];
#pragma unroll
        for (int vt = 0; vt < 4; ++vt) {
            f32x4 t = {0.f, 0.f, 0.f, 0.f};
#pragma unroll
            for (int ks = 0; ks < 2; ++ks) t = mfma32(ld8(SN + (hd * 64 + 16 * vt + fr) * NATP + (32 * ks + 8 * q) * 2), Qf[ks], t);
            oacc[vt] = t * fexp2((float)(tl + 1) * lg);
        }
#pragma unroll 1
        for (int pa = 0; pa <= (w >> 1); ++pa) {
            unsigned pb[4];
#pragma unroll
            for (int u = 0; u < 2; ++u) {
                const int st = 2 * pa + u;
                f32x4 sc = {0.f, 0.f, 0.f, 0.f};
                if (st <= w) {
#pragma unroll
                    for (int ks = 0; ks < 2; ++ks) sc = mfma32(ld8(KN + (hd * 128 + 16 * st + fr) * NATP + (32 * ks + 8 * q) * 2), Qf[ks], sc);
                }
                float p[4];
#pragma unroll
                for (int r = 0; r < 4; ++r) { const int d = tl - (16 * st + 4 * q + r); p[r] = (d >= 0 && st <= w) ? sc[r] * fexp2((float)d * lg) : 0.f; }
                pb[2 * u] = pk2(p[0], p[1]); pb[2 * u + 1] = pk2(p[2], p[3]);
            }
            const u32x4 pbv = {pb[0], pb[1], pb[2], pb[3]};
            const s16x8 Bp = __builtin_bit_cast(s16x8, pbv);
#pragma unroll
            for (int vt = 0; vt < 4; ++vt) {
                const LAS unsigned char* vp = VT + (hd * 64 + 16 * vt + fr) * TRP + (32 * pa + 4 * q) * 2;
                oacc[vt] = mfma32(cat8(ld4(vp), ld4(vp + 32)), Bp, oacc[vt]);
            }
        }
        float ss = 0.f;
#pragma unroll
        for (int vt = 0; vt < 4; ++vt) ss += (oacc[vt].x * oacc[vt].x + oacc[vt].y * oacc[vt].y) + (oacc[vt].z * oacc[vt].z + oacc[vt].w * oacc[vt].w);
        ss += swz_xor<16>(ss); ss += xor32(ss, lane);
        const float rinv = rsqrtf(ss * (1.f / 64.f) + EPS);
#pragma unroll
        for (int vt = 0; vt < 4; ++vt) {
            const int col = h * 64 + 16 * vt + 4 * q;
            const u32x2 gz = gzr[vt];
            const float g0 = __uint_as_float(gz.x << 16), g1 = __uint_as_float(gz.x & 0xffff0000u), g2 = __uint_as_float(gz.y << 16), g3 = __uint_as_float(gz.y & 0xffff0000u);
            u32x2 o; o.x = pk2(oacc[vt].x * rinv * siluf(g0), oacc[vt].y * rinv * siluf(g1)); o.y = pk2(oacc[vt].z * rinv * siluf(g2), oacc[vt].w * rinv * siluf(g3));
            *(u32x2*)(mixed + row * D + 768 + col) = o;
        }
    }
    __syncthreads();
}

__device__ __forceinline__ void ssd_load_raw(const bf16* proj, size_t row0, int p0, int ch, unsigned (&r)[19]) {
#pragma unroll
    for (int i = 0; i < 19; ++i) { const int p = p0 - 3 + i; const size_t rw = (p >= 0) ? row0 + i - 3 : row0; const unsigned v = (unsigned)proj[rw * NP + C_XBC + ch]; r[i] = (p >= 0) ? v : 0u; }
}
__device__ __forceinline__ void ssd_conv(const unsigned (&r)[19], int ch, const float* cw, const float* cb, float (&x)[16]) {
    const float w0 = cw[ch], w1 = cw[768 + ch], w2 = cw[2 * 768 + ch], w3 = cw[3 * 768 + ch], bb = cb[ch];
#pragma unroll
    for (int tt = 0; tt < 16; ++tt) x[tt] = siluf(bb + w0 * __uint_as_float(r[tt] << 16) + w1 * __uint_as_float(r[tt + 1] << 16) + w2 * __uint_as_float(r[tt + 2] << 16) + w3 * __uint_as_float(r[tt + 3] << 16));
}
__device__ __forceinline__ void ssd_scalars(const Args& a, int layer, int b, int c, int g, int tid, LAS float* aL, LAS float* cumL, LAS float* dtL) {
    const float* dtraw = (const float*)(a.ws + WS_DT);
    const int hl = tid >> 7, t = tid & 127, h = 4 * g + hl;
    const float dt = softplusf(dtraw[((size_t)b * L + c * 128 + t) * 8 + h] + a.in[10][layer * 8 + h]);
    dtL[tid] = dt; aL[tid] = -expf(a.in[11][layer * 8 + h]) * dt;
    __syncthreads();
    float cs = 0.f;
#pragma unroll
    for (int i = 0; i < 16; ++i) { const float v = aL[hl * 128 + (t & ~15) + i]; cs += (i <= (t & 15)) ? v : 0.f; }
    LAS float* bs = aL + 512 + 512 + 512;
    if ((t & 15) == 15) bs[hl * 8 + (t >> 4)] = cs;
    __syncthreads();
#pragma unroll
    for (int i = 0; i < 7; ++i) { const float v = bs[hl * 8 + i]; cs += (i < (t >> 4)) ? v : 0.f; }
    cumL[tid] = cs;
    __syncthreads();
}
__device__ __forceinline__ void ssd_m1(const Args& a, int layer, LAS unsigned char* lds, int b, int c, int g, int tid) {
    asm volatile("" : "+v"(tid), "+s"(b), "+s"(c));
    const bf16* proj = (const bf16*)(a.ws + WS_PROJ);
    const float* cw = a.in[8] + (size_t)layer * 4 * 768; const float* cb = a.in[9] + (size_t)layer * 768;
    float* ST = (float*)(a.ws + WS_ST); float* DEC = (float*)(a.ws + WS_DEC);
    const int j = tid >> 6, lane = tid & 63, fr = lane & 15, q = lane >> 4;
    LAS unsigned char* XT = lds; LAS unsigned char* BT = lds + 4 * 64 * TRP;
    LAS float* aL = (LAS float*)(lds + 5 * 64 * TRP); LAS float* cumL = aL + 512; LAS float* dtL = cumL + 512; LAS float* wL = dtL + 512;
    const size_t row0 = (size_t)b * L + c * 128 + 16 * j; const int p0 = c * 128 + 16 * j;
    {
        unsigned raw[5][19];
#pragma unroll
        for (int i = 0; i < 5; ++i) ssd_load_raw(proj, row0, p0, (i < 4 ? (4 * g + i) * 64 : 512 + g * 64) + lane, raw[i]);
        float x[16];
#pragma unroll
        for (int hl = 0; hl < 4; ++hl) {
            ssd_conv(raw[hl], (4 * g + hl) * 64 + lane, cw, cb, x);
            wr_run_T(XT + (hl * 64 + lane) * TRP + 32 * j, x);
        }
        ssd_conv(raw[4], 512 + g * 64 + lane, cw, cb, x);
        wr_run_T(BT + lane * TRP + 32 * j, x);
    }
    ssd_scalars(a, layer, b, c, g, tid, aL, cumL, dtL);
    {
        const int hl = tid >> 7, t = tid & 127;
        const float cl = cumL[hl * 128 + 127];
        wL[tid] = expf(cl - cumL[tid]) * dtL[tid];
        if (t < 64) DEC[(((size_t)b * 64 + c) * 16 + 4 * g + hl) * 64 + t] = expf(cl);
    }
    __syncthreads();
    {
        const int hl = j >> 1;
        float* dst = ST + (((size_t)b * 64 + c) * 16 + 4 * g + hl) * 4096;
#pragma unroll 1
        for (int vi = 0; vi < 2; ++vi) {
            const int vt = (j & 1) * 2 + vi;
            s16x8 Af[4];
#pragma unroll
            for (int ss = 0; ss < 4; ++ss) {
                const u32x4 au = *(const LAS u32x4*)(XT + (hl * 64 + 16 * vt + fr) * TRP + (32 * ss + 8 * q) * 2);
                const f32x4 w0 = *(const LAS f32x4*)(wL + hl * 128 + 32 * ss + 8 * q), w1 = *(const LAS f32x4*)(wL + hl * 128 + 32 * ss + 8 * q + 4);
                u32x4 o;
                o.x = pk2(__uint_as_float(au.x << 16) * w0.x, __uint_as_float(au.x & 0xffff0000u) * w0.y);
                o.y = pk2(__uint_as_float(au.y << 16) * w0.z, __uint_as_float(au.y & 0xffff0000u) * w0.w);
                o.z = pk2(__uint_as_float(au.z << 16) * w1.x, __uint_as_float(au.z & 0xffff0000u) * w1.y);
                o.w = pk2(__uint_as_float(au.w << 16) * w1.z, __uint_as_float(au.w & 0xffff0000u) * w1.w);
                Af[ss] = __builtin_bit_cast(s16x8, o);
            }
#pragma unroll
            for (int kt = 0; kt < 4; ++kt) {
                f32x4 acc = {0.f, 0.f, 0.f, 0.f};
#pragma unroll
                for (int ss = 0; ss < 4; ++ss) acc = mfma32(Af[ss], ld8(BT + (16 * kt + fr) * TRP + (32 * ss + 8 * q) * 2), acc);
#pragma unroll
                for (int r = 0; r < 4; ++r) dst[(16 * vt + 4 * q + r) * 64 + 16 * kt + fr] = acc[r];
            }
        }
    }
    __syncthreads();
}
__device__ __forceinline__ void stage_states2(const float* ST, int b, int c, int head0, LAS unsigned char* SN, int tid) {
    const int idx = tid * 16, hd = idx >> 12, rem = idx & 4095, v = rem >> 6, k0 = rem & 63;
    const float* src = ST + (((size_t)b * 64 + c) * 16 + head0 + hd) * 4096 + v * 64 + k0;
    const f32x4 s0 = *(const f32x4*)src, s1 = *(const f32x4*)(src + 4), s2 = *(const f32x4*)(src + 8), s3 = *(const f32x4*)(src + 12);
    u32x4 w0 = {pk2(s0.x, s0.y), pk2(s0.z, s0.w), pk2(s1.x, s1.y), pk2(s1.z, s1.w)}, w1 = {pk2(s2.x, s2.y), pk2(s2.z, s2.w), pk2(s3.x, s3.y), pk2(s3.z, s3.w)};
    LAS unsigned char* d = SN + (hd * 64 + v) * NATP + k0 * 2;
    *(LAS u32x4*)d = w0; *(LAS u32x4*)(d + 16) = w1;
}
__device__ __forceinline__ void ssd_m3(const Args& a, int layer, LAS unsigned char* lds, int b, int c, int g, int tid) {
    asm volatile("" : "+v"(tid), "+s"(b), "+s"(c));
    const bf16* proj = (const bf16*)(a.ws + WS_PROJ);
    const float* cw = a.in[8] + (size_t)layer * 4 * 768; const float* cb = a.in[9] + (size_t)layer * 768;
    const float* ST = (const float*)(a.ws + WS_ST); bf16* mixed = (bf16*)(a.ws + WS_MIXED);
    const int j = tid >> 6, lane = tid & 63, fr = lane & 15, q = lane >> 4;
    LAS unsigned char* XT = lds; LAS unsigned char* KN = XT + 4 * 64 * TRP; LAS unsigned char* QN = KN + 128 * NATP; LAS unsigned char* SN = QN + 128 * NATP;
    LAS float* aL = (LAS float*)(SN + 2 * 64 * NATP); LAS float* cumL = aL + 512; LAS float* dtL = cumL + 512;
    const size_t row0 = (size_t)b * L + c * 128 + 16 * j; const int p0 = c * 128 + 16 * j;
#pragma unroll 1
    for (int r7_ = 0; r7_ < ((PROBE_SUB == 7) ? 3 : 1); ++r7_) {
        unsigned raw[6][19];
#pragma unroll
        for (int i = 0; i < 6; ++i) ssd_load_raw(proj, row0, p0, (i < 4 ? (4 * g + i) * 64 : (i == 4 ? 512 : 640) + g * 64) + lane, raw[i]);
        float x[16];
#pragma unroll
        for (int hl = 0; hl < 4; ++hl) {
            ssd_conv(raw[hl], (4 * g + hl) * 64 + lane, cw, cb, x);
            wr_run_T(XT + (hl * 64 + lane) * TRP + 32 * j, x);
        }
        ssd_conv(raw[4], 512 + g * 64 + lane, cw, cb, x);
        wr_run_N(KN + (16 * j) * NATP + lane * 2, x);
        ssd_conv(raw[5], 640 + g * 64 + lane, cw, cb, x);
        wr_run_N(QN + (16 * j) * NATP + lane * 2, x);
    }
    stage_states2(ST, b, c, 4 * g, SN, tid);
    ssd_scalars(a, layer, b, c, g, tid, aL, cumL, dtL);
    u32x2 y[2][2][4]; float ssum[2];
    size_t rowp[2];
#pragma unroll
    for (int p = 0; p < 2; ++p) {
        if (p == 1) { __syncthreads(); stage_states2(ST, b, c, 4 * g + 2, SN, tid); __syncthreads(); }
        const int wb = (p == 0) ? j : 7 - j, tl = 16 * wb + fr;
        rowp[p] = (size_t)b * L + c * 128 + tl;
        u32x2 gz[2][4];
#pragma unroll
        for (int hd = 0; hd < 2; ++hd)
#pragma unroll
            for (int vt = 0; vt < 4; ++vt) gz[hd][vt] = *(const u32x2*)(proj + rowp[p] * NP + C_Z + (4 * g + 2 * p + hd) * 64 + 16 * vt + 4 * q);
        s16x8 Qf[2];
#pragma unroll
        for (int ks = 0; ks < 2; ++ks) Qf[ks] = ld8(QN + (16 * wb + fr) * NATP + (32 * ks + 8 * q) * 2);
        f32x4 sc[8];
#pragma unroll
        for (int st = 0; st < 8; ++st) {
            sc[st] = (f32x4){0.f, 0.f, 0.f, 0.f};
            if (st <= wb) {
#pragma unroll
                for (int ks = 0; ks < 2; ++ks) sc[st] = mfma32(ld8(KN + (16 * st + fr) * NATP + (32 * ks + 8 * q) * 2), Qf[ks], sc[st]);
            }
        }
        float ss = 0.f;
#pragma unroll
        for (int hd = 0; hd < 2; ++hd) {
            const int hl = 2 * p + hd, h = 4 * g + hl;
            const float cum_t = cumL[hl * 128 + tl], dsk = a.in[12][layer * 8 + h];
            f32x4 oacc[4];
            const float et = fexp(cum_t);
#pragma unroll
            for (int vt = 0; vt < 4; ++vt) {
                f32x4 t = {0.f, 0.f, 0.f, 0.f};
#pragma unroll
                for (int ks = 0; ks < 2; ++ks) t = mfma32(ld8(SN + (hd * 64 + 16 * vt + fr) * NATP + (32 * ks + 8 * q) * 2), Qf[ks], t);
                oacc[vt] = t * et;
            }
#pragma unroll
            for (int pa = 0; pa < 4; ++pa) {
                if (2 * pa <= wb) {
                    unsigned pb[4];
#pragma unroll
                    for (int u = 0; u < 2; ++u) {
                        const int st = 2 * pa + u;
                        const f32x4 cs4 = *(const LAS f32x4*)(cumL + hl * 128 + 16 * st + 4 * q), dt4 = *(const LAS f32x4*)(dtL + hl * 128 + 16 * st + 4 * q);
                        float pv[4];
#pragma unroll
                        for (int r = 0; r < 4; ++r) {
                            const int d = tl - (16 * st + 4 * q + r);
                            const float v = (d >= 0 && st <= wb) ? sc[st][r] * fexp(cum_t - cs4[r]) * dt4[r] : 0.f;
                            pv[r] = (d == 0) ? v + dsk : v;
                        }
                        pb[2 * u] = pk2(pv[0], pv[1]); pb[2 * u + 1] = pk2(pv[2], pv[3]);
                    }
                    const u32x4 pbv = {pb[0], pb[1], pb[2], pb[3]};
                    const s16x8 Bp = __builtin_bit_cast(s16x8, pbv);
#pragma unroll
                    for (int vt = 0; vt < 4; ++vt) {
                        const LAS unsigned char* vp = XT + (hl * 64 + 16 * vt + fr) * TRP + (32 * pa + 4 * q) * 2;
                        oacc[vt] = mfma32(cat8(ld4(vp), ld4(vp + 32)), Bp, oacc[vt]);
                    }
                }
            }
#pragma unroll
            for (int vt = 0; vt < 4; ++vt) {
                const u32x2 z2 = gz[hd][vt];
                const float y0 = oacc[vt].x * siluf(__uint_as_float(z2.x << 16)), y1 = oacc[vt].y * siluf(__uint_as_float(z2.x & 0xffff0000u));
                const float y2 = oacc[vt].z * siluf(__uint_as_float(z2.y << 16)), y3 = oacc[vt].w * siluf(__uint_as_float(z2.y & 0xffff0000u));
                ss += (y0 * y0 + y1 * y1) + (y2 * y2 + y3 * y3);
                y[p][hd][vt].x = pk2(y0, y1); y[p][hd][vt].y = pk2(y2, y3);
            }
        }
        ss += swz_xor<16>(ss); ss += xor32(ss, lane);
        ssum[p] = ss;
    }
    __syncthreads();
    if (q == 0) { aL[16 * j + fr] = ssum[0]; aL[128 + 16 * (7 - j) + fr] = ssum[1]; }
    __syncthreads();
    const float* gn = a.in[13] + (size_t)layer * 512 + g * 256;
#pragma unroll
    for (int p = 0; p < 2; ++p) {
        const int wb = (p == 0) ? j : 7 - j, tl = 16 * wb + fr;
        const float rinv = rsqrtf((aL[tl] + aL[128 + tl]) * (1.f / 256.f) + EPS);
#pragma unroll
        for (int hd = 0; hd < 2; ++hd)
#pragma unroll
            for (int vt = 0; vt < 4; ++vt) {
                const int col = (2 * p + hd) * 64 + 16 * vt + 4 * q;
                const f32x4 gv = *(const f32x4*)(gn + col);
                const u32x2 yy = y[p][hd][vt];
                u32x2 o; o.x = pk2(__uint_as_float(yy.x << 16) * rinv * gv.x, __uint_as_float(yy.x & 0xffff0000u) * rinv * gv.y); o.y = pk2(__uint_as_float(yy.y << 16) * rinv * gv.z, __uint_as_float(yy.y & 0xffff0000u) * rinv * gv.w);
                *(u32x2*)(mixed + rowp[p] * D + g * 256 + col) = o;
            }
    }
    __syncthreads();
}

constexpr int HG_QN = 0, HG_KN = 2 * 64 * NATP, HG_KH = 4 * 64 * NATP, HG_VT = 6 * 64 * NATP, HG_OB = 8 * 64 * NATP, HG_GL = HG_OB + 2 * 64 * TRP, HG_TOT = HG_GL + 2 * 8 * 64 * 4;
template <bool M3>
__device__ __forceinline__ void hgrn_stage_a(const Args& a, int layer, LAS unsigned char* lds, int b, int c, int half, int hc, int j, int lane) {
    const bf16* proj = (const bf16*)(a.ws + WS_PROJ);
    const int hd = j >> 2, sl = j & 3, h = 2 * half + hd, col = h * 64 + lane, jg = 4 * hc + sl;
    const size_t row0 = (size_t)b * L + c * 128 + 16 * jg;
    const float lbv = ((const float*)(a.ws + WS_LB))[layer * 256 + col];
    float qv[16], kin[16], clv[16], vv[16];
#pragma unroll
    for (int tt = 0; tt < 16; ++tt) {
        const float fr_ = bf2f(proj[(row0 + tt) * NP + C_HF + col]);
        vv[tt] = bf2f(proj[(row0 + tt) * NP + C_HI + col]);
        if (M3) qv[tt] = bf2f(proj[(row0 + tt) * NP + C_HQ + col]);
        const float f = lbv + (1.f - lbv) * sigmf(fr_);
        clv[tt] = flog(fmaxf(f, 1e-30f)); kin[tt] = 1.f - f;
    }
#pragma unroll
    for (int tt = 1; tt < 16; ++tt) clv[tt] += clv[tt - 1];
    const float total = clv[15];
    float x[16];
#pragma unroll
    for (int tt = 0; tt < 16; ++tt) x[tt] = kin[tt] * fexp(total - clv[tt]);
    wr_run_T(lds + HG_KH + (hd * 64 + lane) * NATP + 32 * sl, x);
    wr_run_T(lds + HG_VT + (hd * 64 + lane) * NATP + 32 * sl, vv);
    ((LAS float*)(lds + HG_GL))[(hd * 8 + jg) * 64 + lane] = M3 ? fexp(total) : total;
    if (M3) {
#pragma unroll
        for (int tt = 0; tt < 16; ++tt) x[tt] = qv[tt] * fexp(clv[tt]);
        wr_run_N(lds + HG_QN + (hd * 64 + 16 * sl) * NATP + lane * 2, x);
#pragma unroll
        for (int tt = 0; tt < 16; ++tt) x[tt] = kin[tt] * fexp(fminf(-clv[tt], 80.f));
        wr_run_N(lds + HG_KN + (hd * 64 + 16 * sl) * NATP + lane * 2, x);
    }
}
__device__ __forceinline__ s16x4 pk4(f32x4 v) { u32x2 u = {pk2(v.x, v.y), pk2(v.z, v.w)}; return __builtin_bit_cast(s16x4, u); }
__device__ __forceinline__ s16x4 ld4s(const LAS unsigned char* p) { return *(const LAS s16x4*)p; }
template <bool M3>
__device__ __forceinline__ void hgrn_unit(const Args& a, int layer, LAS unsigned char* lds, int b, int c, int half, int tid) {
    asm volatile("" : "+v"(tid), "+s"(b), "+s"(c));
    const int j = tid >> 6, lane = tid & 63, fr = lane & 15, q = lane >> 4;
    const int hd = j >> 2, vt = j & 3, head = 8 + 2 * half + hd;
    float* STp = (float*)(a.ws + WS_ST) + (((size_t)b * 64 + c) * 16 + head) * 4096;
    f32x4 S[4];
#pragma unroll
    for (int kt = 0; kt < 4; ++kt) {
        S[kt] = (f32x4){0.f, 0.f, 0.f, 0.f};
        if (M3) {
#pragma unroll
            for (int r = 0; r < 4; ++r) S[kt][r] = STp[(16 * kt + 4 * q + r) * 64 + 16 * vt + fr];
        }
    }
    const LAS float* gL = (const LAS float*)(lds + HG_GL);
#pragma unroll 1
    for (int hc = 0; hc < 2; ++hc) {
        for (int r8_ = 0; r8_ < ((PROBE_SUB == 8 && M3) ? 3 : 1); ++r8_) hgrn_stage_a<M3>(a, layer, lds, b, c, half, hc, j, lane);
        __syncthreads();
#pragma unroll 1
        for (int sl = 0; sl < 4; ++sl) {
            const int jg = 4 * hc + sl;
            const s16x4 Bv = ld4s(lds + HG_VT + (hd * 64 + 16 * vt + fr) * NATP + (16 * sl + 4 * q) * 2);
            if (M3) {
                f32x4 pacc = {0.f, 0.f, 0.f, 0.f};
#pragma unroll
                for (int ks = 0; ks < 2; ++ks)
                    pacc = mfma32(ld8(lds + HG_KN + (hd * 64 + 16 * sl + fr) * NATP + (32 * ks + 8 * q) * 2), ld8(lds + HG_QN + (hd * 64 + 16 * sl + fr) * NATP + (32 * ks + 8 * q) * 2), pacc);
#pragma unroll
                for (int r = 0; r < 4; ++r) pacc[r] = (4 * q + r <= fr) ? pacc[r] : 0.f;
                f32x4 oacc = {0.f, 0.f, 0.f, 0.f};
#pragma unroll
                for (int kt = 0; kt < 4; ++kt) oacc = mfma16(ld4s(lds + HG_QN + (hd * 64 + 16 * sl + fr) * NATP + (16 * kt + 4 * q) * 2), pk4(S[kt]), oacc);
                oacc = mfma16(pk4(pacc), Bv, oacc);
                LAS float* ob = (LAS float*)(lds + HG_OB + (hd * 64 + 16 * sl + 4 * q) * TRP) + 16 * vt + fr;
#pragma unroll
                for (int r = 0; r < 4; ++r) ob[r * (TRP / 4)] = oacc[r];
            }
#pragma unroll
            for (int kt = 0; kt < 4; ++kt) {
                const f32x4 g4 = *(const LAS f32x4*)(gL + (hd * 8 + jg) * 64 + 16 * kt + 4 * q);
                f32x4 sc = S[kt];
                if (M3) sc = sc * g4; else { sc.x *= fexp(g4.x); sc.y *= fexp(g4.y); sc.z *= fexp(g4.z); sc.w *= fexp(g4.w); }
                S[kt] = mfma16(ld4s(lds + HG_KH + (hd * 64 + 16 * kt + fr) * NATP + (16 * sl + 4 * q) * 2), Bv, sc);
            }
        }
        __syncthreads();
        if (M3) {
            const int hd2 = tid >> 8, t = (tid >> 2) & 63, qu = tid & 3, h2 = 2 * half + hd2;
            const LAS float* ob = (const LAS float*)(lds + HG_OB + (hd2 * 64 + t) * TRP) + 16 * qu;
            f32x4 o[4]; float ss = 0.f;
#pragma unroll
            for (int i = 0; i < 4; ++i) { o[i] = *(const LAS f32x4*)(ob + 4 * i); ss += (o[i].x * o[i].x + o[i].y * o[i].y) + (o[i].z * o[i].z + o[i].w * o[i].w); }
            ss += swz_xor<1>(ss); ss += swz_xor<2>(ss);
            const float rinv = rsqrtf(ss * (1.f / 64.f) + EPS);
            const size_t row = (size_t)b * L + c * 128 + 64 * hc + t;
            const bf16* gp = (const bf16*)(a.ws + WS_PROJ) + row * NP + C_HG + h2 * 64 + 16 * qu;
            const u32x4 g0 = *(const u32x4*)gp, g1 = *(const u32x4*)(gp + 8);
            const float* ng = a.in[15] + (size_t)layer * 256 + h2 * 64 + 16 * qu;
            const unsigned gg[8] = {g0.x, g0.y, g0.z, g0.w, g1.x, g1.y, g1.z, g1.w};
            unsigned ow[8];
#pragma unroll
            for (int i = 0; i < 4; ++i) {
                const f32x4 nv = *(const f32x4*)(ng + 4 * i);
                ow[2 * i] = pk2(o[i].x * rinv * nv.x * sigmf(__uint_as_float(gg[2 * i] << 16)), o[i].y * rinv * nv.y * sigmf(__uint_as_float(gg[2 * i] & 0xffff0000u)));
                ow[2 * i + 1] = pk2(o[i].z * rinv * nv.z * sigmf(__uint_as_float(gg[2 * i + 1] << 16)), o[i].w * rinv * nv.w * sigmf(__uint_as_float(gg[2 * i + 1] & 0xffff0000u)));
            }
            bf16* mp = (bf16*)(a.ws + WS_MIXED) + row * D + 512 + h2 * 64 + 16 * qu;
            *(u32x4*)mp = (u32x4){ow[0], ow[1], ow[2], ow[3]}; *(u32x4*)(mp + 8) = (u32x4){ow[4], ow[5], ow[6], ow[7]};
            __syncthreads();
        }
    }
    if (!M3) {
#pragma unroll
        for (int kt = 0; kt < 4; ++kt)
#pragma unroll
            for (int r = 0; r < 4; ++r) STp[(16 * kt + 4 * q + r) * 64 + 16 * vt + fr] = S[kt][r];
        if (tid < 128) {
            const int hd2 = tid >> 6, k = tid & 63;
            float s = 0.f;
#pragma unroll
            for (int jg = 0; jg < 8; ++jg) s += gL[(hd2 * 8 + jg) * 64 + k];
            ((float*)(a.ws + WS_DEC))[(((size_t)b * 64 + c) * 16 + 8 + 2 * half + hd2) * 64 + k] = expf(s);
        }
        __syncthreads();
    }
}

__device__ __forceinline__ void phase_m1(const Args& a, int layer, LAS unsigned char* lds, int bid, int G, int tid) {
    for (int u = bid; u < NB * 64 * 2; u += G) {
        const int b = u >> 7, c = (u >> 1) & 63, half = u & 1;
        for (int r_ = 0; r_ < ((PROBE_SUB == 4) ? 3 : 1); ++r_) ssd_m1(a, layer, lds, b, c, half, tid);
        for (int r_ = 0; r_ < ((PROBE_SUB == 5) ? 3 : 1); ++r_) ret_m1(a, lds, b, c, half, tid);
        for (int r_ = 0; r_ < ((PROBE_SUB == 6) ? 3 : 1); ++r_) hgrn_unit<false>(a, layer, lds, b, c, half, tid);
    }
}
__device__ __forceinline__ void phase_m2(const Args& a, LAS unsigned char* lds, int bid, int G, int tid) {
    float* ST = (float*)(a.ws + WS_ST); const float* DEC = (const float*)(a.ws + WS_DEC);
    LAS float* dl = (LAS float*)lds;
    for (int u = bid; u < 256; u += G) {
        const int bh = u >> 3, b = bh >> 4, head = bh & 15, e = (u & 7) * 512 + tid;
        __syncthreads();
#pragma unroll
        for (int i = 0; i < 8; ++i) { const int x = tid + 512 * i, c = x >> 6; dl[x] = DEC[(((size_t)b * 64 + c) * 16 + head) * 64 + (x & 63)]; }
        float s[64];
#pragma unroll
        for (int c = 0; c < 64; ++c) s[c] = ST[(((size_t)b * 64 + c) * 16 + head) * 4096 + e];
        __syncthreads();
        float run = 0.f;
#pragma unroll
        for (int c = 0; c < 64; ++c) { const float prev = run; run = dl[c * 64 + (e >> 6)] * run + s[c]; ST[(((size_t)b * 64 + c) * 16 + head) * 4096 + e] = prev; }
    }
}
__device__ __forceinline__ void phase_m3(const Args& a, int layer, LAS unsigned char* lds, int bid, int G, int tid) {
    for (int u = bid; u < NB * 64 * 2; u += G) {
        const int b = u >> 7, c = (u >> 1) & 63, half = u & 1;
        for (int r_ = 0; r_ < ((PROBE_SUB == 1) ? 3 : 1); ++r_) ssd_m3(a, layer, lds, b, c, half, tid);
        for (int r_ = 0; r_ < ((PROBE_SUB == 2) ? 3 : 1); ++r_) ret_m3(a, lds, b, c, half, tid);
        for (int r_ = 0; r_ < ((PROBE_SUB == 3) ? 3 : 1); ++r_) hgrn_unit<true>(a, layer, lds, b, c, half, tid);
    }
}


__device__ __forceinline__ const void* rd_ptr(LAS const unsigned* p) {
    const unsigned lo = __builtin_amdgcn_readfirstlane(p[0]), hi = __builtin_amdgcn_readfirstlane(p[1]);
    return (const void*)(GAS const void*)(((unsigned long long)hi << 32) | lo);
}
__device__ __forceinline__ Args load_args(LAS unsigned char* lds) {
    LAS const unsigned* la = (LAS const unsigned*)(lds + LDS_ARGS);
    asm volatile("" : "+v"(la));
    Args A;
#pragma unroll
    for (int i = 0; i < 24; ++i) A.in[i] = (const float*)rd_ptr(la + 2 * i);
    A.out = (float*)rd_ptr(la + 48); A.ws = (unsigned char*)rd_ptr(la + 50);
    A.ph_lo = 0; A.ph_hi = 0; A.region = 0; A.pad = 0;
    return A;
}
#define PROBE_PH -1
#define PROBE_REP 2
#define REPS(p) ((PROBE_PH == (p)) ? 1 + PROBE_REP : 1)
__global__ void __launch_bounds__(NTHREADS, 2) fwd(Args a0) {
    extern __shared__ __attribute__((aligned(16))) unsigned char lds_raw[];
    LAS unsigned char* lds = (LAS unsigned char*)lds_raw;
    const int G0 = gridDim.x, bid0 = blockIdx.x;
    const int wave = __builtin_amdgcn_readfirstlane(threadIdx.x >> 6);
#define FRESH() int lane = __builtin_amdgcn_mbcnt_hi(~0u, __builtin_amdgcn_mbcnt_lo(~0u, 0u)); asm volatile("" : "+v"(lane)); int bid = bid0, G = G0; asm volatile("" : "+s"(bid), "+s"(G)); \
    const int tid = wave * 64 + lane, gw = bid * NWAVES + wave, ngw = G * NWAVES; (void)gw; (void)ngw; const Args a = load_args(lds)
    const int lo = a0.ph_lo, hi = a0.ph_hi;
    volatile LAS unsigned* misc = (volatile LAS unsigned*)(lds + LDS_MISC);
    if (threadIdx.x < 4) misc[threadIdx.x] = 0u;
    if (threadIdx.x < 56) ((LAS unsigned*)(lds + LDS_ARGS))[threadIdx.x] = ((const unsigned*)&a0)[threadIdx.x];
    __syncthreads();
    XcdBarrier bar; bar.bar = (unsigned*)(a0.ws + WS_CTL) + CW_BAR + a0.region * XCD_BAR_WORDS; bar.x = 0; bar.st = misc;
    if (hi - lo > 1) bar = xcd_barrier_post(bar.bar, misc);
#define IN(k) (lo <= (k) && (k) < hi)
#define SEAM(k) do { if (IN(k) && IN((k) + 1)) { asm volatile("" : "+s"(bar.bar)); xcd_barrier(bar); } } while (0)
    if (IN(PH_PRO)) { FRESH(); phase_prologue(a, lds, bid, G, tid); phase_convert(a, lds, gw, ngw, wave, lane); }
    SEAM(PH_PRO);
    for (int layer = 0; layer < DEPTH; ++layer) {
        const int pb = 1 + layer * PH_PER_LAYER;
        if (IN(pb + P_N1)) { _Pragma("unroll 1") for (int rep_ = 0; rep_ < REPS(P_N1); ++rep_) { FRESH(); phase_norm1(a, layer, lds, bid, G, wave, lane, rep_ > 0); } }
        SEAM(pb + P_N1);
        if (IN(pb + P_GIN)) { _Pragma("unroll 1") for (int rep_ = 0; rep_ < REPS(P_GIN); ++rep_) { FRESH(); phase_gemm_in(a, layer, lds, G, bid, wave); } }
        SEAM(pb + P_GIN);
        if (IN(pb + P_M1)) { _Pragma("unroll 1") for (int rep_ = 0; rep_ < REPS(P_M1); ++rep_) { FRESH(); phase_m1(a, layer, lds, bid, G, tid); } }
        SEAM(pb + P_M1);
        if (IN(pb + P_M2)) { _Pragma("unroll 1") for (int rep_ = 0; rep_ < REPS(P_M2); ++rep_) { FRESH(); phase_m2(a, lds, bid, G, tid); } }
        SEAM(pb + P_M2);
        if (IN(pb + P_M3)) { _Pragma("unroll 1") for (int rep_ = 0; rep_ < REPS(P_M3); ++rep_) { FRESH(); phase_m3(a, layer, lds, bid, G, tid); } }
        SEAM(pb + P_M3);
        if (IN(pb + P_GOUT)) { _Pragma("unroll 1") for (int rep_ = 0; rep_ < REPS(P_GOUT); ++rep_) { FRESH(); phase_gemm_out(a, layer, lds, G, bid, wave); } }
        SEAM(pb + P_GOUT);
        if (IN(pb + P_N2)) { _Pragma("unroll 1") for (int rep_ = 0; rep_ < REPS(P_N2); ++rep_) { FRESH(); phase_norm2(a, layer, lds, bid, G, wave, lane, rep_ > 0); } }
        SEAM(pb + P_N2);
        if (IN(pb + P_GGU)) { _Pragma("unroll 1") for (int rep_ = 0; rep_ < REPS(P_GGU); ++rep_) { FRESH(); phase_gemm_gu(a, layer, lds, G, bid, tid, wave); } }
        SEAM(pb + P_GGU);
        if (IN(pb + P_GDN)) { _Pragma("unroll 1") for (int rep_ = 0; rep_ < REPS(P_GDN); ++rep_) { FRESH(); phase_gemm_dn(a, layer, lds, G, bid, tid, wave); } }
        SEAM(pb + P_GDN);
    }
    if (IN(PH_FINAL)) { FRESH(); phase_norm1(a, DEPTH, lds, bid, G, wave, lane); }
#undef IN
#undef SEAM
}

#ifndef N_LAUNCH_MODE
#define N_LAUNCH_MODE 1
#endif
extern "C" void kernel_launch(void* const* d_in, const int* in_sizes, int n_in, void* d_out, int out_size, void* d_ws, size_t ws_size, hipStream_t stream) {
    static int grid = 0;
    if (grid == 0) {
        if (n_in != 24 || ws_size < WS_END) { fprintf(stderr, "kernel_launch: unexpected n_in %d / ws %zu\n", n_in, ws_size); grid = -1; return; }
        int dev = 0, cus = 0, per_cu = 0;
        if (hipGetDevice(&dev) != hipSuccess || hipDeviceGetAttribute(&cus, hipDeviceAttributeMultiprocessorCount, dev) != hipSuccess) { grid = -1; return; }
        if (hipFuncSetAttribute((const void*)fwd, hipFuncAttributeMaxDynamicSharedMemorySize, LDS_BYTES) != hipSuccess) { fprintf(stderr, "kernel_launch: hipFuncSetAttribute failed\n"); grid = -1; return; }
        if (hipOccupancyMaxActiveBlocksPerMultiprocessor(&per_cu, (const void*)fwd, NTHREADS, LDS_BYTES) != hipSuccess || per_cu < 1) { fprintf(stderr, "kernel_launch: occupancy query says %d\n", per_cu); }
        (void)hipGetLastError();
        grid = cus;
    }
    if (grid < 0) return;
    unsigned char* ws = (unsigned char*)d_ws;
    (void)hipMemsetAsync(ws + WS_CTL, 0, CTL_BYTES, stream);
    Args a{};
    for (int i = 0; i < 24; ++i) a.in[i] = (const float*)d_in[i];
    a.out = (float*)d_out; a.ws = ws; a.region = 0; a.pad = 0;
#if N_LAUNCH_MODE == 1
    a.ph_lo = 0; a.ph_hi = NPH;
    hipLaunchKernelGGL(fwd, dim3(grid), dim3(NTHREADS), LDS_BYTES, stream, a);
#else
    for (int ph = 0; ph < NPH; ++ph) { a.ph_lo = ph; a.ph_hi = ph + 1; hipLaunchKernelGGL(fwd, dim3(grid), dim3(NTHREADS), LDS_BYTES, stream, a); }
#endif
}
```
